# Optimizing an MI355X kernel written in HIP

```python
import jax, jax.numpy as jnp
from jax import lax
import numpy as np

D_MODEL = 1024
BATCH = 16
SEQ = 256
DEPTH = 1
DEC_BATCH = 4
DEC_SEQ = 4096
PAST_LEN = 256

GRID_W = 64
H_A = 4
DK_A = 128
DV_A = 128
D_A = H_A * DV_A
CONV_K = 5
CHUNK_A = 64
H_B = 4
DK_B = 64
DV_B = 128
D_B = H_B * DV_B
CHUNK_B = 128
ROPE_BASE = 10000.0
D_MIX = D_A + D_B
D_IN = 3 * D_A + D_A + 2 * H_A + 2 * H_A + 2 * H_B * DK_B + D_B + D_B
D_FF = 4 * D_MODEL
ALPHA = (2.0 * DEPTH) ** 0.25
BETA_DN = (8.0 * DEPTH) ** -0.25

kernel_name = "hybrid_deltanet_retention_dit_step"


def layer_norm(x, w=None, b=None, eps=1e-6):
    xf = x.astype(jnp.float32)
    mu = jnp.mean(xf, -1, keepdims=True)
    var = jnp.mean(jnp.square(xf - mu), -1, keepdims=True)
    y = (xf - mu) * lax.rsqrt(var + eps)
    if w is not None:
        y = y * w.astype(jnp.float32) + b.astype(jnp.float32)
    return y.astype(x.dtype)


def l2norm(x, eps=1e-6):
    return x * lax.rsqrt(jnp.sum(jnp.square(x), -1, keepdims=True) + eps)


def heads(t, n):
    return t.reshape(t.shape[0], t.shape[1], n, -1).transpose(0, 2, 1, 3)


def merge_heads(t):
    b, n, s, d = t.shape
    return t.transpose(0, 2, 1, 3).reshape(b, s, n * d)


def flip_t(t):
    return jnp.flip(t, axis=2)


def short_conv(x, w):
    T = x.shape[1]
    pad = (CONV_K - 1) // 2
    xp = jnp.pad(x, ((0, 0), (pad, CONV_K - 1 - pad), (0, 0)))
    y = sum(xp[:, k:k + T] * w[k] for k in range(CONV_K))
    return jax.nn.silu(y)


def axial_rope(x):
    T = x.shape[2]
    rows = T // GRID_W
    r = jnp.repeat(jnp.arange(rows, dtype=jnp.float32), GRID_W)
    col = jnp.tile(jnp.arange(GRID_W, dtype=jnp.float32), rows)
    nf = DK_B // 4
    inv = ROPE_BASE ** (-jnp.arange(nf, dtype=jnp.float32) / nf)
    ang = jnp.concatenate([r[:, None] * inv, col[:, None] * inv], -1)
    cos, sin = jnp.cos(ang), jnp.sin(ang)
    x1, x2 = jnp.split(x, 2, axis=-1)
    return jnp.concatenate([x1 * cos - x2 * sin, x1 * sin + x2 * cos], -1)


def gated_delta_chunked(q, k, v, g, beta, s0):
    Bt, H, T, DK = q.shape
    DV = v.shape[-1]
    C = CHUNK_A
    N = T // C
    qc = q.reshape(Bt, H, N, C, DK)
    kc = k.reshape(Bt, H, N, C, DK)
    vc = v.reshape(Bt, H, N, C, DV)
    gc = jnp.cumsum(g.reshape(Bt, H, N, C), -1)
    bc = beta.reshape(Bt, H, N, C)
    tri = jnp.tril(jnp.ones((C, C), bool))
    strict = jnp.tril(jnp.ones((C, C), bool), -1)
    diff = gc[..., :, None] - gc[..., None, :]
    L = jnp.where(tri, jnp.exp(jnp.where(tri, diff, 0.0)), 0.0)
    kb = kc * bc[..., None]
    M = jnp.where(strict, jnp.einsum('bhnid,bhnjd->bhnij', kb, kc) * L, 0.0)
    A = M + jnp.eye(C, dtype=M.dtype)
    rhs = jnp.concatenate([vc * bc[..., None], kb * jnp.exp(gc)[..., None]], -1)
    sol = lax.linalg.triangular_solve(A, rhs, left_side=True, lower=True, unit_diagonal=True)
    u, w = sol[..., :DV], sol[..., DV:]
    qk = jnp.where(tri, jnp.einsum('bhnid,bhnjd->bhnij', qc, kc) * L, 0.0)
    q_dec = qc * jnp.exp(gc)[..., None]
    k_dec = kc * jnp.exp(gc[..., -1:] - gc)[..., None]
    g_last = jnp.exp(gc[..., -1])

    def step(S, xs):
        u_i, w_i, qk_i, qd_i, kd_i, gl_i = xs
        v_new = u_i - jnp.einsum('bhcd,bhde->bhce', w_i, S)
        o = jnp.einsum('bhcd,bhde->bhce', qd_i, S) + jnp.einsum('bhij,bhje->bhie', qk_i, v_new)
        S = S * gl_i[..., None, None] + jnp.einsum('bhcd,bhce->bhde', kd_i, v_new)
        return S, o

    xs = (jnp.moveaxis(u, 2, 0), jnp.moveaxis(w, 2, 0), jnp.moveaxis(qk, 2, 0),
          jnp.moveaxis(q_dec, 2, 0), jnp.moveaxis(k_dec, 2, 0), jnp.moveaxis(g_last, 2, 0))
    s_final, o = lax.scan(step, s0, xs)
    o = jnp.moveaxis(o, 0, 2).reshape(Bt, H, T, DV)
    return o, s_final


def retention_log_decay():
    return jnp.log1p(-jnp.exp2(-5.0 - jnp.arange(H_B, dtype=jnp.float32)))


def retention_chunked(q, k, v, log_gamma, s0):
    Bt, H, T, DK = q.shape
    DV = v.shape[-1]
    C = CHUNK_B
    N = T // C
    pos = jnp.arange(C, dtype=jnp.float32)
    diff = pos[:, None] - pos[None, :]
    d_mask = jnp.where(diff >= 0, jnp.exp(log_gamma[:, None, None] * jnp.maximum(diff, 0.0)), 0.0)
    xi = jnp.exp(log_gamma[:, None] * (pos + 1.0))
    zeta = jnp.exp(log_gamma[:, None] * (C - 1.0 - pos))
    g_chunk = jnp.exp(log_gamma * C)
    qc = q.reshape(Bt, H, N, C, DK)
    kc = k.reshape(Bt, H, N, C, DK)
    vc = v.reshape(Bt, H, N, C, DV)
    scores = jnp.einsum('bhnid,bhnjd->bhnij', qc, kc) * d_mask[:, None]
    inner = jnp.einsum('bhnij,bhnje->bhnie', scores, vc)
    ds = jnp.einsum('bhncd,bhnce->bhnde', kc * zeta[:, None, :, None], vc)

    def step(s, ds_n):
        return s * g_chunk[:, None, None] + ds_n, s

    s_final, s_prev = lax.scan(step, s0, jnp.moveaxis(ds, 2, 0))
    s_prev = jnp.moveaxis(s_prev, 0, 2)
    cross = jnp.einsum('bhncd,bhnde->bhnce', qc * xi[:, None, :, None], s_prev)
    return (inner + cross).reshape(Bt, H, T, DV), s_final


def mixer(h, s_delta0, s_ret0, use_rope, w_in, conv_w, a_log, dt_bias, norm_a_w, gn_w, gn_b, w_o):
    Bt, T, _ = h.shape
    f32 = jnp.float32
    p = jnp.einsum('btd,de->bte', h, w_in).astype(f32)
    sizes = (3 * D_A, D_A, 2 * H_A, 2 * H_A, H_B * DK_B, H_B * DK_B, D_B, D_B)
    split_pts = np.cumsum(sizes)[:-1].tolist()
    qkv_a, gate_a, alpha_raw, beta_raw, q_b, k_b, v_b, gate_b = jnp.split(p, split_pts, axis=-1)

    qkv_a = short_conv(qkv_a, conv_w.astype(f32))
    qa, ka, va = jnp.split(qkv_a, 3, axis=-1)
    qa = l2norm(heads(qa, H_A)) * (DK_A ** -0.5)
    ka = l2norm(heads(ka, H_A))
    va = heads(va, H_A)
    g_log = -jnp.exp(a_log.astype(f32)) * jax.nn.softplus(alpha_raw.reshape(Bt, T, 2, H_A) + dt_bias.astype(f32))
    g_log = g_log.transpose(2, 0, 3, 1)
    beta = jax.nn.sigmoid(beta_raw.reshape(Bt, T, 2, H_A)).transpose(2, 0, 3, 1)
    sd0 = s_delta0.astype(f32)
    o_f, sd_f = gated_delta_chunked(qa, ka, va, g_log[0], beta[0], sd0[:, 0])
    o_bw, sd_b = gated_delta_chunked(flip_t(qa), flip_t(ka), flip_t(va), flip_t(g_log[1]), flip_t(beta[1]), sd0[:, 1])
    o_a = o_f + flip_t(o_bw)
    o_a = o_a * lax.rsqrt(jnp.mean(jnp.square(o_a), -1, keepdims=True) + 1e-6) * norm_a_w.astype(f32)
    o_a = merge_heads(o_a) * jax.nn.silu(gate_a)

    qb = heads(q_b, H_B) * (DK_B ** -0.5)
    kb = heads(k_b, H_B)
    vb = heads(v_b, H_B)
    if use_rope:
        qb = axial_rope(qb)
        kb = axial_rope(kb)
    lg = retention_log_decay()
    sr0 = s_ret0.astype(f32)
    r_f, sr_f = retention_chunked(qb, kb, vb, lg, sr0[:, 0])
    r_bw, sr_b = retention_chunked(flip_t(qb), flip_t(kb), flip_t(vb), lg[::-1], sr0[:, 1])
    o_r = r_f + flip_t(r_bw)
    o_r = merge_heads(layer_norm(o_r, eps=1e-5)) * gn_w.astype(f32) + gn_b.astype(f32)
    o_r = o_r * jax.nn.silu(gate_b)

    y = jnp.einsum('bte,ed->btd', jnp.concatenate([o_a, o_r], -1), w_o.astype(f32)).astype(h.dtype)
    return y, jnp.stack([sd_f, sd_b], 1), jnp.stack([sr_f, sr_b], 1)


def trunk(x, cond, s_delta, s_ret, use_rope, w_mod, b_mod, w_in, conv_w, a_log, dt_bias, norm_a_w,
          gn_w, gn_b, w_o, ln1_w, ln1_b, w_ff1, b_ff1, w_ff2, b_ff2, ln2_w, ln2_b):
    new_sd, new_sr = [], []
    for l in range(DEPTH):
        mod = jnp.einsum('bd,de->be', jax.nn.silu(cond), w_mod[l]) + b_mod[l]
        sh1, sc1, g1, sh2, sc2, g2 = jnp.split(mod[:, None, :], 6, axis=-1)
        h = layer_norm(x) * (1.0 + sc1) + sh1
        y, sd, sr = mixer(h, s_delta[:, l], s_ret[:, l], use_rope, w_in[l], conv_w[l], a_log[l], dt_bias[l],
                          norm_a_w[l], gn_w[l], gn_b[l], w_o[l])
        x = layer_norm(ALPHA * x + g1 * y, ln1_w[l], ln1_b[l])
        h = layer_norm(x) * (1.0 + sc2) + sh2
        f = jnp.einsum('btf,fd->btd', jnp.square(jax.nn.relu(jnp.einsum('btd,df->btf', h, w_ff1[l]) + b_ff1[l])),
                       w_ff2[l]) + b_ff2[l]
        x = layer_norm(ALPHA * x + g2 * f, ln2_w[l], ln2_b[l])
        new_sd.append(sd)
        new_sr.append(sr)
    return x, jnp.stack(new_sd, 1), jnp.stack(new_sr, 1)


def setup_inputs(seed: int = 0) -> dict:
    key = jax.random.key(seed)
    ks = jax.random.split(key, 24)
    nrm = jax.random.normal
    f32 = jnp.float32
    dt = jnp.exp(jax.random.uniform(ks[9], (DEPTH, 2, H_A), f32, np.log(1e-3), np.log(1e-1)))
    return {
        "x_prompt": nrm(ks[0], (BATCH, SEQ, D_MODEL), f32),
        "x_sample": nrm(ks[1], (DEC_BATCH, DEC_SEQ, D_MODEL), f32),
        "c": nrm(ks[2], (DEC_BATCH, D_MODEL), f32),
        "state_delta": 0.1 * nrm(ks[3], (DEC_BATCH, DEPTH, 2, H_A, DK_A, DV_A), f32),
        "state_ret": 0.5 * nrm(ks[4], (DEC_BATCH, DEPTH, 2, H_B, DK_B, DV_B), f32),
        "c_ctx": nrm(ks[5], (D_MODEL,), f32),
        "w_mod": 0.5 * D_MODEL ** -0.5 * nrm(ks[6], (DEPTH, D_MODEL, 6 * D_MODEL), f32),
        "b_mod": 0.02 * nrm(ks[7], (DEPTH, 6 * D_MODEL), f32),
        "w_in": D_MODEL ** -0.5 * nrm(ks[8], (DEPTH, D_MODEL, D_IN), f32),
        "conv_w": CONV_K ** -0.5 * nrm(ks[10], (DEPTH, CONV_K, 3 * D_A), f32),
        "a_log": jnp.log(jax.random.uniform(ks[11], (DEPTH, 2, H_A), f32, 1.0, 16.0)),
        "dt_bias": dt + jnp.log(-jnp.expm1(-dt)),
        "norm_a_w": 1.0 + 0.02 * nrm(ks[12], (DEPTH, DV_A), f32),
        "gn_w": 1.0 + 0.02 * nrm(ks[13], (DEPTH, D_B), f32),
        "gn_b": 0.02 * nrm(ks[14], (DEPTH, D_B), f32),
        "w_o": BETA_DN * D_MIX ** -0.5 * nrm(ks[15], (DEPTH, D_MIX, D_MODEL), f32),
        "ln1_w": 1.0 + 0.02 * nrm(ks[16], (DEPTH, D_MODEL), f32),
        "ln1_b": 0.02 * nrm(ks[17], (DEPTH, D_MODEL), f32),
        "w_ff1": D_MODEL ** -0.5 * nrm(ks[18], (DEPTH, D_MODEL, D_FF), f32),
        "b_ff1": 0.02 * nrm(ks[19], (DEPTH, D_FF), f32),
        "w_ff2": BETA_DN * D_FF ** -0.5 * nrm(ks[20], (DEPTH, D_FF, D_MODEL), f32),
        "b_ff2": 0.02 * nrm(ks[21], (DEPTH, D_MODEL), f32),
        "ln2_w": 1.0 + 0.02 * nrm(ks[22], (DEPTH, D_MODEL), f32),
        "ln2_b": 0.02 * nrm(ks[23], (DEPTH, D_MODEL), f32),
    }


def reference(x_prompt, x_sample, c, state_delta, state_ret, c_ctx, w_mod, b_mod, w_in, conv_w, a_log, dt_bias,
              norm_a_w, gn_w, gn_b, w_o, ln1_w, ln1_b, w_ff1, b_ff1, w_ff2, b_ff2, ln2_w, ln2_b):
    weights = (w_mod, b_mod, w_in, conv_w, a_log, dt_bias, norm_a_w, gn_w, gn_b, w_o,
               ln1_w, ln1_b, w_ff1, b_ff1, w_ff2, b_ff2, ln2_w, ln2_b)
    bp = x_prompt.shape[0]
    zero_sd = jnp.zeros((bp, DEPTH, 2, H_A, DK_A, DV_A), jnp.float32)
    zero_sr = jnp.zeros((bp, DEPTH, 2, H_B, DK_B, DV_B), jnp.float32)
    y_prompt, new_state_delta, new_state_ret = trunk(x_prompt, c_ctx[None, :], zero_sd, zero_sr, False, *weights)
    y_sample, _, _ = trunk(x_sample, c, state_delta, state_ret, True, *weights)
    return (y_prompt, y_sample, new_state_delta.astype(x_prompt.dtype), new_state_ret.astype(x_prompt.dtype))
```

```cpp
#include <hip/hip_runtime.h>
#include <cstdio>
#include <cstdint>
namespace pg8 {
#define PG8_LAS __attribute__((address_space(3)))
typedef unsigned short bf16_t;
typedef short bf16x8 __attribute__((ext_vector_type(8)));
typedef float f32x4 __attribute__((ext_vector_type(4)));
typedef unsigned u32x4 __attribute__((ext_vector_type(4)));
constexpr int BM = 256, BK = 64, HALF = 128, HTB = HALF * BK * 2  , STAGE_BYTES = 8 * HTB, NXCD = 8, WGM = 8;

__host__ __device__ __forceinline__ int lds_byte(int r, int c) { const int st = (r >> 4) * 2 + (c >> 5), rr = r & 15, cc = c & 31, ob = rr * 64 + cc * 2; return st * 1024 + (ob ^ (((ob >> 9) & 1) << 5)); }
__host__ __device__ __forceinline__ void stage_rc(int b, int& R, int& C) { const int st = b / 1024, sb = b % 1024, swz = sb ^ (((sb >> 9) & 1) << 5); R = (st >> 1) * 16 + swz / 64; C = (st & 1) * 32 + (swz % 64) / 2; }
__host__ __device__ __forceinline__ int perm32(int rho) { const int n = rho >> 4, i = rho & 15; return 8 * (i >> 2) + 4 * n + (i & 3); }

struct Unit { int pm, pn; };
struct Gemm { const bf16_t* A; const bf16_t* Bt; int M, N, K; };

struct StaticOrder {
    int nM, nN, nwg, G, c;
    __host__ __device__ void init(int M, int N, int G_, int c_) { nM = M / BM; nN = N / BM; nwg = nM * nN; G = G_; c = c_; }
    __host__ __device__ bool next(int i, Unit& u) const {
        const long L = (long)i * G + c; if (L >= nwg) return false;
        int wgid = (int)L; { const int q = nwg / NXCD, r = nwg % NXCD, xcd = wgid % NXCD, off = wgid / NXCD; wgid = (xcd < r ? xcd * (q + 1) : r * (q + 1) + (xcd - r) * q) + off; }
        const int nig = WGM * nN, gid = wgid / nig, fm = gid * WGM, gsz = (nM - fm) < WGM ? (nM - fm) : WGM;
        u.pm = fm + ((wgid % nig) % gsz); u.pn = (wgid % nig) / gsz; return true;
    }
    __device__ __forceinline__ void a_ready(const Unit&) const {}
    __device__ __forceinline__ void done(const Unit&) const {}
};

__device__ __forceinline__ unsigned cvt_pk_bf16(float lo, float hi) { unsigned r; asm volatile("v_cvt_pk_bf16_f32 %0, %1, %2" : "=v"(r) : "v"(lo), "v"(hi)); return r; }
template <int ACT> struct EpiBf16 {
    static constexpr bool PERM = true, AFTER_DRAIN = false;
    bf16_t* O; int ldc; const float* bias;
    __device__ __forceinline__ void operator()(const f32x4 (&acc)[2][2][4][2], const Unit& u, int wr, int wc, int fr, int fq) const {
        const int row0 = u.pm * BM + wr * 64 + fr; const int col0 = u.pn * BM + wc * 32 + 8 * fq;
        f32x4 bv[2][2];
#pragma unroll
        for (int bj = 0; bj < 2; ++bj)
#pragma unroll
            for (int n = 0; n < 2; ++n) bv[bj][n] = bias ? *(const f32x4*)(bias + col0 + bj * HALF + 4 * n) : (f32x4){0.f, 0.f, 0.f, 0.f};
#pragma unroll
        for (int ai = 0; ai < 2; ++ai)
#pragma unroll
            for (int m = 0; m < 4; ++m) { bf16_t* rowp = O + (size_t)(row0 + ai * HALF + m * 16) * ldc + col0;
#pragma unroll
                for (int bj = 0; bj < 2; ++bj) { f32x4 v0 = acc[ai][bj][m][0] + bv[bj][0], v1 = acc[ai][bj][m][1] + bv[bj][1];
                    if (ACT == 2) {
#pragma unroll
                        for (int i = 0; i < 4; ++i) { const float a = v0[i] > 0.f ? v0[i] : 0.f, b = v1[i] > 0.f ? v1[i] : 0.f; v0[i] = a * a; v1[i] = b * b; } }
                    u32x4 w; w.x = cvt_pk_bf16(v0[0], v0[1]); w.y = cvt_pk_bf16(v0[2], v0[3]); w.z = cvt_pk_bf16(v1[0], v1[1]); w.w = cvt_pk_bf16(v1[2], v1[3]);
                    *(u32x4*)(rowp + bj * HALF) = w; } }
    }
};
struct EpiResid {
    static constexpr bool PERM = false, AFTER_DRAIN = false;
    const float* base0; const float* base1; float* out; int ldc; const float* bias; const float* gate; int gate_pitch; float alpha;
    __device__ __forceinline__ void operator()(const f32x4 (&acc)[2][2][4][2], const Unit& u, int wr, int wc, int fr, int fq) const {
        const int row0 = u.pm * BM + wr * 64 + fr; const int col0 = u.pn * BM + wc * 32 + 4 * fq;
        const int r0 = u.pm * BM; const int vrow = r0 < 4096 ? 0 : 1 + ((r0 - 4096) >> 12);
        const float* gp = gate + (size_t)vrow * gate_pitch; const float* base = r0 < 4096 ? base0 : base1;
        f32x4 bv[2][2], gv[2][2];
#pragma unroll
        for (int bj = 0; bj < 2; ++bj)
#pragma unroll
            for (int n = 0; n < 2; ++n) { bv[bj][n] = bias ? *(const f32x4*)(bias + col0 + bj * HALF + n * 16) : (f32x4){0.f, 0.f, 0.f, 0.f}; gv[bj][n] = *(const f32x4*)(gp + col0 + bj * HALF + n * 16); }
#pragma unroll
        for (int ai = 0; ai < 2; ++ai)
#pragma unroll
            for (int m = 0; m < 4; ++m) { const size_t off = (size_t)(row0 + ai * HALF + m * 16) * ldc + col0;
#pragma unroll
                for (int bj = 0; bj < 2; ++bj)
#pragma unroll
                    for (int n = 0; n < 2; ++n) { const f32x4 bs = *(const f32x4*)(base + off + bj * HALF + n * 16);
                        const f32x4 o = bs * alpha + gv[bj][n] * (acc[ai][bj][m][n] + bv[bj][n]);
                        *(f32x4*)(out + off + bj * HALF + n * 16) = o; } }
    }
};

template <class Epi, class Sched, bool ALIGN_EPI = false, bool SP2 = false>
__device__ __forceinline__ void gemm_phase(PG8_LAS unsigned char* lds, const Gemm g, const Sched& S, const Epi& E) {
    const int tid = threadIdx.x, wid = __builtin_amdgcn_readfirstlane(tid >> 6), lane = tid & 63, wr = wid >> 2, wc = wid & 3, fr = lane & 15, fq = lane >> 4;
    const int K = g.K, nt = K / BK;
    unsigned voffA[2], voffB[2];
#pragma unroll
    for (int i = 0; i < 2; ++i) { int R, C; stage_rc(tid * 16 + i * 8192, R, C); const int Rb = Epi::PERM ? ((R & ~31) + perm32(R & 31)) : R;
        voffA[i] = (unsigned)(R * K + C) * 2u; voffB[i] = (unsigned)(Rb * K + C) * 2u; }
    const size_t kstep = (size_t)(BK * 2);
    const size_t hstep = (size_t)HALF * K * 2;
    const size_t tstep = 2 * hstep;
    const unsigned ldsw = (unsigned)wid * 1024u;
    const int aoff = lds_byte(wr * 64 + fr, fq * 8), boff = lds_byte(wc * 32 + fr, fq * 8);
#define PG8_SA(b, h) (((b) * 2 + (h)) * HTB)
#define PG8_SB(b, h) ((4 + (b) * 2 + (h)) * HTB)
#define PG8_STAGE(bufoff, gbase, voff) do { _Pragma("unroll") for (int _i = 0; _i < 2; ++_i) \
        __builtin_amdgcn_global_load_lds((const unsigned*)((const char*)(gbase) + (voff)[_i]), (PG8_LAS unsigned*)(lds + (bufoff) + ldsw + _i * 8192), 16, 0, 0); } while (0)
#define PG8_LDA(dst, b, h) do { _Pragma("unroll") for (int m = 0; m < 4; ++m) _Pragma("unroll") for (int k = 0; k < 2; ++k) dst[m][k] = *(const PG8_LAS bf16x8*)(lds + PG8_SA(b, h) + aoff + m * 2048 + k * 1024); } while (0)
#define PG8_LDB(dst, b, h) do { _Pragma("unroll") for (int n = 0; n < 2; ++n) _Pragma("unroll") for (int k = 0; k < 2; ++k) dst[n][k] = *(const PG8_LAS bf16x8*)(lds + PG8_SB(b, h) + boff + n * 2048 + k * 1024); } while (0)
#define PG8_MMA(ai, bj, At, Bt) do { __builtin_amdgcn_s_setprio(1); _Pragma("unroll") for (int m = 0; m < 4; ++m) _Pragma("unroll") for (int n = 0; n < 2; ++n) _Pragma("unroll") for (int k = 0; k < 2; ++k) \
        acc[ai][bj][m][n] = __builtin_amdgcn_mfma_f32_16x16x32_bf16(Bt[n][k], At[m][k], acc[ai][bj][m][n], 0, 0, 0); __builtin_amdgcn_s_setprio(0); } while (0)
#define PG8_WAIT_V(n) asm volatile("s_waitcnt vmcnt(" #n ")" ::: "memory")
#define PG8_WAIT_L(n) asm volatile("s_waitcnt lgkmcnt(" #n ")" ::: "memory")
#define PG8_BAR __builtin_amdgcn_s_barrier()
#define PG8_SCHED __builtin_amdgcn_sched_barrier(0)
    Unit cur, nxt; int ui = 0;
    if (!S.next(0, cur)) return;
    f32x4 acc[2][2][4][2];
#pragma unroll
    for (int a = 0; a < 2; ++a)
#pragma unroll
        for (int b = 0; b < 2; ++b)
#pragma unroll
            for (int m = 0; m < 4; ++m)
#pragma unroll
                for (int n = 0; n < 2; ++n) acc[a][b][m][n] = (f32x4){0.f, 0.f, 0.f, 0.f};
    bf16x8 At[4][2], B0[2][2], B1[2][2];
    const char* cA = (const char*)g.A + (size_t)cur.pm * tstep; const char* cB = (const char*)g.Bt + (size_t)cur.pn * tstep;
    S.a_ready(cur);
    if constexpr (SP2) {
        PG8_STAGE(PG8_SB(0, 0), cB, voffB); PG8_STAGE(PG8_SB(0, 1), cB + hstep, voffB); PG8_STAGE(PG8_SA(0, 0), cA, voffA); PG8_STAGE(PG8_SA(0, 1), cA + hstep, voffA);
        if (wr == 1) PG8_BAR;
        PG8_WAIT_V(2); PG8_BAR;
        PG8_STAGE(PG8_SB(1, 0), cB + kstep, voffB); PG8_STAGE(PG8_SA(1, 0), cA + kstep, voffA); PG8_STAGE(PG8_SB(1, 1), cB + hstep + kstep, voffB);
        PG8_WAIT_V(6); PG8_BAR;
    } else {
        PG8_STAGE(PG8_SB(0, 0), cB, voffB); PG8_STAGE(PG8_SA(0, 0), cA, voffA); PG8_STAGE(PG8_SB(0, 1), cB + hstep, voffB); PG8_STAGE(PG8_SA(0, 1), cA + hstep, voffA);
        if (wr == 1) PG8_BAR;
        PG8_WAIT_V(4); PG8_BAR;
        PG8_STAGE(PG8_SB(1, 0), cB + kstep, voffB); PG8_STAGE(PG8_SA(1, 0), cA + kstep, voffA); PG8_STAGE(PG8_SB(1, 1), cB + hstep + kstep, voffB);
        PG8_WAIT_V(6); PG8_BAR;
    }
    for (;;) {
        const bool has_next = S.next(ui + 1, nxt);
        const char* nA = has_next ? (const char*)g.A + (size_t)nxt.pm * tstep : cA; const char* nB = has_next ? (const char*)g.Bt + (size_t)nxt.pn * tstep : cB;
        for (int t = 0; t < nt; t += 2) {
            const bool last = (t == nt - 2);
            const char* a1 = cA + (size_t)(t + 1) * kstep;
            const char* a2 = last ? nA : cA + (size_t)(t + 2) * kstep; const char* b2 = last ? nB : cB + (size_t)(t + 2) * kstep;
            const char* a3 = a2 + kstep; const char* b3 = b2 + kstep;
            if (last && has_next) S.a_ready(nxt);
            if constexpr (SP2) {
            PG8_LDB(B0, 0, 0); PG8_LDB(B1, 0, 1); PG8_SCHED; PG8_LDA(At, 0, 0); PG8_STAGE(PG8_SA(1, 1), a1 + hstep, voffA);
            PG8_WAIT_V(8); PG8_WAIT_L(0); PG8_BAR; PG8_MMA(0, 0, At, B0); PG8_MMA(0, 1, At, B1); PG8_BAR; PG8_SCHED;
            PG8_LDA(At, 0, 1); PG8_STAGE(PG8_SB(0, 0), b2, voffB); PG8_STAGE(PG8_SB(0, 1), b2 + hstep, voffB); PG8_STAGE(PG8_SA(0, 0), a2, voffA);
            PG8_WAIT_V(8); PG8_WAIT_L(0); PG8_BAR; PG8_MMA(1, 0, At, B0); PG8_MMA(1, 1, At, B1); PG8_BAR; PG8_SCHED;
            PG8_LDB(B0, 1, 0); PG8_LDB(B1, 1, 1); PG8_SCHED; PG8_LDA(At, 1, 0); PG8_STAGE(PG8_SA(0, 1), a2 + hstep, voffA);
            PG8_WAIT_V(8); PG8_WAIT_L(0); PG8_BAR; PG8_MMA(0, 0, At, B0); PG8_MMA(0, 1, At, B1); PG8_BAR; PG8_SCHED;
            PG8_LDA(At, 1, 1); PG8_STAGE(PG8_SB(1, 0), b3, voffB); PG8_STAGE(PG8_SB(1, 1), b3 + hstep, voffB); PG8_STAGE(PG8_SA(1, 0), a3, voffA);
            PG8_WAIT_V(8); PG8_WAIT_L(0); PG8_BAR; PG8_MMA(1, 0, At, B0); PG8_MMA(1, 1, At, B1); PG8_BAR; PG8_SCHED;
            } else {
            PG8_LDB(B0, 0, 0); PG8_SCHED; PG8_LDA(At, 0, 0); PG8_STAGE(PG8_SA(1, 1), a1 + hstep, voffA);
            PG8_WAIT_L(8); PG8_BAR; PG8_WAIT_L(0); PG8_MMA(0, 0, At, B0); PG8_BAR; PG8_SCHED;
            PG8_LDB(B1, 0, 1); PG8_STAGE(PG8_SB(0, 0), b2, voffB);
            PG8_BAR; PG8_WAIT_L(0); PG8_MMA(0, 1, At, B1); PG8_BAR;
            PG8_LDA(At, 0, 1); PG8_STAGE(PG8_SA(0, 0), a2, voffA);
            PG8_BAR; PG8_WAIT_L(0); PG8_MMA(1, 0, At, B0); PG8_BAR; PG8_SCHED;
            PG8_STAGE(PG8_SB(0, 1), b2 + hstep, voffB);
            PG8_WAIT_V(6); PG8_BAR; PG8_MMA(1, 1, At, B1); PG8_BAR;
            PG8_LDB(B0, 1, 0); PG8_SCHED; PG8_LDA(At, 1, 0); PG8_STAGE(PG8_SA(0, 1), a2 + hstep, voffA);
            PG8_WAIT_L(8); PG8_BAR; PG8_WAIT_L(0); PG8_MMA(0, 0, At, B0); PG8_BAR; PG8_SCHED;
            PG8_LDB(B1, 1, 1); PG8_STAGE(PG8_SB(1, 0), b3, voffB);
            PG8_BAR; PG8_WAIT_L(0); PG8_MMA(0, 1, At, B1); PG8_BAR;
            PG8_LDA(At, 1, 1); PG8_STAGE(PG8_SA(1, 0), a3, voffA);
            PG8_BAR; PG8_WAIT_L(0); PG8_MMA(1, 0, At, B0); PG8_BAR; PG8_SCHED;
            PG8_STAGE(PG8_SB(1, 1), b3 + hstep, voffB);
            PG8_WAIT_V(6); PG8_BAR; PG8_MMA(1, 1, At, B1); PG8_BAR;
            }
        }
        if constexpr (ALIGN_EPI) { if (wr == 0) PG8_BAR; }
        if constexpr (!Epi::AFTER_DRAIN) { E(acc, cur, wr, wc, fr, fq); S.done(cur); }
        if (!has_next) break;
#pragma unroll
        for (int a = 0; a < 2; ++a)
#pragma unroll
            for (int b = 0; b < 2; ++b)
#pragma unroll
                for (int m = 0; m < 4; ++m)
#pragma unroll
                    for (int n = 0; n < 2; ++n) acc[a][b][m][n] = (f32x4){0.f, 0.f, 0.f, 0.f};
        cur = nxt; cA = nA; cB = nB; ++ui;
        if constexpr (ALIGN_EPI) { if (wr == 1) PG8_BAR; }
    }
    PG8_WAIT_V(0);
    if constexpr (!ALIGN_EPI) { if (wr == 0) PG8_BAR; }
    PG8_BAR;
    if constexpr (Epi::AFTER_DRAIN) { E.fused(acc, cur, wr, wc, fr, fq, lds, wid, lane); S.done(cur); }
#undef PG8_SA
#undef PG8_SB
#undef PG8_STAGE
#undef PG8_LDA
#undef PG8_LDB
#undef PG8_MMA
#undef PG8_WAIT_V
#undef PG8_WAIT_L
#undef PG8_BAR
#undef PG8_SCHED
}
}

constexpr int NWAVES = 8;
constexpr int D = 1024, FF = 4096, NROW = 20480, NPR = 4096;
constexpr int NPAD = 3840;
constexpr int C_QA = 0, C_KA = 512, C_VA = 1024, C_GA = 1536, C_QB = 2048, C_KB = 2304, C_VB = 2560, C_GB = 3072, C_AL = 3584, C_BE = 3592;
constexpr int NMODV = 5, MODW = 6144;
constexpr float ALPHA_DN = 1.189207115002721f;
constexpr size_t MiB = 1u << 20;
constexpr size_t WS_CTL = 0, CTL_ZERO_BYTES = 1 * MiB;
constexpr size_t CTL_MOD_OFF = 65536;
constexpr size_t WS_WIN = 1 * MiB, WS_WO = 9 * MiB, WS_W1 = 11 * MiB, WS_W2 = 19 * MiB;
constexpr size_t WS_H = 27 * MiB;
constexpr size_t WS_P = 67 * MiB;
constexpr size_t WS_GB = 228 * MiB;
constexpr size_t WS_RB = 230 * MiB;
constexpr size_t WS_END = 250 * MiB;
constexpr size_t OUT_Y = (size_t)NROW * D, OUT_SD = OUT_Y, OUT_SR = OUT_SD + (size_t)16 * 2 * 4 * 128 * 128;

#define LAS __attribute__((address_space(3)))
typedef unsigned short bf16;
typedef unsigned v4u __attribute__((ext_vector_type(4)));
typedef unsigned v2u __attribute__((ext_vector_type(2)));
typedef float f32x4 __attribute__((ext_vector_type(4)));
#define LDS_WAIT() asm volatile("s_waitcnt lgkmcnt(0)" ::: "memory")
__device__ __forceinline__ unsigned f2bf(float f) { unsigned u = __builtin_bit_cast(unsigned, f); return (u + 0x7fffu + ((u >> 16) & 1u)) >> 16; }
__device__ __forceinline__ unsigned pk2(float lo, float hi) { return f2bf(lo) | (f2bf(hi) << 16); }
__device__ __forceinline__ float bf2f(unsigned short h) { return __builtin_bit_cast(float, (unsigned)h << 16); }
__device__ __forceinline__ float bflo(unsigned w) { return __builtin_bit_cast(float, w << 16); }
__device__ __forceinline__ float bfhi(unsigned w) { return __builtin_bit_cast(float, w & 0xffff0000u); }
__device__ __forceinline__ float wave_sum(float v) {
#pragma unroll
    for (int o = 1; o < 64; o <<= 1) v += __shfl_xor(v, o);
    return v;
}
__device__ __forceinline__ float g16_sum(float v) {
#pragma unroll
    for (int o = 1; o < 16; o <<= 1) v += __shfl_xor(v, o);
    return v;
}
__device__ __forceinline__ float silu_f(float x) { return x / (1.f + __expf(-x)); }

struct Args {
    const float *x_prompt, *x_sample, *c, *state_delta, *state_ret, *c_ctx, *w_mod, *b_mod, *w_in, *conv_w, *a_log, *dt_bias, *norm_a_w, *gn_w, *gn_b, *w_o,
                *ln1_w, *ln1_b, *w_ff1, *b_ff1, *w_ff2, *b_ff2, *ln2_w, *ln2_b;
    float* out; unsigned char* ws; int ph_lo, ph_hi;
};
struct Frame { LAS unsigned char* lds; int tid, lane, wave, gw, NGW; };

__device__ __forceinline__ const float* xrow_ptr(const Args& a, int r) { return r < NPR ? a.x_prompt + (size_t)r * D : a.x_sample + (size_t)(r - NPR) * D; }
__device__ __forceinline__ int vrow_of(int r) { return r < NPR ? 0 : 1 + ((r - NPR) >> 12); }

__device__ __forceinline__ int map_in(int nd) { return nd < 2048 ? nd : (nd < 3584 ? nd + 16 : (nd < 3600 ? nd - 3584 + 2048 : -1)); }
template <bool MAP> __device__ __forceinline__ void transpose_item(const float* W, int K, int N, int nblk, bf16* WT, LAS float* scr, int item, int lane) {
    const int kb = item / nblk, nb = item % nblk, k0 = 64 * kb, n0 = 32 * nb;
    const int nd = n0 + (lane & 31), ns = MAP ? map_in(nd) : nd;
#pragma unroll 8
    for (int i = 0; i < 32; ++i) { const int kk = 2 * i + (lane >> 5); scr[kk * 33 + (lane & 31)] = ns >= 0 ? W[(size_t)(k0 + kk) * N + ns] : 0.f; }
    LDS_WAIT(); asm volatile("" ::: "memory");
    const int c = lane & 7;
#pragma unroll
    for (int j = 0; j < 4; ++j) { const int n = (lane >> 3) + 8 * j; const LAS float* s = scr + (8 * c) * 33 + n;
        v4u o; o.x = pk2(s[0 * 33], s[1 * 33]); o.y = pk2(s[2 * 33], s[3 * 33]); o.z = pk2(s[4 * 33], s[5 * 33]); o.w = pk2(s[6 * 33], s[7 * 33]);
        *(v4u*)(WT + (size_t)(n0 + n) * K + k0 + 8 * c) = o; }
    LDS_WAIT(); asm volatile("" ::: "memory");
}
__device__ __forceinline__ void p0_prologue(const Args& a, Frame& F) {
    LAS float* scr = (LAS float*)(F.lds + F.wave * 16384);
    bf16* Win_t = (bf16*)(a.ws + WS_WIN); bf16* Wo_t = (bf16*)(a.ws + WS_WO); bf16* W1_t = (bf16*)(a.ws + WS_W1); bf16* W2_t = (bf16*)(a.ws + WS_W2);
    constexpr int I_IN = (D / 64) * (NPAD / 32), I_O = (D / 64) * (D / 32), I_1 = (D / 64) * (FF / 32), I_2 = (FF / 64) * (D / 32);
    constexpr int I_MOD = 96 * 8;
    constexpr int NITEMS = I_MOD + I_IN + I_O + I_1 + I_2;
    float* mod = (float*)(a.ws + WS_CTL + CTL_MOD_OFF);
    for (int it = F.gw; it < NITEMS; it += F.NGW) {
        int r = it;
        if (r < I_MOD) {
            const int cg = r % 96, ks = r / 96, e = cg * 64 + F.lane;
            float acc[NMODV];
#pragma unroll
            for (int v = 0; v < NMODV; ++v) acc[v] = 0.f;
            for (int dd = 0; dd < 128; ++dd) { const int d = ks * 128 + dd; const float wv = a.w_mod[(size_t)d * MODW + e];
#pragma unroll
                for (int v = 0; v < NMODV; ++v) { const float cv = v == 0 ? a.c_ctx[d] : a.c[(v - 1) * D + d]; acc[v] += silu_f(cv) * wv; } }
            const float bb = ks == 0 ? a.b_mod[e] : 0.f;
#pragma unroll
            for (int v = 0; v < NMODV; ++v) atomicAdd(mod + v * MODW + e, acc[v] + bb);
            continue; }
        r -= I_MOD;
        if (r < I_IN) { transpose_item<true>(a.w_in, D, 3600, NPAD / 32, Win_t, scr, r, F.lane); continue; } r -= I_IN;
        if (r < I_O) { transpose_item<false>(a.w_o, D, D, D / 32, Wo_t, scr, r, F.lane); continue; } r -= I_O;
        if (r < I_1) { transpose_item<false>(a.w_ff1, D, FF, FF / 32, W1_t, scr, r, F.lane); continue; } r -= I_1;
        transpose_item<false>(a.w_ff2, FF, D, D / 32, W2_t, scr, r, F.lane);
    }
}

__device__ __forceinline__ void ln_stats(const f32x4 (&v)[4], float eps, float& mean, float& rstd) {
    float s = 0.f;
#pragma unroll
    for (int j = 0; j < 4; ++j) s += (v[j].x + v[j].y) + (v[j].z + v[j].w);
    mean = wave_sum(s) * (1.f / D); float s2 = 0.f;
#pragma unroll
    for (int j = 0; j < 4; ++j) { const f32x4 d = v[j] - mean; s2 += (d.x * d.x + d.y * d.y) + (d.z * d.z + d.w * d.w); }
    rstd = 1.f / sqrtf(wave_sum(s2) * (1.f / D) + eps);
}
__device__ __forceinline__ void p1_h(const Args& a, Frame& F) {
    const float* mod = (const float*)(a.ws + WS_CTL + CTL_MOD_OFF); bf16* H = (bf16*)(a.ws + WS_H);
    for (int r = F.gw; r < NROW; r += F.NGW) {
        const f32x4* xr = (const f32x4*)xrow_ptr(a, r) + F.lane; const float* mv = mod + (size_t)vrow_of(r) * MODW;
        f32x4 v[4];
#pragma unroll
        for (int j = 0; j < 4; ++j) v[j] = xr[64 * j];
        float mean, rstd; ln_stats(v, 1e-6f, mean, rstd);
        unsigned long long* o8 = (unsigned long long*)(H + (size_t)r * D) + F.lane;
#pragma unroll
        for (int j = 0; j < 4; ++j) { const f32x4 sh = *((const f32x4*)mv + F.lane + 64 * j), sc = *((const f32x4*)(mv + 1024) + F.lane + 64 * j);
            const f32x4 h = (v[j] - mean) * rstd * (sc + 1.f) + sh;
            o8[64 * j] = (unsigned long long)pk2(h.x, h.y) | ((unsigned long long)pk2(h.z, h.w) << 32); }
    }
}
__device__ __forceinline__ void seq_of_row(int r, int& base, int& T, int& t) { if (r < NPR) { base = r & ~255; T = 256; t = r & 255; } else { const int q = r - NPR; base = NPR + (q & ~4095); T = 4096; t = q & 4095; } }
__device__ __forceinline__ void unpack8(const v4u w, float (&f)[8]) { f[0] = bflo(w.x); f[1] = bfhi(w.x); f[2] = bflo(w.y); f[3] = bfhi(w.y); f[4] = bflo(w.z); f[5] = bfhi(w.z); f[6] = bflo(w.w); f[7] = bfhi(w.w); }
__device__ __forceinline__ v4u pack8(const float (&f)[8]) { v4u w; w.x = pk2(f[0], f[1]); w.y = pk2(f[2], f[3]); w.z = pk2(f[4], f[5]); w.w = pk2(f[6], f[7]); return w; }

__device__ __forceinline__ void p3a_prep(const Args& a, Frame& F) {
    bf16* P = (bf16*)(a.ws + WS_P); bf16* QKVC = (bf16*)a.out; float* GB = (float*)(a.ws + WS_GB);
    const int l = F.lane;
    for (int r = F.gw; r < NROW; r += F.NGW) {
        int base, T, t; seq_of_row(r, base, T, t);
        float acc[3][8];
#pragma unroll
        for (int s = 0; s < 3; ++s)
#pragma unroll
            for (int i = 0; i < 8; ++i) acc[s][i] = 0.f;
#pragma unroll
        for (int kk = 0; kk < 5; ++kk) { const int tt = t + kk - 2;
            if (tt >= 0 && tt < T) { const bf16* rp = P + (size_t)(base + tt) * NPAD;
#pragma unroll
                for (int s = 0; s < 3; ++s) { float xv[8]; unpack8(*(const v4u*)(rp + 512 * s + 8 * l), xv);
                    const f32x4 w0 = *(const f32x4*)(a.conv_w + kk * 1536 + 512 * s + 8 * l), w1 = *(const f32x4*)(a.conv_w + kk * 1536 + 512 * s + 8 * l + 4);
                    acc[s][0] += xv[0] * w0.x; acc[s][1] += xv[1] * w0.y; acc[s][2] += xv[2] * w0.z; acc[s][3] += xv[3] * w0.w;
                    acc[s][4] += xv[4] * w1.x; acc[s][5] += xv[5] * w1.y; acc[s][6] += xv[6] * w1.z; acc[s][7] += xv[7] * w1.w; } } }
#pragma unroll
        for (int s = 0; s < 3; ++s)
#pragma unroll
            for (int i = 0; i < 8; ++i) acc[s][i] = silu_f(acc[s][i]);
#pragma unroll
        for (int s = 0; s < 2; ++s) { float ss = 0.f;
#pragma unroll
            for (int i = 0; i < 8; ++i) ss += acc[s][i] * acc[s][i];
            ss = g16_sum(ss); const float sc = (1.f / sqrtf(ss + 1e-6f)) * (s == 0 ? 0.08838834764831845f : 1.f);
#pragma unroll
            for (int i = 0; i < 8; ++i) acc[s][i] *= sc; }
        bf16* op = QKVC + (size_t)r * 1536;
#pragma unroll
        for (int s = 0; s < 3; ++s) *(v4u*)(op + 512 * s + 8 * l) = pack8(acc[s]);
        { bf16* rp = P + (size_t)r * NPAD; const int hb = l >> 4, j0 = 2 * (l & 15);
          unsigned* q1p = (unsigned*)(rp + C_QB + 64 * hb + j0); unsigned* q2p = (unsigned*)(rp + C_QB + 64 * hb + 32 + j0);
          unsigned* k1p = (unsigned*)(rp + C_KB + 64 * hb + j0); unsigned* k2p = (unsigned*)(rp + C_KB + 64 * hb + 32 + j0);
          const unsigned q1 = *q1p, q2 = *q2p, k1 = *k1p, k2 = *k2p;
          float c0 = 1.f, s0 = 0.f, c1 = 1.f, s1 = 0.f;
          if (r >= NPR) { const float pos = (j0 < 16) ? (float)(t >> 6) : (float)(t & 63); const int f0 = j0 & 15;
              const float inv0 = powf(10000.f, -(float)f0 / 16.f), inv1 = powf(10000.f, -(float)(f0 + 1) / 16.f);
              sincosf(pos * inv0, &s0, &c0); sincosf(pos * inv1, &s1, &c1); }
          const float qa0 = bflo(q1) * 0.125f, qa1 = bfhi(q1) * 0.125f, qb0 = bflo(q2) * 0.125f, qb1 = bfhi(q2) * 0.125f;
          const float ka0 = bflo(k1), ka1 = bfhi(k1), kb0 = bflo(k2), kb1 = bfhi(k2);
          *q1p = pk2(qa0 * c0 - qb0 * s0, qa1 * c1 - qb1 * s1); *q2p = pk2(qa0 * s0 + qb0 * c0, qa1 * s1 + qb1 * c1);
          *k1p = pk2(ka0 * c0 - kb0 * s0, ka1 * c1 - kb1 * s1); *k2p = pk2(ka0 * s0 + kb0 * c0, ka1 * s1 + kb1 * c1); }
        if (l < 16) { const float raw = bf2f(P[(size_t)r * NPAD + C_AL + l]); float o;
            if (l < 8) { const float z = raw + a.dt_bias[l]; const float sp = z > 20.f ? z : log1pf(expf(z)); o = -expf(a.a_log[l]) * sp; }
            else o = 1.f / (1.f + expf(-raw));
            GB[(size_t)r * 16 + l] = o; }
    }
}

__device__ __forceinline__ void p3b_delta_naive(const Args& a, Frame& F) {
    const bf16* QKVC = (const bf16*)a.out; const float* GB = (const float*)(a.ws + WS_GB); bf16* P = (bf16*)(a.ws + WS_P);
    const int l = F.lane;
    for (int it = F.gw; it < 5120; it += F.NGW) {
        const bool smp = it < 1024; const int q = smp ? it : it - 1024;
        const int cg = q & 31, dir = (q >> 5) & 1, h = (q >> 6) & 3, sq = q >> 8;
        const int T = smp ? 4096 : 256, base = smp ? NPR + sq * 4096 : sq * 256, e0 = cg * 4;
        float s0[4], s1[4];
        if (smp) { const float* S0 = a.state_delta + ((size_t)(sq * 2 + dir) * 4 + h) * 128 * 128;
#pragma unroll
            for (int c = 0; c < 4; ++c) { s0[c] = S0[(size_t)l * 128 + e0 + c]; s1[c] = S0[(size_t)(l + 64) * 128 + e0 + c]; } }
        else {
#pragma unroll
            for (int c = 0; c < 4; ++c) { s0[c] = 0.f; s1[c] = 0.f; } }
        int row = base + (dir ? T - 1 : 0);
        const bf16* rp = QKVC + (size_t)row * 1536 + h * 128;
        unsigned short nq0 = rp[l], nq1 = rp[64 + l], nk0 = rp[512 + l], nk1 = rp[512 + 64 + l]; v2u nv = *(const v2u*)(rp + 1024 + e0);
        float ng = GB[(size_t)row * 16 + dir * 4 + h], nb = GB[(size_t)row * 16 + 8 + dir * 4 + h];
        for (int step = 0; step < T; ++step) {
            const float q0 = bf2f(nq0), q1 = bf2f(nq1), k0 = bf2f(nk0), k1 = bf2f(nk1), g = ng, b = nb; const v2u vv = nv; const int crow = row;
            if (step + 1 < T) { row = base + (dir ? T - 2 - step : step + 1); rp = QKVC + (size_t)row * 1536 + h * 128;
                nq0 = rp[l]; nq1 = rp[64 + l]; nk0 = rp[512 + l]; nk1 = rp[512 + 64 + l]; nv = *(const v2u*)(rp + 1024 + e0);
                ng = GB[(size_t)row * 16 + dir * 4 + h]; nb = GB[(size_t)row * 16 + 8 + dir * 4 + h]; }
            const float al = __expf(g);
            const float v4[4] = {bflo(vv.x), bfhi(vv.x), bflo(vv.y), bfhi(vv.y)};
            float dt[4], o[4];
#pragma unroll
            for (int c = 0; c < 4; ++c) dt[c] = k0 * s0[c] + k1 * s1[c];
#pragma unroll
            for (int c = 0; c < 4; ++c) dt[c] = wave_sum(dt[c]);
#pragma unroll
            for (int c = 0; c < 4; ++c) { const float cf = b * (v4[c] - al * dt[c]); s0[c] = al * s0[c] + cf * k0; s1[c] = al * s1[c] + cf * k1; o[c] = q0 * s0[c] + q1 * s1[c]; }
#pragma unroll
            for (int c = 0; c < 4; ++c) o[c] = wave_sum(o[c]);
            if (l == 0) { v2u w; w.x = pk2(o[0], o[1]); w.y = pk2(o[2], o[3]); *(v2u*)(P + (size_t)crow * NPAD + dir * 512 + h * 128 + e0) = w; }
        }
        if (!smp) { float* So = a.out + OUT_SD + ((size_t)(sq * 2 + dir) * 4 + h) * 128 * 128;
#pragma unroll
            for (int c = 0; c < 4; ++c) { So[(size_t)l * 128 + e0 + c] = s0[c]; So[(size_t)(l + 64) * 128 + e0 + c] = s1[c]; } }
    }
}

__device__ __forceinline__ void p3c_ret_naive(const Args& a, Frame& F) {
    const bf16* P = (const bf16*)(a.ws + WS_P); bf16* RF = (bf16*)a.out + (size_t)NROW * 1536; bf16* RB = (bf16*)(a.ws + WS_RB);
    const int l = F.lane;
    for (int it = F.gw; it < 5120; it += F.NGW) {
        const bool smp = it < 1024; const int q = smp ? it : it - 1024;
        const int cg = q & 31, dir = (q >> 5) & 1, h = (q >> 6) & 3, sq = q >> 8;
        const int T = smp ? 4096 : 256, base = smp ? NPR + sq * 4096 : sq * 256, e0 = cg * 4;
        const int hg = dir ? 3 - h : h; const float gam = 1.f - exp2f(-5.f - (float)hg);
        float s[4];
        if (smp) { const float* S0 = a.state_ret + ((size_t)(sq * 2 + dir) * 4 + h) * 64 * 128;
#pragma unroll
            for (int c = 0; c < 4; ++c) s[c] = S0[(size_t)l * 128 + e0 + c]; }
        else {
#pragma unroll
            for (int c = 0; c < 4; ++c) s[c] = 0.f; }
        bf16* R = dir ? RB : RF;
        int row = base + (dir ? T - 1 : 0);
        const bf16* rp = P + (size_t)row * NPAD;
        unsigned short nq = rp[C_QB + 64 * h + l], nk = rp[C_KB + 64 * h + l]; v2u nv = *(const v2u*)(rp + C_VB + 128 * h + e0);
        for (int step = 0; step < T; ++step) {
            const float qv = bf2f(nq), kv = bf2f(nk); const v2u vv = nv; const int crow = row;
            if (step + 1 < T) { row = base + (dir ? T - 2 - step : step + 1); rp = P + (size_t)row * NPAD;
                nq = rp[C_QB + 64 * h + l]; nk = rp[C_KB + 64 * h + l]; nv = *(const v2u*)(rp + C_VB + 128 * h + e0); }
            const float v4[4] = {bflo(vv.x), bfhi(vv.x), bflo(vv.y), bfhi(vv.y)};
            float o[4];
#pragma unroll
            for (int c = 0; c < 4; ++c) { s[c] = gam * s[c] + kv * v4[c]; o[c] = qv * s[c]; }
#pragma unroll
            for (int c = 0; c < 4; ++c) o[c] = wave_sum(o[c]);
            if (l == 0) { v2u w; w.x = pk2(o[0], o[1]); w.y = pk2(o[2], o[3]); *(v2u*)(R + (size_t)crow * 512 + h * 128 + e0) = w; }
        }
        if (!smp) { float* So = a.out + OUT_SR + ((size_t)(sq * 2 + dir) * 4 + h) * 64 * 128;
#pragma unroll
            for (int c = 0; c < 4; ++c) So[(size_t)l * 128 + e0 + c] = s[c]; }
    }
}

__device__ __forceinline__ void p5_combine(const Args& a, Frame& F) {
    const bf16* P = (const bf16*)(a.ws + WS_P); const bf16* RF = (const bf16*)a.out + (size_t)NROW * 1536; const bf16* RB = (const bf16*)(a.ws + WS_RB);
    bf16* MIX = (bf16*)(a.ws + WS_H); const int l = F.lane;
    for (int r = F.gw; r < NROW; r += F.NGW) {
        const bf16* rp = P + (size_t)r * NPAD;
        float x0[8], x1[8], gt[8], o[8];
        unpack8(*(const v4u*)(rp + 8 * l), x0); unpack8(*(const v4u*)(rp + 512 + 8 * l), x1); unpack8(*(const v4u*)(rp + C_GA + 8 * l), gt);
        float ss = 0.f;
#pragma unroll
        for (int i = 0; i < 8; ++i) { x0[i] += x1[i]; ss += x0[i] * x0[i]; }
        ss = g16_sum(ss); const float rs = 1.f / sqrtf(ss * (1.f / 128.f) + 1e-6f);
#pragma unroll
        for (int i = 0; i < 8; ++i) o[i] = x0[i] * rs * a.norm_a_w[(8 * l + i) & 127] * silu_f(gt[i]);
        *(v4u*)(MIX + (size_t)r * D + 8 * l) = pack8(o);
        unpack8(*(const v4u*)(RF + (size_t)r * 512 + 8 * l), x0); unpack8(*(const v4u*)(RB + (size_t)r * 512 + 8 * l), x1); unpack8(*(const v4u*)(rp + C_GB + 8 * l), gt);
        float sm = 0.f;
#pragma unroll
        for (int i = 0; i < 8; ++i) { x0[i] += x1[i]; sm += x0[i]; }
        const float mean = g16_sum(sm) * (1.f / 128.f); float sv = 0.f;
#pragma unroll
        for (int i = 0; i < 8; ++i) { x0[i] -= mean; sv += x0[i] * x0[i]; }
        const float rstd = 1.f / sqrtf(g16_sum(sv) * (1.f / 128.f) + 1e-5f);
#pragma unroll
        for (int i = 0; i < 8; ++i) o[i] = (x0[i] * rstd * a.gn_w[8 * l + i] + a.gn_b[8 * l + i]) * silu_f(gt[i]);
        *(v4u*)(MIX + (size_t)r * D + 512 + 8 * l) = pack8(o);
    }
}

__device__ __forceinline__ void p6b_ln1(const Args& a, Frame& F) {
    const float* mod = (const float*)(a.ws + WS_CTL + CTL_MOD_OFF); bf16* H2 = (bf16*)(a.ws + WS_H);
    for (int r = F.gw; r < NROW; r += F.NGW) {
        f32x4* zr = (f32x4*)(a.out + (size_t)r * D) + F.lane; const float* mv = mod + (size_t)vrow_of(r) * MODW;
        f32x4 v[4];
#pragma unroll
        for (int j = 0; j < 4; ++j) v[j] = zr[64 * j];
        float mean, rstd; ln_stats(v, 1e-6f, mean, rstd);
#pragma unroll
        for (int j = 0; j < 4; ++j) { const f32x4 w = *((const f32x4*)a.ln1_w + F.lane + 64 * j), b = *((const f32x4*)a.ln1_b + F.lane + 64 * j);
            v[j] = (v[j] - mean) * rstd * w + b; zr[64 * j] = v[j]; }
        ln_stats(v, 1e-6f, mean, rstd);
        unsigned long long* o8 = (unsigned long long*)(H2 + (size_t)r * D) + F.lane;
#pragma unroll
        for (int j = 0; j < 4; ++j) { const f32x4 sh = *((const f32x4*)(mv + 3072) + F.lane + 64 * j), sc = *((const f32x4*)(mv + 4096) + F.lane + 64 * j);
            const f32x4 h = (v[j] - mean) * rstd * (sc + 1.f) + sh;
            o8[64 * j] = (unsigned long long)pk2(h.x, h.y) | ((unsigned long long)pk2(h.z, h.w) << 32); }
    }
}
__device__ __forceinline__ void p8b_ln2(const Args& a, Frame& F) {
    for (int r = F.gw; r < NROW; r += F.NGW) {
        f32x4* zr = (f32x4*)(a.out + (size_t)r * D) + F.lane;
        f32x4 v[4];
#pragma unroll
        for (int j = 0; j < 4; ++j) v[j] = zr[64 * j];
        float mean, rstd; ln_stats(v, 1e-6f, mean, rstd);
#pragma unroll
        for (int j = 0; j < 4; ++j) { const f32x4 w = *((const f32x4*)a.ln2_w + F.lane + 64 * j), b = *((const f32x4*)a.ln2_b + F.lane + 64 * j);
            zr[64 * j] = (v[j] - mean) * rstd * w + b; }
    }
}

constexpr int LDS_BYTES = 147456;
constexpr int N_PHASES = 12;
__global__ void __launch_bounds__(NWAVES * 64, 2) fwd(Args a) {
    extern __shared__ __attribute__((aligned(16))) unsigned char lds[];
    Frame F; F.lds = (LAS unsigned char*)lds; F.tid = threadIdx.x; F.lane = F.tid & 63; F.wave = __builtin_amdgcn_readfirstlane(F.tid >> 6);
    F.gw = blockIdx.x * NWAVES + F.wave; F.NGW = gridDim.x * NWAVES;
    const int lo = a.ph_lo, hi = a.ph_hi;
    const float* mod = (const float*)(a.ws + WS_CTL + CTL_MOD_OFF);
#define IN(k) (lo <= (k) && (k) < hi)
    if (IN(0)) p0_prologue(a, F);
    if (IN(1)) p1_h(a, F);
    if (IN(2)) { pg8::Gemm g{(const pg8::bf16_t*)(a.ws + WS_H), (const pg8::bf16_t*)(a.ws + WS_WIN), NROW, NPAD, D}; pg8::StaticOrder S; S.init(NROW, NPAD, gridDim.x, (int)blockIdx.x);
        pg8::EpiBf16<0> E{(pg8::bf16_t*)(a.ws + WS_P), NPAD, nullptr};
        pg8::gemm_phase<pg8::EpiBf16<0>, pg8::StaticOrder, true, true>(F.lds, g, S, E); }
    if (IN(3)) p3a_prep(a, F);
    if (IN(4)) p3b_delta_naive(a, F);
    if (IN(5)) p3c_ret_naive(a, F);
    if (IN(6)) p5_combine(a, F);
    if (IN(7)) { pg8::Gemm g{(const pg8::bf16_t*)(a.ws + WS_H), (const pg8::bf16_t*)(a.ws + WS_WO), NROW, D, D}; pg8::StaticOrder S; S.init(NROW, D, gridDim.x, (int)blockIdx.x);
        pg8::EpiResid E{a.x_prompt, a.x_sample - (size_t)NPR * D, a.out, D, nullptr, mod + 2048, MODW, ALPHA_DN};
        pg8::gemm_phase<pg8::EpiResid, pg8::StaticOrder, true, true>(F.lds, g, S, E); }
    if (IN(8)) p6b_ln1(a, F);
    if (IN(9)) { pg8::Gemm g{(const pg8::bf16_t*)(a.ws + WS_H), (const pg8::bf16_t*)(a.ws + WS_W1), NROW, FF, D}; pg8::StaticOrder S; S.init(NROW, FF, gridDim.x, (int)blockIdx.x);
        pg8::EpiBf16<2> E{(pg8::bf16_t*)(a.ws + WS_P), FF, a.b_ff1};
        pg8::gemm_phase<pg8::EpiBf16<2>, pg8::StaticOrder, true, true>(F.lds, g, S, E); }
    if (IN(10)) { pg8::Gemm g{(const pg8::bf16_t*)(a.ws + WS_P), (const pg8::bf16_t*)(a.ws + WS_W2), NROW, D, FF}; pg8::StaticOrder S; S.init(NROW, D, gridDim.x, (int)blockIdx.x);
        pg8::EpiResid E{a.out, a.out, a.out, D, a.b_ff2, mod + 5120, MODW, ALPHA_DN};
        pg8::gemm_phase<pg8::EpiResid, pg8::StaticOrder, true, true>(F.lds, g, S, E); }
    if (IN(11)) p8b_ln2(a, F);
#undef IN
}

extern "C" void kernel_launch(void* const* d_in, const int* in_sizes, int n_in, void* d_out, int out_size, void* d_ws, size_t ws_size, hipStream_t stream) {
    static int grid = 0;
    if (grid == 0) {
        if (n_in != 24 || ws_size < WS_END || (size_t)out_size != OUT_SR + (size_t)16 * 2 * 4 * 64 * 128) { fprintf(stderr, "kernel_launch: unexpected problem: n_in %d out %d ws %zu\n", n_in, out_size, ws_size); grid = -1; return; }
        int dev = 0, cus = 0;
        if (hipGetDevice(&dev) != hipSuccess || hipDeviceGetAttribute(&cus, hipDeviceAttributeMultiprocessorCount, dev) != hipSuccess) { grid = -1; return; }
        if (hipFuncSetAttribute((const void*)fwd, hipFuncAttributeMaxDynamicSharedMemorySize, LDS_BYTES) != hipSuccess) { fprintf(stderr, "kernel_launch: hipFuncSetAttribute failed\n"); grid = -1; return; }
        grid = cus;
    }
    if (grid < 0) return;
    (void)hipMemsetAsync((char*)d_ws + WS_CTL, 0, CTL_ZERO_BYTES, stream);
    Args a{};
    const float** ap = (const float**)&a;
    for (int i = 0; i < 24; ++i) ap[i] = (const float*)d_in[i];
    a.out = (float*)d_out; a.ws = (unsigned char*)d_ws;
    for (int p = 0; p < N_PHASES; ++p) { a.ph_lo = p; a.ph_hi = p + 1; hipLaunchKernelGGL(fwd, dim3(grid), dim3(NWAVES * 64), LDS_BYTES, stream, a); }
}
```

```cpp
#include <hip/hip_runtime.h>
#include <cstdio>
#include <cstdint>
namespace pg8 {
#define PG8_LAS __attribute__((address_space(3)))
typedef unsigned short bf16_t;
typedef short bf16x8 __attribute__((ext_vector_type(8)));
typedef float f32x4 __attribute__((ext_vector_type(4)));
typedef unsigned u32x4 __attribute__((ext_vector_type(4)));
constexpr int BM = 256, BK = 64, HALF = 128, HTB = HALF * BK * 2  , STAGE_BYTES = 8 * HTB, NXCD = 8, WGM = 8;

__host__ __device__ __forceinline__ int lds_byte(int r, int c) { const int st = (r >> 4) * 2 + (c >> 5), rr = r & 15, cc = c & 31, ob = rr * 64 + cc * 2; return st * 1024 + (ob ^ (((ob >> 9) & 1) << 5)); }
__host__ __device__ __forceinline__ void stage_rc(int b, int& R, int& C) { const int st = b / 1024, sb = b % 1024, swz = sb ^ (((sb >> 9) & 1) << 5); R = (st >> 1) * 16 + swz / 64; C = (st & 1) * 32 + (swz % 64) / 2; }
__host__ __device__ __forceinline__ int perm32(int rho) { const int n = rho >> 4, i = rho & 15; return 8 * (i >> 2) + 4 * n + (i & 3); }

struct Unit { int pm, pn; };
struct Gemm { const bf16_t* A; const bf16_t* Bt; int M, N, K; };

struct StaticOrder {
    int nM, nN, nwg, G, c;
    __host__ __device__ void init(int M, int N, int G_, int c_) { nM = M / BM; nN = N / BM; nwg = nM * nN; G = G_; c = c_; }
    __host__ __device__ bool next(int i, Unit& u) const {
        const long L = (long)i * G + c; if (L >= nwg) return false;
        int wgid = (int)L; { const int q = nwg / NXCD, r = nwg % NXCD, xcd = wgid % NXCD, off = wgid / NXCD; wgid = (xcd < r ? xcd * (q + 1) : r * (q + 1) + (xcd - r) * q) + off; }
        const int nig = WGM * nN, gid = wgid / nig, fm = gid * WGM, gsz = (nM - fm) < WGM ? (nM - fm) : WGM;
        u.pm = fm + ((wgid % nig) % gsz); u.pn = (wgid % nig) / gsz; return true;
    }
    __device__ __forceinline__ void a_ready(const Unit&) const {}
    __device__ __forceinline__ void done(const Unit&) const {}
};

__device__ __forceinline__ unsigned cvt_pk_bf16(float lo, float hi) { unsigned r; asm volatile("v_cvt_pk_bf16_f32 %0, %1, %2" : "=v"(r) : "v"(lo), "v"(hi)); return r; }
template <int ACT> struct EpiBf16 {
    static constexpr bool PERM = true, AFTER_DRAIN = false;
    bf16_t* O; int ldc; const float* bias;
    __device__ __forceinline__ void operator()(const f32x4 (&acc)[2][2][4][2], const Unit& u, int wr, int wc, int fr, int fq) const {
        const int row0 = u.pm * BM + wr * 64 + fr; const int col0 = u.pn * BM + wc * 32 + 8 * fq;
        f32x4 bv[2][2];
#pragma unroll
        for (int bj = 0; bj < 2; ++bj)
#pragma unroll
            for (int n = 0; n < 2; ++n) bv[bj][n] = bias ? *(const f32x4*)(bias + col0 + bj * HALF + 4 * n) : (f32x4){0.f, 0.f, 0.f, 0.f};
#pragma unroll
        for (int ai = 0; ai < 2; ++ai)
#pragma unroll
            for (int m = 0; m < 4; ++m) { bf16_t* rowp = O + (size_t)(row0 + ai * HALF + m * 16) * ldc + col0;
#pragma unroll
                for (int bj = 0; bj < 2; ++bj) { f32x4 v0 = acc[ai][bj][m][0] + bv[bj][0], v1 = acc[ai][bj][m][1] + bv[bj][1];
                    if (ACT == 2) {
#pragma unroll
                        for (int i = 0; i < 4; ++i) { const float a = v0[i] > 0.f ? v0[i] : 0.f, b = v1[i] > 0.f ? v1[i] : 0.f; v0[i] = a * a; v1[i] = b * b; } }
                    u32x4 w; w.x = cvt_pk_bf16(v0[0], v0[1]); w.y = cvt_pk_bf16(v0[2], v0[3]); w.z = cvt_pk_bf16(v1[0], v1[1]); w.w = cvt_pk_bf16(v1[2], v1[3]);
                    *(u32x4*)(rowp + bj * HALF) = w; } }
    }
};
struct EpiResid {
    static constexpr bool PERM = false, AFTER_DRAIN = false;
    const float* base0; const float* base1; float* out; int ldc; const float* bias; const float* gate; int gate_pitch; float alpha;
    __device__ __forceinline__ void operator()(const f32x4 (&acc)[2][2][4][2], const Unit& u, int wr, int wc, int fr, int fq) const {
        const int row0 = u.pm * BM + wr * 64 + fr; const int col0 = u.pn * BM + wc * 32 + 4 * fq;
        const int r0 = u.pm * BM; const int vrow = r0 < 4096 ? 0 : 1 + ((r0 - 4096) >> 12);
        const float* gp = gate + (size_t)vrow * gate_pitch; const float* base = r0 < 4096 ? base0 : base1;
        f32x4 bv[2][2], gv[2][2];
#pragma unroll
        for (int bj = 0; bj < 2; ++bj)
#pragma unroll
            for (int n = 0; n < 2; ++n) { bv[bj][n] = bias ? *(const f32x4*)(bias + col0 + bj * HALF + n * 16) : (f32x4){0.f, 0.f, 0.f, 0.f}; gv[bj][n] = *(const f32x4*)(gp + col0 + bj * HALF + n * 16); }
#pragma unroll
        for (int ai = 0; ai < 2; ++ai)
#pragma unroll
            for (int m = 0; m < 4; ++m) { const size_t off = (size_t)(row0 + ai * HALF + m * 16) * ldc + col0;
#pragma unroll
                for (int bj = 0; bj < 2; ++bj)
#pragma unroll
                    for (int n = 0; n < 2; ++n) { const f32x4 bs = *(const f32x4*)(base + off + bj * HALF + n * 16);
                        const f32x4 o = bs * alpha + gv[bj][n] * (acc[ai][bj][m][n] + bv[bj][n]);
                        *(f32x4*)(out + off + bj * HALF + n * 16) = o; } }
    }
};

template <class Epi, class Sched, bool ALIGN_EPI = false, bool SP2 = false>
__device__ __forceinline__ void gemm_phase(PG8_LAS unsigned char* lds, const Gemm g, const Sched& S, const Epi& E) {
    const int tid = threadIdx.x, wid = __builtin_amdgcn_readfirstlane(tid >> 6), lane = tid & 63, wr = wid >> 2, wc = wid & 3, fr = lane & 15, fq = lane >> 4;
    const int K = g.K, nt = K / BK;
    unsigned voffA[2], voffB[2];
#pragma unroll
    for (int i = 0; i < 2; ++i) { int R, C; stage_rc(tid * 16 + i * 8192, R, C); const int Rb = Epi::PERM ? ((R & ~31) + perm32(R & 31)) : R;
        voffA[i] = (unsigned)(R * K + C) * 2u; voffB[i] = (unsigned)(Rb * K + C) * 2u; }
    const size_t kstep = (size_t)(BK * 2);
    const size_t hstep = (size_t)HALF * K * 2;
    const size_t tstep = 2 * hstep;
    const unsigned ldsw = (unsigned)wid * 1024u;
    const int aoff = lds_byte(wr * 64 + fr, fq * 8), boff = lds_byte(wc * 32 + fr, fq * 8);
#define PG8_SA(b, h) (((b) * 2 + (h)) * HTB)
#define PG8_SB(b, h) ((4 + (b) * 2 + (h)) * HTB)
#define PG8_STAGE(bufoff, gbase, voff) do { _Pragma("unroll") for (int _i = 0; _i < 2; ++_i) \
        __builtin_amdgcn_global_load_lds((const unsigned*)((const char*)(gbase) + (voff)[_i]), (PG8_LAS unsigned*)(lds + (bufoff) + ldsw + _i * 8192), 16, 0, 0); } while (0)
#define PG8_LDA(dst, b, h) do { _Pragma("unroll") for (int m = 0; m < 4; ++m) _Pragma("unroll") for (int k = 0; k < 2; ++k) dst[m][k] = *(const PG8_LAS bf16x8*)(lds + PG8_SA(b, h) + aoff + m * 2048 + k * 1024); } while (0)
#define PG8_LDB(dst, b, h) do { _Pragma("unroll") for (int n = 0; n < 2; ++n) _Pragma("unroll") for (int k = 0; k < 2; ++k) dst[n][k] = *(const PG8_LAS bf16x8*)(lds + PG8_SB(b, h) + boff + n * 2048 + k * 1024); } while (0)
#define PG8_MMA(ai, bj, At, Bt) do { __builtin_amdgcn_s_setprio(1); _Pragma("unroll") for (int m = 0; m < 4; ++m) _Pragma("unroll") for (int n = 0; n < 2; ++n) _Pragma("unroll") for (int k = 0; k < 2; ++k) \
        acc[ai][bj][m][n] = __builtin_amdgcn_mfma_f32_16x16x32_bf16(Bt[n][k], At[m][k], acc[ai][bj][m][n], 0, 0, 0); __builtin_amdgcn_s_setprio(0); } while (0)
#define PG8_WAIT_V(n) asm volatile("s_waitcnt vmcnt(" #n ")" ::: "memory")
#define PG8_WAIT_L(n) asm volatile("s_waitcnt lgkmcnt(" #n ")" ::: "memory")
#define PG8_BAR __builtin_amdgcn_s_barrier()
#define PG8_SCHED __builtin_amdgcn_sched_barrier(0)
    Unit cur, nxt; int ui = 0;
    if (!S.next(0, cur)) return;
    f32x4 acc[2][2][4][2];
#pragma unroll
    for (int a = 0; a < 2; ++a)
#pragma unroll
        for (int b = 0; b < 2; ++b)
#pragma unroll
            for (int m = 0; m < 4; ++m)
#pragma unroll
                for (int n = 0; n < 2; ++n) acc[a][b][m][n] = (f32x4){0.f, 0.f, 0.f, 0.f};
    bf16x8 At[4][2], B0[2][2], B1[2][2];
    const char* cA = (const char*)g.A + (size_t)cur.pm * tstep; const char* cB = (const char*)g.Bt + (size_t)cur.pn * tstep;
    S.a_ready(cur);
    if constexpr (SP2) {
        PG8_STAGE(PG8_SB(0, 0), cB, voffB); PG8_STAGE(PG8_SB(0, 1), cB + hstep, voffB); PG8_STAGE(PG8_SA(0, 0), cA, voffA); PG8_STAGE(PG8_SA(0, 1), cA + hstep, voffA);
        if (wr == 1) PG8_BAR;
        PG8_WAIT_V(2); PG8_BAR;
        PG8_STAGE(PG8_SB(1, 0), cB + kstep, voffB); PG8_STAGE(PG8_SA(1, 0), cA + kstep, voffA); PG8_STAGE(PG8_SB(1, 1), cB + hstep + kstep, voffB);
        PG8_WAIT_V(6); PG8_BAR;
    } else {
        PG8_STAGE(PG8_SB(0, 0), cB, voffB); PG8_STAGE(PG8_SA(0, 0), cA, voffA); PG8_STAGE(PG8_SB(0, 1), cB + hstep, voffB); PG8_STAGE(PG8_SA(0, 1), cA + hstep, voffA);
        if (wr == 1) PG8_BAR;
        PG8_WAIT_V(4); PG8_BAR;
        PG8_STAGE(PG8_SB(1, 0), cB + kstep, voffB); PG8_STAGE(PG8_SA(1, 0), cA + kstep, voffA); PG8_STAGE(PG8_SB(1, 1), cB + hstep + kstep, voffB);
        PG8_WAIT_V(6); PG8_BAR;
    }
    for (;;) {
        const bool has_next = S.next(ui + 1, nxt);
        const char* nA = has_next ? (const char*)g.A + (size_t)nxt.pm * tstep : cA; const char* nB = has_next ? (const char*)g.Bt + (size_t)nxt.pn * tstep : cB;
        for (int t = 0; t < nt; t += 2) {
            const bool last = (t == nt - 2);
            const char* a1 = cA + (size_t)(t + 1) * kstep;
            const char* a2 = last ? nA : cA + (size_t)(t + 2) * kstep; const char* b2 = last ? nB : cB + (size_t)(t + 2) * kstep;
            const char* a3 = a2 + kstep; const char* b3 = b2 + kstep;
            if (last && has_next) S.a_ready(nxt);
            if constexpr (SP2) {
            PG8_LDB(B0, 0, 0); PG8_LDB(B1, 0, 1); PG8_SCHED; PG8_LDA(At, 0, 0); PG8_STAGE(PG8_SA(1, 1), a1 + hstep, voffA);
            PG8_WAIT_V(8); PG8_WAIT_L(0); PG8_BAR; PG8_MMA(0, 0, At, B0); PG8_MMA(0, 1, At, B1); PG8_BAR; PG8_SCHED;
            PG8_LDA(At, 0, 1); PG8_STAGE(PG8_SB(0, 0), b2, voffB); PG8_STAGE(PG8_SB(0, 1), b2 + hstep, voffB); PG8_STAGE(PG8_SA(0, 0), a2, voffA);
            PG8_WAIT_V(8); PG8_WAIT_L(0); PG8_BAR; PG8_MMA(1, 0, At, B0); PG8_MMA(1, 1, At, B1); PG8_BAR; PG8_SCHED;
            PG8_LDB(B0, 1, 0); PG8_LDB(B1, 1, 1); PG8_SCHED; PG8_LDA(At, 1, 0); PG8_STAGE(PG8_SA(0, 1), a2 + hstep, voffA);
            PG8_WAIT_V(8); PG8_WAIT_L(0); PG8_BAR; PG8_MMA(0, 0, At, B0); PG8_MMA(0, 1, At, B1); PG8_BAR; PG8_SCHED;
            PG8_LDA(At, 1, 1); PG8_STAGE(PG8_SB(1, 0), b3, voffB); PG8_STAGE(PG8_SB(1, 1), b3 + hstep, voffB); PG8_STAGE(PG8_SA(1, 0), a3, voffA);
            PG8_WAIT_V(8); PG8_WAIT_L(0); PG8_BAR; PG8_MMA(1, 0, At, B0); PG8_MMA(1, 1, At, B1); PG8_BAR; PG8_SCHED;
            } else {
            PG8_LDB(B0, 0, 0); PG8_SCHED; PG8_LDA(At, 0, 0); PG8_STAGE(PG8_SA(1, 1), a1 + hstep, voffA);
            PG8_WAIT_L(8); PG8_BAR; PG8_WAIT_L(0); PG8_MMA(0, 0, At, B0); PG8_BAR; PG8_SCHED;
            PG8_LDB(B1, 0, 1); PG8_STAGE(PG8_SB(0, 0), b2, voffB);
            PG8_BAR; PG8_WAIT_L(0); PG8_MMA(0, 1, At, B1); PG8_BAR;
            PG8_LDA(At, 0, 1); PG8_STAGE(PG8_SA(0, 0), a2, voffA);
            PG8_BAR; PG8_WAIT_L(0); PG8_MMA(1, 0, At, B0); PG8_BAR; PG8_SCHED;
            PG8_STAGE(PG8_SB(0, 1), b2 + hstep, voffB);
            PG8_WAIT_V(6); PG8_BAR; PG8_MMA(1, 1, At, B1); PG8_BAR;
            PG8_LDB(B0, 1, 0); PG8_SCHED; PG8_LDA(At, 1, 0); PG8_STAGE(PG8_SA(0, 1), a2 + hstep, voffA);
            PG8_WAIT_L(8); PG8_BAR; PG8_WAIT_L(0); PG8_MMA(0, 0, At, B0); PG8_BAR; PG8_SCHED;
            PG8_LDB(B1, 1, 1); PG8_STAGE(PG8_SB(1, 0), b3, voffB);
            PG8_BAR; PG8_WAIT_L(0); PG8_MMA(0, 1, At, B1); PG8_BAR;
            PG8_LDA(At, 1, 1); PG8_STAGE(PG8_SA(1, 0), a3, voffA);
            PG8_BAR; PG8_WAIT_L(0); PG8_MMA(1, 0, At, B0); PG8_BAR; PG8_SCHED;
            PG8_STAGE(PG8_SB(1, 1), b3 + hstep, voffB);
            PG8_WAIT_V(6); PG8_BAR; PG8_MMA(1, 1, At, B1); PG8_BAR;
            }
        }
        if constexpr (ALIGN_EPI) { if (wr == 0) PG8_BAR; }
        if constexpr (!Epi::AFTER_DRAIN) { E(acc, cur, wr, wc, fr, fq); S.done(cur); }
        if (!has_next) break;
#pragma unroll
        for (int a = 0; a < 2; ++a)
#pragma unroll
            for (int b = 0; b < 2; ++b)
#pragma unroll
                for (int m = 0; m < 4; ++m)
#pragma unroll
                    for (int n = 0; n < 2; ++n) acc[a][b][m][n] = (f32x4){0.f, 0.f, 0.f, 0.f};
        cur = nxt; cA = nA; cB = nB; ++ui;
        if constexpr (ALIGN_EPI) { if (wr == 1) PG8_BAR; }
    }
    PG8_WAIT_V(0);
    if constexpr (!ALIGN_EPI) { if (wr == 0) PG8_BAR; }
    PG8_BAR;
    if constexpr (Epi::AFTER_DRAIN) { E.fused(acc, cur, wr, wc, fr, fq, lds, wid, lane); S.done(cur); }
#undef PG8_SA
#undef PG8_SB
#undef PG8_STAGE
#undef PG8_LDA
#undef PG8_LDB
#undef PG8_MMA
#undef PG8_WAIT_V
#undef PG8_WAIT_L
#undef PG8_BAR
#undef PG8_SCHED
}
}

constexpr int NWAVES = 8;
constexpr int D = 1024, FF = 4096, NROW = 20480, NPR = 4096;
constexpr int NPAD = 3840;
constexpr int C_QA = 0, C_KA = 512, C_VA = 1024, C_GA = 1536, C_QB = 2048, C_KB = 2304, C_VB = 2560, C_GB = 3072, C_AL = 3584, C_BE = 3592;
constexpr int NMODV = 5, MODW = 6144;
constexpr float ALPHA_DN = 1.189207115002721f;
constexpr size_t MiB = 1u << 20;
constexpr size_t WS_CTL = 0, CTL_ZERO_BYTES = 1 * MiB;
constexpr size_t CTL_MOD_OFF = 65536;
constexpr int CW_BAR = 4096;
constexpr int LDS_BYTES = 147456;
constexpr int LDSCTL_OFF = 131072, MISC_OFF = LDSCTL_OFF + 320;
constexpr size_t WS_WIN = 1 * MiB, WS_WO = 9 * MiB, WS_W1 = 11 * MiB, WS_W2 = 19 * MiB;
constexpr size_t WS_H = 27 * MiB;
constexpr size_t WS_P = 67 * MiB;
constexpr size_t WS_GB = 228 * MiB;
constexpr size_t WS_RB = 230 * MiB;
constexpr size_t WS_END = 250 * MiB;
constexpr size_t OUT_Y = (size_t)NROW * D, OUT_SD = OUT_Y, OUT_SR = OUT_SD + (size_t)16 * 2 * 4 * 128 * 128;

#define LAS __attribute__((address_space(3)))
typedef unsigned short bf16;
typedef unsigned v4u __attribute__((ext_vector_type(4)));
typedef unsigned v2u __attribute__((ext_vector_type(2)));
typedef float f32x4 __attribute__((ext_vector_type(4)));
#define LDS_WAIT() asm volatile("s_waitcnt lgkmcnt(0)" ::: "memory")
__device__ __forceinline__ unsigned f2bf(float f) { unsigned u = __builtin_bit_cast(unsigned, f); return (u + 0x7fffu + ((u >> 16) & 1u)) >> 16; }
__device__ __forceinline__ unsigned pk2(float lo, float hi) { return f2bf(lo) | (f2bf(hi) << 16); }
__device__ __forceinline__ float bf2f(unsigned short h) { return __builtin_bit_cast(float, (unsigned)h << 16); }
__device__ __forceinline__ float bflo(unsigned w) { return __builtin_bit_cast(float, w << 16); }
__device__ __forceinline__ float bfhi(unsigned w) { return __builtin_bit_cast(float, w & 0xffff0000u); }
__device__ __forceinline__ float wave_sum(float v) {
#pragma unroll
    for (int o = 1; o < 64; o <<= 1) v += __shfl_xor(v, o);
    return v;
}
__device__ __forceinline__ float g16_sum(float v) {
#pragma unroll
    for (int o = 1; o < 16; o <<= 1) v += __shfl_xor(v, o);
    return v;
}
__device__ __forceinline__ float silu_f(float x) { return x / (1.f + __expf(-x)); }

struct Args {
    const float *x_prompt, *x_sample, *c, *state_delta, *state_ret, *c_ctx, *w_mod, *b_mod, *w_in, *conv_w, *a_log, *dt_bias, *norm_a_w, *gn_w, *gn_b, *w_o,
                *ln1_w, *ln1_b, *w_ff1, *b_ff1, *w_ff2, *b_ff2, *ln2_w, *ln2_b;
    float* out; unsigned char* ws; int ph_lo, ph_hi;
};
struct Frame { LAS unsigned char* lds; int tid, lane, wave, gw, NGW; };

__device__ __forceinline__ const float* xrow_ptr(const Args& a, int r) { return r < NPR ? a.x_prompt + (size_t)r * D : a.x_sample + (size_t)(r - NPR) * D; }
__device__ __forceinline__ int vrow_of(int r) { return r < NPR ? 0 : 1 + ((r - NPR) >> 12); }

__device__ __forceinline__ int map_in(int nd) { return nd < 2048 ? nd : (nd < 3584 ? nd + 16 : (nd < 3600 ? nd - 3584 + 2048 : -1)); }
template <bool MAP> __device__ __forceinline__ void transpose_item(const float* W, int K, int N, int nblk, bf16* WT, LAS float* scr, int item, int lane) {
    const int kb = item / nblk, nb = item % nblk, k0 = 64 * kb, n0 = 32 * nb;
    const int nd = n0 + (lane & 31), ns = MAP ? map_in(nd) : nd;
#pragma unroll 8
    for (int i = 0; i < 32; ++i) { const int kk = 2 * i + (lane >> 5); scr[kk * 33 + (lane & 31)] = ns >= 0 ? W[(size_t)(k0 + kk) * N + ns] : 0.f; }
    LDS_WAIT(); asm volatile("" ::: "memory");
    const int c = lane & 7;
#pragma unroll
    for (int j = 0; j < 4; ++j) { const int n = (lane >> 3) + 8 * j; const LAS float* s = scr + (8 * c) * 33 + n;
        v4u o; o.x = pk2(s[0 * 33], s[1 * 33]); o.y = pk2(s[2 * 33], s[3 * 33]); o.z = pk2(s[4 * 33], s[5 * 33]); o.w = pk2(s[6 * 33], s[7 * 33]);
        *(v4u*)(WT + (size_t)(n0 + n) * K + k0 + 8 * c) = o; }
    LDS_WAIT(); asm volatile("" ::: "memory");
}
__device__ __forceinline__ void p0_prologue(const Args& a, Frame& F) {
    LAS float* scr = (LAS float*)(F.lds + F.wave * 16384);
    bf16* Win_t = (bf16*)(a.ws + WS_WIN); bf16* Wo_t = (bf16*)(a.ws + WS_WO); bf16* W1_t = (bf16*)(a.ws + WS_W1); bf16* W2_t = (bf16*)(a.ws + WS_W2);
    constexpr int I_IN = (D / 64) * (NPAD / 32), I_O = (D / 64) * (D / 32), I_1 = (D / 64) * (FF / 32), I_2 = (FF / 64) * (D / 32);
    constexpr int I_MOD = 96 * 8;
    constexpr int NITEMS = I_MOD + I_IN + I_O + I_1 + I_2;
    float* mod = (float*)(a.ws + WS_CTL + CTL_MOD_OFF);
    for (int it = F.gw; it < NITEMS; it += F.NGW) {
        int r = it;
        if (r < I_MOD) {
            const int cg = r % 96, ks = r / 96, e = cg * 64 + F.lane;
            float acc[NMODV];
#pragma unroll
            for (int v = 0; v < NMODV; ++v) acc[v] = 0.f;
            for (int dd = 0; dd < 128; ++dd) { const int d = ks * 128 + dd; const float wv = a.w_mod[(size_t)d * MODW + e];
#pragma unroll
                for (int v = 0; v < NMODV; ++v) { const float cv = v == 0 ? a.c_ctx[d] : a.c[(v - 1) * D + d]; acc[v] += silu_f(cv) * wv; } }
            const float bb = ks == 0 ? a.b_mod[e] : 0.f;
#pragma unroll
            for (int v = 0; v < NMODV; ++v) atomicAdd(mod + v * MODW + e, acc[v] + bb);
            continue; }
        r -= I_MOD;
        if (r < I_IN) { transpose_item<true>(a.w_in, D, 3600, NPAD / 32, Win_t, scr, r, F.lane); continue; } r -= I_IN;
        if (r < I_O) { transpose_item<false>(a.w_o, D, D, D / 32, Wo_t, scr, r, F.lane); continue; } r -= I_O;
        if (r < I_1) { transpose_item<false>(a.w_ff1, D, FF, FF / 32, W1_t, scr, r, F.lane); continue; } r -= I_1;
        transpose_item<false>(a.w_ff2, FF, D, D / 32, W2_t, scr, r, F.lane);
    }
}

__device__ __forceinline__ void ln_stats(const f32x4 (&v)[4], float eps, float& mean, float& rstd) {
    float s = 0.f;
#pragma unroll
    for (int j = 0; j < 4; ++j) s += (v[j].x + v[j].y) + (v[j].z + v[j].w);
    mean = wave_sum(s) * (1.f / D); float s2 = 0.f;
#pragma unroll
    for (int j = 0; j < 4; ++j) { const f32x4 d = v[j] - mean; s2 += (d.x * d.x + d.y * d.y) + (d.z * d.z + d.w * d.w); }
    rstd = 1.f / sqrtf(wave_sum(s2) * (1.f / D) + eps);
}
__device__ __forceinline__ void p1_h(const Args& a, Frame& F) {
    const float* mod = (const float*)(a.ws + WS_CTL + CTL_MOD_OFF); bf16* H = (bf16*)(a.ws + WS_H);
    for (int r = F.gw; r < NROW; r += F.NGW) {
        const f32x4* xr = (const f32x4*)xrow_ptr(a, r) + F.lane; const float* mv = mod + (size_t)vrow_of(r) * MODW;
        f32x4 v[4];
#pragma unroll
        for (int j = 0; j < 4; ++j) v[j] = xr[64 * j];
        float mean, rstd; ln_stats(v, 1e-6f, mean, rstd);
        unsigned long long* o8 = (unsigned long long*)(H + (size_t)r * D) + F.lane;
#pragma unroll
        for (int j = 0; j < 4; ++j) { const f32x4 sh = *((const f32x4*)mv + F.lane + 64 * j), sc = *((const f32x4*)(mv + 1024) + F.lane + 64 * j);
            const f32x4 h = (v[j] - mean) * rstd * (sc + 1.f) + sh;
            o8[64 * j] = (unsigned long long)pk2(h.x, h.y) | ((unsigned long long)pk2(h.z, h.w) << 32); }
    }
}
#define XB_TMO      128
#define XB_XCNT(j)  (256  + 64 * (j))
#define XB_XSUB(j)  (1280 + 64 * (j))
#define XB_XGEN(j)  (2304 + 64 * (j))
#define XB_TOP      3328
#define XB_TOPGEN   3392
#define XCD_BAR_WORDS 3456
#define XB_SPIN_CAP (1u << 22)

__device__ __forceinline__ unsigned xb_ld(unsigned* p)              { return __hip_atomic_load(p, __ATOMIC_RELAXED, __HIP_MEMORY_SCOPE_AGENT); }
__device__ __forceinline__ unsigned xb_add(unsigned* p, unsigned v) { return __hip_atomic_fetch_add(p, v, __ATOMIC_RELAXED, __HIP_MEMORY_SCOPE_AGENT); }
__device__ __forceinline__ unsigned xb_xcc_id() { return (unsigned)__builtin_amdgcn_s_getreg((3 << 11) | 20) & 0xFu; }
#define XB_SPIN(cond, bar) do { unsigned _sp = 0; while (cond) { __builtin_amdgcn_s_sleep(1); \
    if ((++_sp & 255u) == 0u) { if (xb_ld(&(bar)[XB_TMO])) break; if (_sp > XB_SPIN_CAP) { atomicAdd(&(bar)[XB_TMO], 1u); break; } } } } while (0)

struct XcdBarrier {
    unsigned* bar; unsigned x;
    volatile LAS unsigned* st;
};

__device__ __forceinline__ XcdBarrier xcd_barrier_post(unsigned* bar, volatile LAS unsigned* st) {
    XcdBarrier b; b.bar = bar; b.x = xb_xcc_id(); b.st = st;
    if (threadIdx.x == 0) (void)xb_add(&bar[XB_XCNT(b.x)], 1u);
    return b;
}
__device__ __forceinline__ void xcd_barrier_complete(unsigned* bar, unsigned x, unsigned& nloc, unsigned& nx) {
    const unsigned G = gridDim.x * gridDim.y * gridDim.z;
    unsigned sum, cnt, mine, sp = 0u;
    for (;;) {
        sum = 0u; cnt = 0u; mine = 0u;
#pragma unroll
        for (unsigned j = 0; j < 16; ++j) { const unsigned c = xb_ld(&bar[XB_XCNT(j)]); sum += c; cnt += (c > 0u) ? 1u : 0u; mine = (j == x) ? c : mine; }
        if (sum == G) break;
        __builtin_amdgcn_s_sleep(1);
        if ((++sp & 255u) == 0u) { if (xb_ld(&bar[XB_TMO])) break; if (sp > XB_SPIN_CAP) { atomicAdd(&bar[XB_TMO], 1u); break; } }
    }
    nloc = mine > 0u ? mine : 1u; nx = cnt > 0u ? cnt : 1u;
}

__device__ __forceinline__ void xcd_barrier(const XcdBarrier& b) {
    asm volatile("s_waitcnt vmcnt(0)" ::: "memory");
    __syncthreads();
    if (threadIdx.x == 0) {
        unsigned* bar = b.bar;
        __builtin_amdgcn_s_waitcnt(0);
        unsigned nloc = b.st[0], nx = b.st[1];
        if (nloc == 0u) { xcd_barrier_complete(bar, b.x, nloc, nx); b.st[0] = nloc; b.st[1] = nx; }
        const unsigned old = xb_add(&bar[XB_XSUB(b.x)], 1u);
        const unsigned gen = old / nloc;
        if (old + 1u == (gen + 1u) * nloc) {
            __builtin_amdgcn_fence(__ATOMIC_RELEASE, "agent");
            asm volatile("s_waitcnt vmcnt(0)" ::: "memory");
            const unsigned og = xb_add(&bar[XB_TOP], 1u);
            const unsigned tg = og / nx;
            if (og + 1u == (tg + 1u) * nx) xb_add(&bar[XB_TOPGEN], 1u);
            else XB_SPIN(xb_ld(&bar[XB_TOPGEN]) == tg, bar);
            __builtin_amdgcn_fence(__ATOMIC_ACQUIRE, "agent");
            xb_add(&bar[XB_XGEN(b.x)], 1u);
            asm volatile("s_waitcnt vmcnt(0)" ::: "memory");
        } else {
            XB_SPIN(xb_ld(&bar[XB_XGEN(b.x)]) == gen, bar);
            __builtin_amdgcn_fence(__ATOMIC_ACQUIRE, "agent");
            asm volatile("s_waitcnt vmcnt(0)" ::: "memory");
        }
    }
    __syncthreads();
}
__device__ __forceinline__ void seq_of_row(int r, int& base, int& T, int& t) { if (r < NPR) { base = r & ~255; T = 256; t = r & 255; } else { const int q = r - NPR; base = NPR + (q & ~4095); T = 4096; t = q & 4095; } }
__device__ __forceinline__ void unpack8(const v4u w, float (&f)[8]) { f[0] = bflo(w.x); f[1] = bfhi(w.x); f[2] = bflo(w.y); f[3] = bfhi(w.y); f[4] = bflo(w.z); f[5] = bfhi(w.z); f[6] = bflo(w.w); f[7] = bfhi(w.w); }
__device__ __forceinline__ v4u pack8(const float (&f)[8]) { v4u w; w.x = pk2(f[0], f[1]); w.y = pk2(f[2], f[3]); w.z = pk2(f[4], f[5]); w.w = pk2(f[6], f[7]); return w; }

__device__ __forceinline__ void p3a_prep(const Args& a, Frame& F) {
    bf16* P = (bf16*)(a.ws + WS_P); bf16* QKVC = (bf16*)a.out; float* GB = (float*)(a.ws + WS_GB);
    const int l = F.lane;
    for (int r = F.gw; r < NROW; r += F.NGW) {
        int base, T, t; seq_of_row(r, base, T, t);
        float acc[3][8];
#pragma unroll
        for (int s = 0; s < 3; ++s)
#pragma unroll
            for (int i = 0; i < 8; ++i) acc[s][i] = 0.f;
#pragma unroll
        for (int kk = 0; kk < 5; ++kk) { const int tt = t + kk - 2;
            if (tt >= 0 && tt < T) { const bf16* rp = P + (size_t)(base + tt) * NPAD;
#pragma unroll
                for (int s = 0; s < 3; ++s) { float xv[8]; unpack8(*(const v4u*)(rp + 512 * s + 8 * l), xv);
                    const f32x4 w0 = *(const f32x4*)(a.conv_w + kk * 1536 + 512 * s + 8 * l), w1 = *(const f32x4*)(a.conv_w + kk * 1536 + 512 * s + 8 * l + 4);
                    acc[s][0] += xv[0] * w0.x; acc[s][1] += xv[1] * w0.y; acc[s][2] += xv[2] * w0.z; acc[s][3] += xv[3] * w0.w;
                    acc[s][4] += xv[4] * w1.x; acc[s][5] += xv[5] * w1.y; acc[s][6] += xv[6] * w1.z; acc[s][7] += xv[7] * w1.w; } } }
#pragma unroll
        for (int s = 0; s < 3; ++s)
#pragma unroll
            for (int i = 0; i < 8; ++i) acc[s][i] = silu_f(acc[s][i]);
#pragma unroll
        for (int s = 0; s < 2; ++s) { float ss = 0.f;
#pragma unroll
            for (int i = 0; i < 8; ++i) ss += acc[s][i] * acc[s][i];
            ss = g16_sum(ss); const float sc = (1.f / sqrtf(ss + 1e-6f)) * (s == 0 ? 0.08838834764831845f : 1.f);
#pragma unroll
            for (int i = 0; i < 8; ++i) acc[s][i] *= sc; }
        bf16* op = QKVC + (size_t)r * 1536;
#pragma unroll
        for (int s = 0; s < 3; ++s) *(v4u*)(op + 512 * s + 8 * l) = pack8(acc[s]);
        { bf16* rp = P + (size_t)r * NPAD; const int hb = l >> 4, j0 = 2 * (l & 15);
          unsigned* q1p = (unsigned*)(rp + C_QB + 64 * hb + j0); unsigned* q2p = (unsigned*)(rp + C_QB + 64 * hb + 32 + j0);
          unsigned* k1p = (unsigned*)(rp + C_KB + 64 * hb + j0); unsigned* k2p = (unsigned*)(rp + C_KB + 64 * hb + 32 + j0);
          const unsigned q1 = *q1p, q2 = *q2p, k1 = *k1p, k2 = *k2p;
          float c0 = 1.f, s0 = 0.f, c1 = 1.f, s1 = 0.f;
          if (r >= NPR) { const float pos = (j0 < 16) ? (float)(t >> 6) : (float)(t & 63); const int f0 = j0 & 15;
              const float inv0 = powf(10000.f, -(float)f0 / 16.f), inv1 = powf(10000.f, -(float)(f0 + 1) / 16.f);
              sincosf(pos * inv0, &s0, &c0); sincosf(pos * inv1, &s1, &c1); }
          const float qa0 = bflo(q1) * 0.125f, qa1 = bfhi(q1) * 0.125f, qb0 = bflo(q2) * 0.125f, qb1 = bfhi(q2) * 0.125f;
          const float ka0 = bflo(k1), ka1 = bfhi(k1), kb0 = bflo(k2), kb1 = bfhi(k2);
          *q1p = pk2(qa0 * c0 - qb0 * s0, qa1 * c1 - qb1 * s1); *q2p = pk2(qa0 * s0 + qb0 * c0, qa1 * s1 + qb1 * c1);
          *k1p = pk2(ka0 * c0 - kb0 * s0, ka1 * c1 - kb1 * s1); *k2p = pk2(ka0 * s0 + kb0 * c0, ka1 * s1 + kb1 * c1); }
        if (l < 16) { const float raw = bf2f(P[(size_t)r * NPAD + C_AL + l]); float o;
            if (l < 8) { const float z = raw + a.dt_bias[l]; const float sp = z > 20.f ? z : log1pf(expf(z)); o = -expf(a.a_log[l]) * sp; }
            else o = 1.f / (1.f + expf(-raw));
            GB[(size_t)r * 16 + l] = o; }
    }
}

__device__ __forceinline__ void p3b_delta_naive(const Args& a, Frame& F) {
    const bf16* QKVC = (const bf16*)a.out; const float* GB = (const float*)(a.ws + WS_GB); bf16* P = (bf16*)(a.ws + WS_P);
    const int l = F.lane;
    for (int it = F.gw; it < 5120; it += F.NGW) {
        const bool smp = it < 1024; const int q = smp ? it : it - 1024;
        const int cg = q & 31, dir = (q >> 5) & 1, h = (q >> 6) & 3, sq = q >> 8;
        const int T = smp ? 4096 : 256, base = smp ? NPR + sq * 4096 : sq * 256, e0 = cg * 4;
        float s0[4], s1[4];
        if (smp) { const float* S0 = a.state_delta + ((size_t)(sq * 2 + dir) * 4 + h) * 128 * 128;
#pragma unroll
            for (int c = 0; c < 4; ++c) { s0[c] = S0[(size_t)l * 128 + e0 + c]; s1[c] = S0[(size_t)(l + 64) * 128 + e0 + c]; } }
        else {
#pragma unroll
            for (int c = 0; c < 4; ++c) { s0[c] = 0.f; s1[c] = 0.f; } }
        int row = base + (dir ? T - 1 : 0);
        const bf16* rp = QKVC + (size_t)row * 1536 + h * 128;
        unsigned short nq0 = rp[l], nq1 = rp[64 + l], nk0 = rp[512 + l], nk1 = rp[512 + 64 + l]; v2u nv = *(const v2u*)(rp + 1024 + e0);
        float ng = GB[(size_t)row * 16 + dir * 4 + h], nb = GB[(size_t)row * 16 + 8 + dir * 4 + h];
        for (int step = 0; step < T; ++step) {
            const float q0 = bf2f(nq0), q1 = bf2f(nq1), k0 = bf2f(nk0), k1 = bf2f(nk1), g = ng, b = nb; const v2u vv = nv; const int crow = row;
            if (step + 1 < T) { row = base + (dir ? T - 2 - step : step + 1); rp = QKVC + (size_t)row * 1536 + h * 128;
                nq0 = rp[l]; nq1 = rp[64 + l]; nk0 = rp[512 + l]; nk1 = rp[512 + 64 + l]; nv = *(const v2u*)(rp + 1024 + e0);
                ng = GB[(size_t)row * 16 + dir * 4 + h]; nb = GB[(size_t)row * 16 + 8 + dir * 4 + h]; }
            const float al = __expf(g);
            const float v4[4] = {bflo(vv.x), bfhi(vv.x), bflo(vv.y), bfhi(vv.y)};
            float dt[4], o[4];
#pragma unroll
            for (int c = 0; c < 4; ++c) dt[c] = k0 * s0[c] + k1 * s1[c];
#pragma unroll
            for (int c = 0; c < 4; ++c) dt[c] = wave_sum(dt[c]);
#pragma unroll
            for (int c = 0; c < 4; ++c) { const float cf = b * (v4[c] - al * dt[c]); s0[c] = al * s0[c] + cf * k0; s1[c] = al * s1[c] + cf * k1; o[c] = q0 * s0[c] + q1 * s1[c]; }
#pragma unroll
            for (int c = 0; c < 4; ++c) o[c] = wave_sum(o[c]);
            if (l == 0) { v2u w; w.x = pk2(o[0], o[1]); w.y = pk2(o[2], o[3]); *(v2u*)(P + (size_t)crow * NPAD + dir * 512 + h * 128 + e0) = w; }
        }
        if (!smp) { float* So = a.out + OUT_SD + ((size_t)(sq * 2 + dir) * 4 + h) * 128 * 128;
#pragma unroll
            for (int c = 0; c < 4; ++c) { So[(size_t)l * 128 + e0 + c] = s0[c]; So[(size_t)(l + 64) * 128 + e0 + c] = s1[c]; } }
    }
}

__device__ __forceinline__ void p3c_ret_naive(const Args& a, Frame& F) {
    const bf16* P = (const bf16*)(a.ws + WS_P); bf16* RF = (bf16*)a.out + (size_t)NROW * 1536; bf16* RB = (bf16*)(a.ws + WS_RB);
    const int l = F.lane;
    for (int it = F.gw; it < 5120; it += F.NGW) {
        const bool smp = it < 1024; const int q = smp ? it : it - 1024;
        const int cg = q & 31, dir = (q >> 5) & 1, h = (q >> 6) & 3, sq = q >> 8;
        const int T = smp ? 4096 : 256, base = smp ? NPR + sq * 4096 : sq * 256, e0 = cg * 4;
        const int hg = dir ? 3 - h : h; const float gam = 1.f - exp2f(-5.f - (float)hg);
        float s[4];
        if (smp) { const float* S0 = a.state_ret + ((size_t)(sq * 2 + dir) * 4 + h) * 64 * 128;
#pragma unroll
            for (int c = 0; c < 4; ++c) s[c] = S0[(size_t)l * 128 + e0 + c]; }
        else {
#pragma unroll
            for (int c = 0; c < 4; ++c) s[c] = 0.f; }
        bf16* R = dir ? RB : RF;
        int row = base + (dir ? T - 1 : 0);
        const bf16* rp = P + (size_t)row * NPAD;
        unsigned short nq = rp[C_QB + 64 * h + l], nk = rp[C_KB + 64 * h + l]; v2u nv = *(const v2u*)(rp + C_VB + 128 * h + e0);
        for (int step = 0; step < T; ++step) {
            const float qv = bf2f(nq), kv = bf2f(nk); const v2u vv = nv; const int crow = row;
            if (step + 1 < T) { row = base + (dir ? T - 2 - step : step + 1); rp = P + (size_t)row * NPAD;
                nq = rp[C_QB + 64 * h + l]; nk = rp[C_KB + 64 * h + l]; nv = *(const v2u*)(rp + C_VB + 128 * h + e0); }
            const float v4[4] = {bflo(vv.x), bfhi(vv.x), bflo(vv.y), bfhi(vv.y)};
            float o[4];
#pragma unroll
            for (int c = 0; c < 4; ++c) { s[c] = gam * s[c] + kv * v4[c]; o[c] = qv * s[c]; }
#pragma unroll
            for (int c = 0; c < 4; ++c) o[c] = wave_sum(o[c]);
            if (l == 0) { v2u w; w.x = pk2(o[0], o[1]); w.y = pk2(o[2], o[3]); *(v2u*)(R + (size_t)crow * 512 + h * 128 + e0) = w; }
        }
        if (!smp) { float* So = a.out + OUT_SR + ((size_t)(sq * 2 + dir) * 4 + h) * 64 * 128;
#pragma unroll
            for (int c = 0; c < 4; ++c) So[(size_t)l * 128 + e0 + c] = s[c]; }
    }
}

__device__ __forceinline__ void p5_combine(const Args& a, Frame& F) {
    const bf16* P = (const bf16*)(a.ws + WS_P); const bf16* RF = (const bf16*)a.out + (size_t)NROW * 1536; const bf16* RB = (const bf16*)(a.ws + WS_RB);
    bf16* MIX = (bf16*)(a.ws + WS_H); const int l = F.lane;
    for (int r = F.gw; r < NROW; r += F.NGW) {
        const bf16* rp = P + (size_t)r * NPAD;
        float x0[8], x1[8], gt[8], o[8];
        unpack8(*(const v4u*)(rp + 8 * l), x0); unpack8(*(const v4u*)(rp + 512 + 8 * l), x1); unpack8(*(const v4u*)(rp + C_GA + 8 * l), gt);
        float ss = 0.f;
#pragma unroll
        for (int i = 0; i < 8; ++i) { x0[i] += x1[i]; ss += x0[i] * x0[i]; }
        ss = g16_sum(ss); const float rs = 1.f / sqrtf(ss * (1.f / 128.f) + 1e-6f);
#pragma unroll
        for (int i = 0; i < 8; ++i) o[i] = x0[i] * rs * a.norm_a_w[(8 * l + i) & 127] * silu_f(gt[i]);
        *(v4u*)(MIX + (size_t)r * D + 8 * l) = pack8(o);
        unpack8(*(const v4u*)(RF + (size_t)r * 512 + 8 * l), x0); unpack8(*(const v4u*)(RB + (size_t)r * 512 + 8 * l), x1); unpack8(*(const v4u*)(rp + C_GB + 8 * l), gt);
        float sm = 0.f;
#pragma unroll
        for (int i = 0; i < 8; ++i) { x0[i] += x1[i]; sm += x0[i]; }
        const float mean = g16_sum(sm) * (1.f / 128.f); float sv = 0.f;
#pragma unroll
        for (int i = 0; i < 8; ++i) { x0[i] -= mean; sv += x0[i] * x0[i]; }
        const float rstd = 1.f / sqrtf(g16_sum(sv) * (1.f / 128.f) + 1e-5f);
#pragma unroll
        for (int i = 0; i < 8; ++i) o[i] = (x0[i] * rstd * a.gn_w[8 * l + i] + a.gn_b[8 * l + i]) * silu_f(gt[i]);
        *(v4u*)(MIX + (size_t)r * D + 512 + 8 * l) = pack8(o);
    }
}

__device__ __forceinline__ void p6b_ln1(const Args& a, Frame& F) {
    const float* mod = (const float*)(a.ws + WS_CTL + CTL_MOD_OFF); bf16* H2 = (bf16*)(a.ws + WS_H);
    for (int r = F.gw; r < NROW; r += F.NGW) {
        f32x4* zr = (f32x4*)(a.out + (size_t)r * D) + F.lane; const float* mv = mod + (size_t)vrow_of(r) * MODW;
        f32x4 v[4];
#pragma unroll
        for (int j = 0; j < 4; ++j) v[j] = zr[64 * j];
        float mean, rstd; ln_stats(v, 1e-6f, mean, rstd);
#pragma unroll
        for (int j = 0; j < 4; ++j) { const f32x4 w = *((const f32x4*)a.ln1_w + F.lane + 64 * j), b = *((const f32x4*)a.ln1_b + F.lane + 64 * j);
            v[j] = (v[j] - mean) * rstd * w + b; zr[64 * j] = v[j]; }
        ln_stats(v, 1e-6f, mean, rstd);
        unsigned long long* o8 = (unsigned long long*)(H2 + (size_t)r * D) + F.lane;
#pragma unroll
        for (int j = 0; j < 4; ++j) { const f32x4 sh = *((const f32x4*)(mv + 3072) + F.lane + 64 * j), sc = *((const f32x4*)(mv + 4096) + F.lane + 64 * j);
            const f32x4 h = (v[j] - mean) * rstd * (sc + 1.f) + sh;
            o8[64 * j] = (unsigned long long)pk2(h.x, h.y) | ((unsigned long long)pk2(h.z, h.w) << 32); }
    }
}
__device__ __forceinline__ void p8b_ln2(const Args& a, Frame& F) {
    for (int r = F.gw; r < NROW; r += F.NGW) {
        f32x4* zr = (f32x4*)(a.out + (size_t)r * D) + F.lane;
        f32x4 v[4];
#pragma unroll
        for (int j = 0; j < 4; ++j) v[j] = zr[64 * j];
        float mean, rstd; ln_stats(v, 1e-6f, mean, rstd);
#pragma unroll
        for (int j = 0; j < 4; ++j) { const f32x4 w = *((const f32x4*)a.ln2_w + F.lane + 64 * j), b = *((const f32x4*)a.ln2_b + F.lane + 64 * j);
            zr[64 * j] = (v[j] - mean) * rstd * w + b; }
    }
}

constexpr int N_PHASES = 12;
#ifndef N_LAUNCHES
#define N_LAUNCHES 1
#endif
__global__ void __launch_bounds__(NWAVES * 64, 2) fwd(Args a) {
    extern __shared__ __attribute__((aligned(16))) unsigned char lds[];
    Frame F; F.lds = (LAS unsigned char*)lds; F.tid = threadIdx.x; F.lane = F.tid & 63; F.wave = __builtin_amdgcn_readfirstlane(F.tid >> 6);
    F.gw = blockIdx.x * NWAVES + F.wave; F.NGW = gridDim.x * NWAVES;
    const int lo = a.ph_lo, hi = a.ph_hi;
    const float* mod = (const float*)(a.ws + WS_CTL + CTL_MOD_OFF);
    volatile LAS unsigned* MISC = (volatile LAS unsigned*)(F.lds + MISC_OFF);
    for (int u = F.tid; u < (LDS_BYTES - LDSCTL_OFF) / 4; u += NWAVES * 64) ((LAS unsigned*)(F.lds + LDSCTL_OFF))[u] = 0u;
    __syncthreads();
    XcdBarrier bar; bar.bar = (unsigned*)(a.ws + WS_CTL) + CW_BAR; bar.x = 0; bar.st = nullptr;
    if (hi - lo > 1) bar = xcd_barrier_post((unsigned*)(a.ws + WS_CTL) + CW_BAR, MISC + 8);
#define IN(k) (lo <= (k) && (k) < hi)
#define SEAM(k) do { if (IN(k) && IN((k) + 1)) xcd_barrier(bar); } while (0)
    if (IN(0)) p0_prologue(a, F);
    SEAM(0);
    if (IN(1)) p1_h(a, F);
    SEAM(1);
    if (IN(2)) { pg8::Gemm g{(const pg8::bf16_t*)(a.ws + WS_H), (const pg8::bf16_t*)(a.ws + WS_WIN), NROW, NPAD, D}; pg8::StaticOrder S; S.init(NROW, NPAD, gridDim.x, (int)blockIdx.x);
        pg8::EpiBf16<0> E{(pg8::bf16_t*)(a.ws + WS_P), NPAD, nullptr};
        pg8::gemm_phase<pg8::EpiBf16<0>, pg8::StaticOrder, true, true>(F.lds, g, S, E); }
    SEAM(2);
    if (IN(3)) p3a_prep(a, F);
    SEAM(3);
    if (IN(4)) p3b_delta_naive(a, F);
    SEAM(4);
    if (IN(5)) p3c_ret_naive(a, F);
    SEAM(5);
    if (IN(6)) p5_combine(a, F);
    SEAM(6);
    if (IN(7)) { pg8::Gemm g{(const pg8::bf16_t*)(a.ws + WS_H), (const pg8::bf16_t*)(a.ws + WS_WO), NROW, D, D}; pg8::StaticOrder S; S.init(NROW, D, gridDim.x, (int)blockIdx.x);
        pg8::EpiResid E{a.x_prompt, a.x_sample - (size_t)NPR * D, a.out, D, nullptr, mod + 2048, MODW, ALPHA_DN};
        pg8::gemm_phase<pg8::EpiResid, pg8::StaticOrder, true, true>(F.lds, g, S, E); }
    SEAM(7);
    if (IN(8)) p6b_ln1(a, F);
    SEAM(8);
    if (IN(9)) { pg8::Gemm g{(const pg8::bf16_t*)(a.ws + WS_H), (const pg8::bf16_t*)(a.ws + WS_W1), NROW, FF, D}; pg8::StaticOrder S; S.init(NROW, FF, gridDim.x, (int)blockIdx.x);
        pg8::EpiBf16<2> E{(pg8::bf16_t*)(a.ws + WS_P), FF, a.b_ff1};
        pg8::gemm_phase<pg8::EpiBf16<2>, pg8::StaticOrder, true, true>(F.lds, g, S, E); }
    SEAM(9);
    if (IN(10)) { pg8::Gemm g{(const pg8::bf16_t*)(a.ws + WS_P), (const pg8::bf16_t*)(a.ws + WS_W2), NROW, D, FF}; pg8::StaticOrder S; S.init(NROW, D, gridDim.x, (int)blockIdx.x);
        pg8::EpiResid E{a.out, a.out, a.out, D, a.b_ff2, mod + 5120, MODW, ALPHA_DN};
        pg8::gemm_phase<pg8::EpiResid, pg8::StaticOrder, true, true>(F.lds, g, S, E); }
    SEAM(10);
    if (IN(11)) p8b_ln2(a, F);
#undef IN
#undef SEAM
}

extern "C" void kernel_launch(void* const* d_in, const int* in_sizes, int n_in, void* d_out, int out_size, void* d_ws, size_t ws_size, hipStream_t stream) {
    static int grid = 0;
    if (grid == 0) {
        if (n_in != 24 || ws_size < WS_END || (size_t)out_size != OUT_SR + (size_t)16 * 2 * 4 * 64 * 128) { fprintf(stderr, "kernel_launch: unexpected problem: n_in %d out %d ws %zu\n", n_in, out_size, ws_size); grid = -1; return; }
        int dev = 0, cus = 0, per_cu = 0;
        if (hipGetDevice(&dev) != hipSuccess || hipDeviceGetAttribute(&cus, hipDeviceAttributeMultiprocessorCount, dev) != hipSuccess) { grid = -1; return; }
        if (hipFuncSetAttribute((const void*)fwd, hipFuncAttributeMaxDynamicSharedMemorySize, LDS_BYTES) != hipSuccess) { fprintf(stderr, "kernel_launch: hipFuncSetAttribute failed\n"); grid = -1; return; }
        if (hipOccupancyMaxActiveBlocksPerMultiprocessor(&per_cu, (const void*)fwd, NWAVES * 64, LDS_BYTES) != hipSuccess || per_cu < 1) { fprintf(stderr, "kernel_launch: occupancy query says %d workgroups per CU\n", per_cu); (void)hipGetLastError(); grid = -1; return; }
        grid = cus;
    }
    if (grid < 0) return;
    (void)hipMemsetAsync((char*)d_ws + WS_CTL, 0, CTL_ZERO_BYTES, stream);
    Args a{};
    const float** ap = (const float**)&a;
    for (int i = 0; i < 24; ++i) ap[i] = (const float*)d_in[i];
    a.out = (float*)d_out; a.ws = (unsigned char*)d_ws;
    if (N_LAUNCHES == 1) { a.ph_lo = 0; a.ph_hi = N_PHASES; hipLaunchKernelGGL(fwd, dim3(grid), dim3(NWAVES * 64), LDS_BYTES, stream, a); }
    else for (int p = 0; p < N_PHASES; ++p) { a.ph_lo = p; a.ph_hi = p + 1; hipLaunchKernelGGL(fwd, dim3(grid), dim3(NWAVES * 64), LDS_BYTES, stream, a); }
}
```

```cpp
#include <hip/hip_runtime.h>
#include <cstdio>
#include <cstdint>
namespace pg8 {
#define PG8_LAS __attribute__((address_space(3)))
typedef unsigned short bf16_t;
typedef short bf16x8 __attribute__((ext_vector_type(8)));
typedef float f32x4 __attribute__((ext_vector_type(4)));
typedef unsigned u32x4 __attribute__((ext_vector_type(4)));
constexpr int BM = 256, BK = 64, HALF = 128, HTB = HALF * BK * 2  , STAGE_BYTES = 8 * HTB, NXCD = 8, WGM = 8;

__host__ __device__ __forceinline__ int lds_byte(int r, int c) { const int st = (r >> 4) * 2 + (c >> 5), rr = r & 15, cc = c & 31, ob = rr * 64 + cc * 2; return st * 1024 + (ob ^ (((ob >> 9) & 1) << 5)); }
__host__ __device__ __forceinline__ void stage_rc(int b, int& R, int& C) { const int st = b / 1024, sb = b % 1024, swz = sb ^ (((sb >> 9) & 1) << 5); R = (st >> 1) * 16 + swz / 64; C = (st & 1) * 32 + (swz % 64) / 2; }
__host__ __device__ __forceinline__ int perm32(int rho) { const int n = rho >> 4, i = rho & 15; return 8 * (i >> 2) + 4 * n + (i & 3); }

struct Unit { int pm, pn; };
struct Gemm { const bf16_t* A; const bf16_t* Bt; int M, N, K; };

struct StaticOrder {
    int nM, nN, nwg, G, c;
    __host__ __device__ void init(int M, int N, int G_, int c_) { nM = M / BM; nN = N / BM; nwg = nM * nN; G = G_; c = c_; }
    __host__ __device__ bool next(int i, Unit& u) const {
        const long L = (long)i * G + c; if (L >= nwg) return false;
        int wgid = (int)L; { const int q = nwg / NXCD, r = nwg % NXCD, xcd = wgid % NXCD, off = wgid / NXCD; wgid = (xcd < r ? xcd * (q + 1) : r * (q + 1) + (xcd - r) * q) + off; }
        const int nig = WGM * nN, gid = wgid / nig, fm = gid * WGM, gsz = (nM - fm) < WGM ? (nM - fm) : WGM;
        u.pm = fm + ((wgid % nig) % gsz); u.pn = (wgid % nig) / gsz; return true;
    }
    __device__ __forceinline__ void a_ready(const Unit&) const {}
    __device__ __forceinline__ void done(const Unit&) const {}
};

__device__ __forceinline__ unsigned cvt_pk_bf16(float lo, float hi) { unsigned r; asm volatile("v_cvt_pk_bf16_f32 %0, %1, %2" : "=v"(r) : "v"(lo), "v"(hi)); return r; }
template <int ACT> struct EpiBf16 {
    static constexpr bool PERM = true, AFTER_DRAIN = false;
    bf16_t* O; int ldc; const float* bias;
    __device__ __forceinline__ void operator()(const f32x4 (&acc)[2][2][4][2], const Unit& u, int wr, int wc, int fr, int fq) const {
        const int row0 = u.pm * BM + wr * 64 + fr; const int col0 = u.pn * BM + wc * 32 + 8 * fq;
        f32x4 bv[2][2];
#pragma unroll
        for (int bj = 0; bj < 2; ++bj)
#pragma unroll
            for (int n = 0; n < 2; ++n) bv[bj][n] = bias ? *(const f32x4*)(bias + col0 + bj * HALF + 4 * n) : (f32x4){0.f, 0.f, 0.f, 0.f};
#pragma unroll
        for (int ai = 0; ai < 2; ++ai)
#pragma unroll
            for (int m = 0; m < 4; ++m) { bf16_t* rowp = O + (size_t)(row0 + ai * HALF + m * 16) * ldc + col0;
#pragma unroll
                for (int bj = 0; bj < 2; ++bj) { f32x4 v0 = acc[ai][bj][m][0] + bv[bj][0], v1 = acc[ai][bj][m][1] + bv[bj][1];
                    if (ACT == 2) {
#pragma unroll
                        for (int i = 0; i < 4; ++i) { const float a = v0[i] > 0.f ? v0[i] : 0.f, b = v1[i] > 0.f ? v1[i] : 0.f; v0[i] = a * a; v1[i] = b * b; } }
                    u32x4 w; w.x = cvt_pk_bf16(v0[0], v0[1]); w.y = cvt_pk_bf16(v0[2], v0[3]); w.z = cvt_pk_bf16(v1[0], v1[1]); w.w = cvt_pk_bf16(v1[2], v1[3]);
                    *(u32x4*)(rowp + bj * HALF) = w; } }
    }
};
struct EpiResid {
    static constexpr bool PERM = false, AFTER_DRAIN = false;
    const float* base0; const float* base1; float* out; int ldc; const float* bias; const float* gate; int gate_pitch; float alpha;
    __device__ __forceinline__ void operator()(const f32x4 (&acc)[2][2][4][2], const Unit& u, int wr, int wc, int fr, int fq) const {
        const int row0 = u.pm * BM + wr * 64 + fr; const int col0 = u.pn * BM + wc * 32 + 4 * fq;
        const int r0 = u.pm * BM; const int vrow = r0 < 4096 ? 0 : 1 + ((r0 - 4096) >> 12);
        const float* gp = gate + (size_t)vrow * gate_pitch; const float* base = r0 < 4096 ? base0 : base1;
        f32x4 bv[2][2], gv[2][2];
#pragma unroll
        for (int bj = 0; bj < 2; ++bj)
#pragma unroll
            for (int n = 0; n < 2; ++n) { bv[bj][n] = bias ? *(const f32x4*)(bias + col0 + bj * HALF + n * 16) : (f32x4){0.f, 0.f, 0.f, 0.f}; gv[bj][n] = *(const f32x4*)(gp + col0 + bj * HALF + n * 16); }
#pragma unroll
        for (int ai = 0; ai < 2; ++ai)
#pragma unroll
            for (int m = 0; m < 4; ++m) { const size_t off = (size_t)(row0 + ai * HALF + m * 16) * ldc + col0;
#pragma unroll
                for (int bj = 0; bj < 2; ++bj)
#pragma unroll
                    for (int n = 0; n < 2; ++n) { const f32x4 bs = *(const f32x4*)(base + off + bj * HALF + n * 16);
                        const f32x4 o = bs * alpha + gv[bj][n] * (acc[ai][bj][m][n] + bv[bj][n]);
                        *(f32x4*)(out + off + bj * HALF + n * 16) = o; } }
    }
};

template <class Epi, class Sched, bool ALIGN_EPI = false, bool SP2 = false>
__device__ __forceinline__ void gemm_phase(PG8_LAS unsigned char* lds, const Gemm g, const Sched& S, const Epi& E) {
    const int tid = threadIdx.x, wid = __builtin_amdgcn_readfirstlane(tid >> 6), lane = tid & 63, wr = wid >> 2, wc = wid & 3, fr = lane & 15, fq = lane >> 4;
    const int K = g.K, nt = K / BK;
    unsigned voffA[2], voffB[2];
#pragma unroll
    for (int i = 0; i < 2; ++i) { int R, C; stage_rc(tid * 16 + i * 8192, R, C); const int Rb = Epi::PERM ? ((R & ~31) + perm32(R & 31)) : R;
        voffA[i] = (unsigned)(R * K + C) * 2u; voffB[i] = (unsigned)(Rb * K + C) * 2u; }
    const size_t kstep = (size_t)(BK * 2);
    const size_t hstep = (size_t)HALF * K * 2;
    const size_t tstep = 2 * hstep;
    const unsigned ldsw = (unsigned)wid * 1024u;
    const int aoff = lds_byte(wr * 64 + fr, fq * 8), boff = lds_byte(wc * 32 + fr, fq * 8);
#define PG8_SA(b, h) (((b) * 2 + (h)) * HTB)
#define PG8_SB(b, h) ((4 + (b) * 2 + (h)) * HTB)
#define PG8_STAGE(bufoff, gbase, voff) do { _Pragma("unroll") for (int _i = 0; _i < 2; ++_i) \
        __builtin_amdgcn_global_load_lds((const unsigned*)((const char*)(gbase) + (voff)[_i]), (PG8_LAS unsigned*)(lds + (bufoff) + ldsw + _i * 8192), 16, 0, 0); } while (0)
#define PG8_LDA(dst, b, h) do { _Pragma("unroll") for (int m = 0; m < 4; ++m) _Pragma("unroll") for (int k = 0; k < 2; ++k) dst[m][k] = *(const PG8_LAS bf16x8*)(lds + PG8_SA(b, h) + aoff + m * 2048 + k * 1024); } while (0)
#define PG8_LDB(dst, b, h) do { _Pragma("unroll") for (int n = 0; n < 2; ++n) _Pragma("unroll") for (int k = 0; k < 2; ++k) dst[n][k] = *(const PG8_LAS bf16x8*)(lds + PG8_SB(b, h) + boff + n * 2048 + k * 1024); } while (0)
#define PG8_MMA(ai, bj, At, Bt) do { __builtin_amdgcn_s_setprio(1); _Pragma("unroll") for (int m = 0; m < 4; ++m) _Pragma("unroll") for (int n = 0; n < 2; ++n) _Pragma("unroll") for (int k = 0; k < 2; ++k) \
        acc[ai][bj][m][n] = __builtin_amdgcn_mfma_f32_16x16x32_bf16(Bt[n][k], At[m][k], acc[ai][bj][m][n], 0, 0, 0); __builtin_amdgcn_s_setprio(0); } while (0)
#define PG8_WAIT_V(n) asm volatile("s_waitcnt vmcnt(" #n ")" ::: "memory")
#define PG8_WAIT_L(n) asm volatile("s_waitcnt lgkmcnt(" #n ")" ::: "memory")
#define PG8_BAR __builtin_amdgcn_s_barrier()
#define PG8_SCHED __builtin_amdgcn_sched_barrier(0)
    Unit cur, nxt; int ui = 0;
    if (!S.next(0, cur)) return;
    f32x4 acc[2][2][4][2];
#pragma unroll
    for (int a = 0; a < 2; ++a)
#pragma unroll
        for (int b = 0; b < 2; ++b)
#pragma unroll
            for (int m = 0; m < 4; ++m)
#pragma unroll
                for (int n = 0; n < 2; ++n) acc[a][b][m][n] = (f32x4){0.f, 0.f, 0.f, 0.f};
    bf16x8 At[4][2], B0[2][2], B1[2][2];
    const char* cA = (const char*)g.A + (size_t)cur.pm * tstep; const char* cB = (const char*)g.Bt + (size_t)cur.pn * tstep;
    S.a_ready(cur);
    if constexpr (SP2) {
        PG8_STAGE(PG8_SB(0, 0), cB, voffB); PG8_STAGE(PG8_SB(0, 1), cB + hstep, voffB); PG8_STAGE(PG8_SA(0, 0), cA, voffA); PG8_STAGE(PG8_SA(0, 1), cA + hstep, voffA);
        if (wr == 1) PG8_BAR;
        PG8_WAIT_V(2); PG8_BAR;
        PG8_STAGE(PG8_SB(1, 0), cB + kstep, voffB); PG8_STAGE(PG8_SA(1, 0), cA + kstep, voffA); PG8_STAGE(PG8_SB(1, 1), cB + hstep + kstep, voffB);
        PG8_WAIT_V(6); PG8_BAR;
    } else {
        PG8_STAGE(PG8_SB(0, 0), cB, voffB); PG8_STAGE(PG8_SA(0, 0), cA, voffA); PG8_STAGE(PG8_SB(0, 1), cB + hstep, voffB); PG8_STAGE(PG8_SA(0, 1), cA + hstep, voffA);
        if (wr == 1) PG8_BAR;
        PG8_WAIT_V(4); PG8_BAR;
        PG8_STAGE(PG8_SB(1, 0), cB + kstep, voffB); PG8_STAGE(PG8_SA(1, 0), cA + kstep, voffA); PG8_STAGE(PG8_SB(1, 1), cB + hstep + kstep, voffB);
        PG8_WAIT_V(6); PG8_BAR;
    }
    for (;;) {
        const bool has_next = S.next(ui + 1, nxt);
        const char* nA = has_next ? (const char*)g.A + (size_t)nxt.pm * tstep : cA; const char* nB = has_next ? (const char*)g.Bt + (size_t)nxt.pn * tstep : cB;
        for (int t = 0; t < nt; t += 2) {
            const bool last = (t == nt - 2);
            const char* a1 = cA + (size_t)(t + 1) * kstep;
            const char* a2 = last ? nA : cA + (size_t)(t + 2) * kstep; const char* b2 = last ? nB : cB + (size_t)(t + 2) * kstep;
            const char* a3 = a2 + kstep; const char* b3 = b2 + kstep;
            if (last && has_next) S.a_ready(nxt);
            if constexpr (SP2) {
            PG8_LDB(B0, 0, 0); PG8_LDB(B1, 0, 1); PG8_SCHED; PG8_LDA(At, 0, 0); PG8_STAGE(PG8_SA(1, 1), a1 + hstep, voffA);
            PG8_WAIT_V(8); PG8_WAIT_L(0); PG8_BAR; PG8_MMA(0, 0, At, B0); PG8_MMA(0, 1, At, B1); PG8_BAR; PG8_SCHED;
            PG8_LDA(At, 0, 1); PG8_STAGE(PG8_SB(0, 0), b2, voffB); PG8_STAGE(PG8_SB(0, 1), b2 + hstep, voffB); PG8_STAGE(PG8_SA(0, 0), a2, voffA);
            PG8_WAIT_V(8); PG8_WAIT_L(0); PG8_BAR; PG8_MMA(1, 0, At, B0); PG8_MMA(1, 1, At, B1); PG8_BAR; PG8_SCHED;
            PG8_LDB(B0, 1, 0); PG8_LDB(B1, 1, 1); PG8_SCHED; PG8_LDA(At, 1, 0); PG8_STAGE(PG8_SA(0, 1), a2 + hstep, voffA);
            PG8_WAIT_V(8); PG8_WAIT_L(0); PG8_BAR; PG8_MMA(0, 0, At, B0); PG8_MMA(0, 1, At, B1); PG8_BAR; PG8_SCHED;
            PG8_LDA(At, 1, 1); PG8_STAGE(PG8_SB(1, 0), b3, voffB); PG8_STAGE(PG8_SB(1, 1), b3 + hstep, voffB); PG8_STAGE(PG8_SA(1, 0), a3, voffA);
            PG8_WAIT_V(8); PG8_WAIT_L(0); PG8_BAR; PG8_MMA(1, 0, At, B0); PG8_MMA(1, 1, At, B1); PG8_BAR; PG8_SCHED;
            } else {
            PG8_LDB(B0, 0, 0); PG8_SCHED; PG8_LDA(At, 0, 0); PG8_STAGE(PG8_SA(1, 1), a1 + hstep, voffA);
            PG8_WAIT_L(8); PG8_BAR; PG8_WAIT_L(0); PG8_MMA(0, 0, At, B0); PG8_BAR; PG8_SCHED;
            PG8_LDB(B1, 0, 1); PG8_STAGE(PG8_SB(0, 0), b2, voffB);
            PG8_BAR; PG8_WAIT_L(0); PG8_MMA(0, 1, At, B1); PG8_BAR;
            PG8_LDA(At, 0, 1); PG8_STAGE(PG8_SA(0, 0), a2, voffA);
            PG8_BAR; PG8_WAIT_L(0); PG8_MMA(1, 0, At, B0); PG8_BAR; PG8_SCHED;
            PG8_STAGE(PG8_SB(0, 1), b2 + hstep, voffB);
            PG8_WAIT_V(6); PG8_BAR; PG8_MMA(1, 1, At, B1); PG8_BAR;
            PG8_LDB(B0, 1, 0); PG8_SCHED; PG8_LDA(At, 1, 0); PG8_STAGE(PG8_SA(0, 1), a2 + hstep, voffA);
            PG8_WAIT_L(8); PG8_BAR; PG8_WAIT_L(0); PG8_MMA(0, 0, At, B0); PG8_BAR; PG8_SCHED;
            PG8_LDB(B1, 1, 1); PG8_STAGE(PG8_SB(1, 0), b3, voffB);
            PG8_BAR; PG8_WAIT_L(0); PG8_MMA(0, 1, At, B1); PG8_BAR;
            PG8_LDA(At, 1, 1); PG8_STAGE(PG8_SA(1, 0), a3, voffA);
            PG8_BAR; PG8_WAIT_L(0); PG8_MMA(1, 0, At, B0); PG8_BAR; PG8_SCHED;
            PG8_STAGE(PG8_SB(1, 1), b3 + hstep, voffB);
            PG8_WAIT_V(6); PG8_BAR; PG8_MMA(1, 1, At, B1); PG8_BAR;
            }
        }
        if constexpr (ALIGN_EPI) { if (wr == 0) PG8_BAR; }
        if constexpr (!Epi::AFTER_DRAIN) { E(acc, cur, wr, wc, fr, fq); S.done(cur); }
        if (!has_next) break;
#pragma unroll
        for (int a = 0; a < 2; ++a)
#pragma unroll
            for (int b = 0; b < 2; ++b)
#pragma unroll
                for (int m = 0; m < 4; ++m)
#pragma unroll
                    for (int n = 0; n < 2; ++n) acc[a][b][m][n] = (f32x4){0.f, 0.f, 0.f, 0.f};
        cur = nxt; cA = nA; cB = nB; ++ui;
        if constexpr (ALIGN_EPI) { if (wr == 1) PG8_BAR; }
    }
    PG8_WAIT_V(0);
    if constexpr (!ALIGN_EPI) { if (wr == 0) PG8_BAR; }
    PG8_BAR;
    if constexpr (Epi::AFTER_DRAIN) { E.fused(acc, cur, wr, wc, fr, fq, lds, wid, lane); S.done(cur); }
#undef PG8_SA
#undef PG8_SB
#undef PG8_STAGE
#undef PG8_LDA
#undef PG8_LDB
#undef PG8_MMA
#undef PG8_WAIT_V
#undef PG8_WAIT_L
#undef PG8_BAR
#undef PG8_SCHED
}
}

constexpr int NWAVES = 8;
constexpr int D = 1024, FF = 4096, NROW = 20480, NPR = 4096;
constexpr int NPAD = 3840;
constexpr int C_QA = 0, C_KA = 512, C_VA = 1024, C_GA = 1536, C_QB = 2048, C_KB = 2304, C_VB = 2560, C_GB = 3072, C_AL = 3584, C_BE = 3592;
constexpr int NMODV = 5, MODW = 6144;
constexpr float ALPHA_DN = 1.189207115002721f;
constexpr size_t MiB = 1u << 20;
constexpr size_t WS_CTL = 0, CTL_ZERO_BYTES = 1 * MiB;
constexpr size_t CTL_MOD_OFF = 65536;
constexpr int CW_BAR = 4096;
constexpr int LDS_BYTES = 147456;
constexpr int LDSCTL_OFF = 131072, MISC_OFF = LDSCTL_OFF + 320;
constexpr size_t WS_WIN = 1 * MiB, WS_WO = 9 * MiB, WS_W1 = 11 * MiB, WS_W2 = 19 * MiB;
constexpr size_t WS_H = 27 * MiB;
constexpr size_t WS_MIX = WS_H;
constexpr size_t WS_P = 67 * MiB;
constexpr size_t WS_GB = 228 * MiB;
constexpr size_t WS_RB = 230 * MiB;
constexpr size_t WS_END = 250 * MiB;
constexpr size_t OUT_Y = (size_t)NROW * D, OUT_SD = OUT_Y, OUT_SR = OUT_SD + (size_t)16 * 2 * 4 * 128 * 128;

#define LAS __attribute__((address_space(3)))
typedef unsigned short bf16;
typedef unsigned v4u __attribute__((ext_vector_type(4)));
typedef unsigned v2u __attribute__((ext_vector_type(2)));
typedef float f32x4 __attribute__((ext_vector_type(4)));
#define LDS_WAIT() asm volatile("s_waitcnt lgkmcnt(0)" ::: "memory")
__device__ __forceinline__ unsigned f2bf(float f) { unsigned u = __builtin_bit_cast(unsigned, f); return (u + 0x7fffu + ((u >> 16) & 1u)) >> 16; }
__device__ __forceinline__ unsigned pk2(float lo, float hi) { return f2bf(lo) | (f2bf(hi) << 16); }
__device__ __forceinline__ float bf2f(unsigned short h) { return __builtin_bit_cast(float, (unsigned)h << 16); }
__device__ __forceinline__ float bflo(unsigned w) { return __builtin_bit_cast(float, w << 16); }
__device__ __forceinline__ float bfhi(unsigned w) { return __builtin_bit_cast(float, w & 0xffff0000u); }
__device__ __forceinline__ float wave_sum(float v) {
#pragma unroll
    for (int o = 1; o < 64; o <<= 1) v += __shfl_xor(v, o);
    return v;
}
__device__ __forceinline__ float g16_sum(float v) {
#pragma unroll
    for (int o = 1; o < 16; o <<= 1) v += __shfl_xor(v, o);
    return v;
}
__device__ __forceinline__ float silu_f(float x) { return x / (1.f + __expf(-x)); }

struct Args {
    const float *x_prompt, *x_sample, *c, *state_delta, *state_ret, *c_ctx, *w_mod, *b_mod, *w_in, *conv_w, *a_log, *dt_bias, *norm_a_w, *gn_w, *gn_b, *w_o,
                *ln1_w, *ln1_b, *w_ff1, *b_ff1, *w_ff2, *b_ff2, *ln2_w, *ln2_b;
    float* out; unsigned char* ws; int ph_lo, ph_hi;
};
struct Frame { LAS unsigned char* lds; int tid, lane, wave, gw, NGW; };

__device__ __forceinline__ const float* xrow_ptr(const Args& a, int r) { return r < NPR ? a.x_prompt + (size_t)r * D : a.x_sample + (size_t)(r - NPR) * D; }
__device__ __forceinline__ int vrow_of(int r) { return r < NPR ? 0 : 1 + ((r - NPR) >> 12); }

__device__ __forceinline__ int map_in(int nd) { return nd < 2048 ? nd : (nd < 3584 ? nd + 16 : (nd < 3600 ? nd - 3584 + 2048 : -1)); }
template <bool MAP> __device__ __forceinline__ void transpose_item(const float* W, int K, int N, int nblk, bf16* WT, LAS float* scr, int item, int lane) {
    const int kb = item / nblk, nb = item % nblk, k0 = 64 * kb, n0 = 32 * nb;
    const int nd = n0 + (lane & 31), ns = MAP ? map_in(nd) : nd;
#pragma unroll 8
    for (int i = 0; i < 32; ++i) { const int kk = 2 * i + (lane >> 5); scr[kk * 33 + (lane & 31)] = ns >= 0 ? W[(size_t)(k0 + kk) * N + ns] : 0.f; }
    LDS_WAIT(); asm volatile("" ::: "memory");
    const int c = lane & 7;
#pragma unroll
    for (int j = 0; j < 4; ++j) { const int n = (lane >> 3) + 8 * j; const LAS float* s = scr + (8 * c) * 33 + n;
        v4u o; o.x = pk2(s[0 * 33], s[1 * 33]); o.y = pk2(s[2 * 33], s[3 * 33]); o.z = pk2(s[4 * 33], s[5 * 33]); o.w = pk2(s[6 * 33], s[7 * 33]);
        *(v4u*)(WT + (size_t)(n0 + n) * K + k0 + 8 * c) = o; }
    LDS_WAIT(); asm volatile("" ::: "memory");
}
__device__ __forceinline__ void p0_prologue(const Args& a, Frame& F) {
    LAS float* scr = (LAS float*)(F.lds + F.wave * 16384);
    bf16* Win_t = (bf16*)(a.ws + WS_WIN); bf16* Wo_t = (bf16*)(a.ws + WS_WO); bf16* W1_t = (bf16*)(a.ws + WS_W1); bf16* W2_t = (bf16*)(a.ws + WS_W2);
    constexpr int I_IN = (D / 64) * (NPAD / 32), I_O = (D / 64) * (D / 32), I_1 = (D / 64) * (FF / 32), I_2 = (FF / 64) * (D / 32);
    constexpr int I_MOD = 96 * 8;
    constexpr int NITEMS = I_MOD + I_IN + I_O + I_1 + I_2;
    float* mod = (float*)(a.ws + WS_CTL + CTL_MOD_OFF);
    for (int it = F.gw; it < NITEMS; it += F.NGW) {
        int r = it;
        if (r < I_MOD) {
            const int cg = r % 96, ks = r / 96, e = cg * 64 + F.lane;
            float acc[NMODV];
#pragma unroll
            for (int v = 0; v < NMODV; ++v) acc[v] = 0.f;
            for (int dd = 0; dd < 128; ++dd) { const int d = ks * 128 + dd; const float wv = a.w_mod[(size_t)d * MODW + e];
#pragma unroll
                for (int v = 0; v < NMODV; ++v) { const float cv = v == 0 ? a.c_ctx[d] : a.c[(v - 1) * D + d]; acc[v] += silu_f(cv) * wv; } }
            const float bb = ks == 0 ? a.b_mod[e] : 0.f;
#pragma unroll
            for (int v = 0; v < NMODV; ++v) atomicAdd(mod + v * MODW + e, acc[v] + bb);
            continue; }
        r -= I_MOD;
        if (r < I_IN) { transpose_item<true>(a.w_in, D, 3600, NPAD / 32, Win_t, scr, r, F.lane); continue; } r -= I_IN;
        if (r < I_O) { transpose_item<false>(a.w_o, D, D, D / 32, Wo_t, scr, r, F.lane); continue; } r -= I_O;
        if (r < I_1) { transpose_item<false>(a.w_ff1, D, FF, FF / 32, W1_t, scr, r, F.lane); continue; } r -= I_1;
        transpose_item<false>(a.w_ff2, FF, D, D / 32, W2_t, scr, r, F.lane);
    }
}

__device__ __forceinline__ void ln_stats(const f32x4 (&v)[4], float eps, float& mean, float& rstd) {
    float s = 0.f;
#pragma unroll
    for (int j = 0; j < 4; ++j) s += (v[j].x + v[j].y) + (v[j].z + v[j].w);
    mean = wave_sum(s) * (1.f / D); float s2 = 0.f;
#pragma unroll
    for (int j = 0; j < 4; ++j) { const f32x4 d = v[j] - mean; s2 += (d.x * d.x + d.y * d.y) + (d.z * d.z + d.w * d.w); }
    rstd = 1.f / sqrtf(wave_sum(s2) * (1.f / D) + eps);
}
__device__ __forceinline__ void p1_h(const Args& a, Frame& F) {
    const float* mod = (const float*)(a.ws + WS_CTL + CTL_MOD_OFF); bf16* H = (bf16*)(a.ws + WS_H);
    for (int r = F.gw; r < NROW; r += F.NGW) {
        const f32x4* xr = (const f32x4*)xrow_ptr(a, r) + F.lane; const float* mv = mod + (size_t)vrow_of(r) * MODW;
        f32x4 v[4];
#pragma unroll
        for (int j = 0; j < 4; ++j) v[j] = xr[64 * j];
        float mean, rstd; ln_stats(v, 1e-6f, mean, rstd);
        unsigned long long* o8 = (unsigned long long*)(H + (size_t)r * D) + F.lane;
#pragma unroll
        for (int j = 0; j < 4; ++j) { const f32x4 sh = *((const f32x4*)mv + F.lane + 64 * j), sc = *((const f32x4*)(mv + 1024) + F.lane + 64 * j);
            const f32x4 h = (v[j] - mean) * rstd * (sc + 1.f) + sh;
            o8[64 * j] = (unsigned long long)pk2(h.x, h.y) | ((unsigned long long)pk2(h.z, h.w) << 32); }
    }
}
#define XB_TMO      128
#define XB_XCNT(j)  (256  + 64 * (j))
#define XB_XSUB(j)  (1280 + 64 * (j))
#define XB_XGEN(j)  (2304 + 64 * (j))
#define XB_TOP      3328
#define XB_TOPGEN   3392
#define XCD_BAR_WORDS 3456
#define XB_SPIN_CAP (1u << 22)

__device__ __forceinline__ unsigned xb_ld(unsigned* p)              { return __hip_atomic_load(p, __ATOMIC_RELAXED, __HIP_MEMORY_SCOPE_AGENT); }
__device__ __forceinline__ unsigned xb_add(unsigned* p, unsigned v) { return __hip_atomic_fetch_add(p, v, __ATOMIC_RELAXED, __HIP_MEMORY_SCOPE_AGENT); }
__device__ __forceinline__ unsigned xb_xcc_id() { return (unsigned)__builtin_amdgcn_s_getreg((3 << 11) | 20) & 0xFu; }
#define XB_SPIN(cond, bar) do { unsigned _sp = 0; while (cond) { __builtin_amdgcn_s_sleep(1); \
    if ((++_sp & 255u) == 0u) { if (xb_ld(&(bar)[XB_TMO])) break; if (_sp > XB_SPIN_CAP) { atomicAdd(&(bar)[XB_TMO], 1u); break; } } } } while (0)

struct XcdBarrier {
    unsigned* bar; unsigned x;
    volatile LAS unsigned* st;
};

__device__ __forceinline__ XcdBarrier xcd_barrier_post(unsigned* bar, volatile LAS unsigned* st) {
    XcdBarrier b; b.bar = bar; b.x = xb_xcc_id(); b.st = st;
    if (threadIdx.x == 0) (void)xb_add(&bar[XB_XCNT(b.x)], 1u);
    return b;
}
__device__ __forceinline__ void xcd_barrier_complete(unsigned* bar, unsigned x, unsigned& nloc, unsigned& nx) {
    const unsigned G = gridDim.x * gridDim.y * gridDim.z;
    unsigned sum, cnt, mine, sp = 0u;
    for (;;) {
        sum = 0u; cnt = 0u; mine = 0u;
#pragma unroll
        for (unsigned j = 0; j < 16; ++j) { const unsigned c = xb_ld(&bar[XB_XCNT(j)]); sum += c; cnt += (c > 0u) ? 1u : 0u; mine = (j == x) ? c : mine; }
        if (sum == G) break;
        __builtin_amdgcn_s_sleep(1);
        if ((++sp & 255u) == 0u) { if (xb_ld(&bar[XB_TMO])) break; if (sp > XB_SPIN_CAP) { atomicAdd(&bar[XB_TMO], 1u); break; } }
    }
    nloc = mine > 0u ? mine : 1u; nx = cnt > 0u ? cnt : 1u;
}

__device__ __forceinline__ void xcd_barrier(const XcdBarrier& b) {
    asm volatile("s_waitcnt vmcnt(0)" ::: "memory");
    __syncthreads();
    if (threadIdx.x == 0) {
        unsigned* bar = b.bar;
        __builtin_amdgcn_s_waitcnt(0);
        unsigned nloc = b.st[0], nx = b.st[1];
        if (nloc == 0u) { xcd_barrier_complete(bar, b.x, nloc, nx); b.st[0] = nloc; b.st[1] = nx; }
        const unsigned old = xb_add(&bar[XB_XSUB(b.x)], 1u);
        const unsigned gen = old / nloc;
        if (old + 1u == (gen + 1u) * nloc) {
            __builtin_amdgcn_fence(__ATOMIC_RELEASE, "agent");
            asm volatile("s_waitcnt vmcnt(0)" ::: "memory");
            const unsigned og = xb_add(&bar[XB_TOP], 1u);
            const unsigned tg = og / nx;
            if (og + 1u == (tg + 1u) * nx) xb_add(&bar[XB_TOPGEN], 1u);
            else XB_SPIN(xb_ld(&bar[XB_TOPGEN]) == tg, bar);
            __builtin_amdgcn_fence(__ATOMIC_ACQUIRE, "agent");
            xb_add(&bar[XB_XGEN(b.x)], 1u);
            asm volatile("s_waitcnt vmcnt(0)" ::: "memory");
        } else {
            XB_SPIN(xb_ld(&bar[XB_XGEN(b.x)]) == gen, bar);
            __builtin_amdgcn_fence(__ATOMIC_ACQUIRE, "agent");
            asm volatile("s_waitcnt vmcnt(0)" ::: "memory");
        }
    }
    __syncthreads();
}
__device__ __forceinline__ void seq_of_row(int r, int& base, int& T, int& t) { if (r < NPR) { base = r & ~255; T = 256; t = r & 255; } else { const int q = r - NPR; base = NPR + (q & ~4095); T = 4096; t = q & 4095; } }
__device__ __forceinline__ void unpack8(const v4u w, float (&f)[8]) { f[0] = bflo(w.x); f[1] = bfhi(w.x); f[2] = bflo(w.y); f[3] = bfhi(w.y); f[4] = bflo(w.z); f[5] = bfhi(w.z); f[6] = bflo(w.w); f[7] = bfhi(w.w); }
__device__ __forceinline__ v4u pack8(const float (&f)[8]) { v4u w; w.x = pk2(f[0], f[1]); w.y = pk2(f[2], f[3]); w.z = pk2(f[4], f[5]); w.w = pk2(f[6], f[7]); return w; }

__device__ __forceinline__ void p3a_prep(const Args& a, Frame& F) {
    bf16* P = (bf16*)(a.ws + WS_P); bf16* QKVC = (bf16*)a.out; float* GB = (float*)(a.ws + WS_GB);
    const int l = F.lane;
    for (int r = F.gw; r < NROW; r += F.NGW) {
        int base, T, t; seq_of_row(r, base, T, t);
        float acc[3][8];
#pragma unroll
        for (int s = 0; s < 3; ++s)
#pragma unroll
            for (int i = 0; i < 8; ++i) acc[s][i] = 0.f;
#pragma unroll
        for (int kk = 0; kk < 5; ++kk) { const int tt = t + kk - 2;
            if (tt >= 0 && tt < T) { const bf16* rp = P + (size_t)(base + tt) * NPAD;
#pragma unroll
                for (int s = 0; s < 3; ++s) { float xv[8]; unpack8(*(const v4u*)(rp + 512 * s + 8 * l), xv);
                    const f32x4 w0 = *(const f32x4*)(a.conv_w + kk * 1536 + 512 * s + 8 * l), w1 = *(const f32x4*)(a.conv_w + kk * 1536 + 512 * s + 8 * l + 4);
                    acc[s][0] += xv[0] * w0.x; acc[s][1] += xv[1] * w0.y; acc[s][2] += xv[2] * w0.z; acc[s][3] += xv[3] * w0.w;
                    acc[s][4] += xv[4] * w1.x; acc[s][5] += xv[5] * w1.y; acc[s][6] += xv[6] * w1.z; acc[s][7] += xv[7] * w1.w; } } }
#pragma unroll
        for (int s = 0; s < 3; ++s)
#pragma unroll
            for (int i = 0; i < 8; ++i) acc[s][i] = silu_f(acc[s][i]);
#pragma unroll
        for (int s = 0; s < 2; ++s) { float ss = 0.f;
#pragma unroll
            for (int i = 0; i < 8; ++i) ss += acc[s][i] * acc[s][i];
            ss = g16_sum(ss); const float sc = (1.f / sqrtf(ss + 1e-6f)) * (s == 0 ? 0.08838834764831845f : 1.f);
#pragma unroll
            for (int i = 0; i < 8; ++i) acc[s][i] *= sc; }
        bf16* op = QKVC + (size_t)r * 1536;
#pragma unroll
        for (int s = 0; s < 3; ++s) *(v4u*)(op + 512 * s + 8 * l) = pack8(acc[s]);
        if (l < 16) { const float raw = bf2f(P[(size_t)r * NPAD + C_AL + l]); float o;
            if (l < 8) { const float z = raw + a.dt_bias[l]; const float sp = z > 20.f ? z : log1pf(expf(z)); o = -expf(a.a_log[l]) * sp; }
            else o = 1.f / (1.f + expf(-raw));
            GB[(size_t)r * 16 + l] = o; }
    }
}

__device__ __forceinline__ void p3b_delta_naive(const Args& a, Frame& F) {
    const bf16* QKVC = (const bf16*)a.out; const float* GB = (const float*)(a.ws + WS_GB); bf16* P = (bf16*)(a.ws + WS_P);
    const int l = F.lane;
    for (int it = F.gw; it < 5120; it += F.NGW) {
        const bool smp = it < 1024; const int q = smp ? it : it - 1024;
        const int cg = q & 31, dir = (q >> 5) & 1, h = (q >> 6) & 3, sq = q >> 8;
        const int T = smp ? 4096 : 256, base = smp ? NPR + sq * 4096 : sq * 256, e0 = cg * 4;
        float s0[4], s1[4];
        if (smp) { const float* S0 = a.state_delta + ((size_t)(sq * 2 + dir) * 4 + h) * 128 * 128;
#pragma unroll
            for (int c = 0; c < 4; ++c) { s0[c] = S0[(size_t)l * 128 + e0 + c]; s1[c] = S0[(size_t)(l + 64) * 128 + e0 + c]; } }
        else {
#pragma unroll
            for (int c = 0; c < 4; ++c) { s0[c] = 0.f; s1[c] = 0.f; } }
        int row = base + (dir ? T - 1 : 0);
        const bf16* rp = QKVC + (size_t)row * 1536 + h * 128;
        unsigned short nq0 = rp[l], nq1 = rp[64 + l], nk0 = rp[512 + l], nk1 = rp[512 + 64 + l]; v2u nv = *(const v2u*)(rp + 1024 + e0);
        float ng = GB[(size_t)row * 16 + dir * 4 + h], nb = GB[(size_t)row * 16 + 8 + dir * 4 + h];
        for (int step = 0; step < T; ++step) {
            const float q0 = bf2f(nq0), q1 = bf2f(nq1), k0 = bf2f(nk0), k1 = bf2f(nk1), g = ng, b = nb; const v2u vv = nv; const int crow = row;
            if (step + 1 < T) { row = base + (dir ? T - 2 - step : step + 1); rp = QKVC + (size_t)row * 1536 + h * 128;
                nq0 = rp[l]; nq1 = rp[64 + l]; nk0 = rp[512 + l]; nk1 = rp[512 + 64 + l]; nv = *(const v2u*)(rp + 1024 + e0);
                ng = GB[(size_t)row * 16 + dir * 4 + h]; nb = GB[(size_t)row * 16 + 8 + dir * 4 + h]; }
            const float al = __expf(g);
            const float v4[4] = {bflo(vv.x), bfhi(vv.x), bflo(vv.y), bfhi(vv.y)};
            float dt[4], o[4];
#pragma unroll
            for (int c = 0; c < 4; ++c) dt[c] = k0 * s0[c] + k1 * s1[c];
#pragma unroll
            for (int c = 0; c < 4; ++c) dt[c] = wave_sum(dt[c]);
#pragma unroll
            for (int c = 0; c < 4; ++c) { const float cf = b * (v4[c] - al * dt[c]); s0[c] = al * s0[c] + cf * k0; s1[c] = al * s1[c] + cf * k1; o[c] = q0 * s0[c] + q1 * s1[c]; }
#pragma unroll
            for (int c = 0; c < 4; ++c) o[c] = wave_sum(o[c]);
            if (l == 0) { v2u w; w.x = pk2(o[0], o[1]); w.y = pk2(o[2], o[3]); *(v2u*)(P + (size_t)crow * NPAD + dir * 512 + h * 128 + e0) = w; }
        }
        if (!smp) { float* So = a.out + OUT_SD + ((size_t)(sq * 2 + dir) * 4 + h) * 128 * 128;
#pragma unroll
            for (int c = 0; c < 4; ++c) { So[(size_t)l * 128 + e0 + c] = s0[c]; So[(size_t)(l + 64) * 128 + e0 + c] = s1[c]; } }
    }
}

__device__ __forceinline__ void p3c_ret_naive(const Args& a, Frame& F) {
    const bf16* P = (const bf16*)(a.ws + WS_P); bf16* RF = (bf16*)a.out + (size_t)NROW * 1536; bf16* RB = (bf16*)(a.ws + WS_RB);
    const int l = F.lane;
    for (int it = F.gw; it < 5120; it += F.NGW) {
        const bool smp = it < 1024; const int q = smp ? it : it - 1024;
        const int cg = q & 31, dir = (q >> 5) & 1, h = (q >> 6) & 3, sq = q >> 8;
        const int T = smp ? 4096 : 256, base = smp ? NPR + sq * 4096 : sq * 256, e0 = cg * 4;
        const int hg = dir ? 3 - h : h; const float gam = 1.f - exp2f(-5.f - (float)hg);
        float s[4];
        if (smp) { const float* S0 = a.state_ret + ((size_t)(sq * 2 + dir) * 4 + h) * 64 * 128;
#pragma unroll
            for (int c = 0; c < 4; ++c) s[c] = S0[(size_t)l * 128 + e0 + c]; }
        else {
#pragma unroll
            for (int c = 0; c < 4; ++c) s[c] = 0.f; }
        bf16* R = dir ? RB : RF;
        int row = base + (dir ? T - 1 : 0);
        const bf16* rp = P + (size_t)row * NPAD;
        unsigned short nq = rp[C_QB + 64 * h + l], nk = rp[C_KB + 64 * h + l]; v2u nv = *(const v2u*)(rp + C_VB + 128 * h + e0);
        for (int step = 0; step < T; ++step) {
            const float qv = bf2f(nq), kv = bf2f(nk); const v2u vv = nv; const int crow = row;
            if (step + 1 < T) { row = base + (dir ? T - 2 - step : step + 1); rp = P + (size_t)row * NPAD;
                nq = rp[C_QB + 64 * h + l]; nk = rp[C_KB + 64 * h + l]; nv = *(const v2u*)(rp + C_VB + 128 * h + e0); }
            const float v4[4] = {bflo(vv.x), bfhi(vv.x), bflo(vv.y), bfhi(vv.y)};
            float o[4];
#pragma unroll
            for (int c = 0; c < 4; ++c) { s[c] = gam * s[c] + kv * v4[c]; o[c] = qv * s[c]; }
#pragma unroll
            for (int c = 0; c < 4; ++c) o[c] = wave_sum(o[c]);
            if (l == 0) { v2u w; w.x = pk2(o[0], o[1]); w.y = pk2(o[2], o[3]); *(v2u*)(R + (size_t)crow * 512 + h * 128 + e0) = w; }
        }
        if (!smp) { float* So = a.out + OUT_SR + ((size_t)(sq * 2 + dir) * 4 + h) * 64 * 128;
#pragma unroll
            for (int c = 0; c < 4; ++c) So[(size_t)l * 128 + e0 + c] = s[c]; }
    }
}

__device__ __forceinline__ void p5_combine(const Args& a, Frame& F) {
    const bf16* P = (const bf16*)(a.ws + WS_P);
    bf16* MIX = (bf16*)(a.ws + WS_MIX); const int l = F.lane;
    for (int r = F.gw; r < NROW; r += F.NGW) {
        const bf16* rp = P + (size_t)r * NPAD;
        float x0[8], x1[8], gt[8], o[8];
        unpack8(*(const v4u*)(rp + 8 * l), x0); unpack8(*(const v4u*)(rp + 512 + 8 * l), x1); unpack8(*(const v4u*)(rp + C_GA + 8 * l), gt);
        float ss = 0.f;
#pragma unroll
        for (int i = 0; i < 8; ++i) { x0[i] += x1[i]; ss += x0[i] * x0[i]; }
        ss = g16_sum(ss); const float rs = 1.f / sqrtf(ss * (1.f / 128.f) + 1e-6f);
#pragma unroll
        for (int i = 0; i < 8; ++i) o[i] = x0[i] * rs * a.norm_a_w[(8 * l + i) & 127] * silu_f(gt[i]);
        *(v4u*)(MIX + (size_t)r * D + 8 * l) = pack8(o);
    }
}

__device__ __forceinline__ void p6b_ln1(const Args& a, Frame& F) {
    const float* mod = (const float*)(a.ws + WS_CTL + CTL_MOD_OFF); bf16* H2 = (bf16*)(a.ws + WS_H);
    for (int r = F.gw; r < NROW; r += F.NGW) {
        f32x4* zr = (f32x4*)(a.out + (size_t)r * D) + F.lane; const float* mv = mod + (size_t)vrow_of(r) * MODW;
        f32x4 v[4];
#pragma unroll
        for (int j = 0; j < 4; ++j) v[j] = zr[64 * j];
        float mean, rstd; ln_stats(v, 1e-6f, mean, rstd);
#pragma unroll
        for (int j = 0; j < 4; ++j) { const f32x4 w = *((const f32x4*)a.ln1_w + F.lane + 64 * j), b = *((const f32x4*)a.ln1_b + F.lane + 64 * j);
            v[j] = (v[j] - mean) * rstd * w + b; zr[64 * j] = v[j]; }
        ln_stats(v, 1e-6f, mean, rstd);
        unsigned long long* o8 = (unsigned long long*)(H2 + (size_t)r * D) + F.lane;
#pragma unroll
        for (int j = 0; j < 4; ++j) { const f32x4 sh = *((const f32x4*)(mv + 3072) + F.lane + 64 * j), sc = *((const f32x4*)(mv + 4096) + F.lane + 64 * j);
            const f32x4 h = (v[j] - mean) * rstd * (sc + 1.f) + sh;
            o8[64 * j] = (unsigned long long)pk2(h.x, h.y) | ((unsigned long long)pk2(h.z, h.w) << 32); }
    }
}
__device__ __forceinline__ void p8b_ln2(const Args& a, Frame& F) {
    for (int r = F.gw; r < NROW; r += F.NGW) {
        f32x4* zr = (f32x4*)(a.out + (size_t)r * D) + F.lane;
        f32x4 v[4];
#pragma unroll
        for (int j = 0; j < 4; ++j) v[j] = zr[64 * j];
        float mean, rstd; ln_stats(v, 1e-6f, mean, rstd);
#pragma unroll
        for (int j = 0; j < 4; ++j) { const f32x4 w = *((const f32x4*)a.ln2_w + F.lane + 64 * j), b = *((const f32x4*)a.ln2_b + F.lane + 64 * j);
            zr[64 * j] = (v[j] - mean) * rstd * w + b; }
    }
}
constexpr int RL_Q = 0, RL_K = 18432, RL_VT = 36864, RL_KTF = 71680, RL_KTB = 89088;
constexpr int RQP = 72, RVP = 136;
typedef short bf16x8 __attribute__((ext_vector_type(8)));
typedef short s16x4 __attribute__((ext_vector_type(4)));
#define MFMA16(a, b, c) __builtin_amdgcn_mfma_f32_16x16x32_bf16((a), (b), (c), 0, 0, 0)
constexpr size_t WS_DS = WS_H;
constexpr size_t WS_SP = WS_RB;

__device__ __forceinline__ void ret_item(int it, int& base, int& n, int& h, bool& smp) {
    if (it < 512) { smp = true; h = it & 3; n = (it >> 2) & 31; base = NPR + (it >> 7) * 4096; }
    else { const int q = it - 512; smp = false; h = q & 3; n = (q >> 2) & 1; base = (q >> 3) * 256; }
}
__device__ __forceinline__ float lg2gamma(int hg) { return log2f(1.f - exp2f(-5.f - (float)hg)); }

template <bool NEED_QK, bool NEED_KT>
__device__ __forceinline__ void ret_stage(const Args& a, Frame& F, int base, int n, int h, bool smp) {
    const bf16* P = (const bf16*)(a.ws + WS_P);
    LAS bf16* Lq = (LAS bf16*)(F.lds + RL_Q); LAS bf16* Lk = (LAS bf16*)(F.lds + RL_K); LAS bf16* Lvt = (LAS bf16*)(F.lds + RL_VT);
    LAS bf16* Lkf = (LAS bf16*)(F.lds + RL_KTF); LAS bf16* Lkb = (LAS bf16*)(F.lds + RL_KTB);
    const int t = F.tid, row = t >> 2, pc = t & 3, tpos = 128 * n + row;
    const bf16* rp = P + (size_t)(base + tpos) * NPAD;
    { const int j0 = pc * 8;
      float q1[8], q2[8], k1[8], k2[8];
      if (NEED_QK) { unpack8(*(const v4u*)(rp + C_QB + 64 * h + j0), q1); unpack8(*(const v4u*)(rp + C_QB + 64 * h + 32 + j0), q2); }
      unpack8(*(const v4u*)(rp + C_KB + 64 * h + j0), k1); unpack8(*(const v4u*)(rp + C_KB + 64 * h + 32 + j0), k2);
      if (smp) { const float pos = (pc < 2) ? (float)(tpos >> 6) : (float)(tpos & 63);
#pragma unroll
          for (int i = 0; i < 8; ++i) { const int f = (j0 + i) & 15; const float ang = pos * exp2f(-(float)f * 0.83048202372184059f); float sn, cs; __sincosf(ang, &sn, &cs);
              if (NEED_QK) { const float x1 = q1[i], x2 = q2[i]; q1[i] = x1 * cs - x2 * sn; q2[i] = x1 * sn + x2 * cs; }
              const float y1 = k1[i], y2 = k2[i]; k1[i] = y1 * cs - y2 * sn; k2[i] = y1 * sn + y2 * cs; } }
      if (NEED_QK) {
#pragma unroll
          for (int i = 0; i < 8; ++i) { q1[i] *= 0.125f; q2[i] *= 0.125f; }
          *(LAS v4u*)(Lq + row * RQP + j0) = pack8(q1); *(LAS v4u*)(Lq + row * RQP + 32 + j0) = pack8(q2);
          *(LAS v4u*)(Lk + row * RQP + j0) = pack8(k1); *(LAS v4u*)(Lk + row * RQP + 32 + j0) = pack8(k2); }
      if (NEED_KT) { const float zf = exp2f((float)(127 - row) * lg2gamma(h)), zb = exp2f((float)row * lg2gamma(3 - h));
#pragma unroll
          for (int i = 0; i < 8; ++i) { Lkf[(j0 + i) * RVP + row] = (bf16)f2bf(k1[i] * zf); Lkf[(32 + j0 + i) * RVP + row] = (bf16)f2bf(k2[i] * zf);
              Lkb[(j0 + i) * RVP + row] = (bf16)f2bf(k1[i] * zb); Lkb[(32 + j0 + i) * RVP + row] = (bf16)f2bf(k2[i] * zb); } } }
    { const int e0 = pc * 32;
#pragma unroll
      for (int q4 = 0; q4 < 4; ++q4) { const v4u w = *(const v4u*)(rp + C_VB + 128 * h + e0 + 8 * q4); const unsigned ww[4] = {w.x, w.y, w.z, w.w};
#pragma unroll
          for (int i = 0; i < 4; ++i) { Lvt[(e0 + 8 * q4 + 2 * i) * RVP + row] = (bf16)(ww[i] & 0xffffu); Lvt[(e0 + 8 * q4 + 2 * i + 1) * RVP + row] = (bf16)(ww[i] >> 16); } } }
}

__device__ __forceinline__ void ret_ra(const Args& a, Frame& F) {
    float* DS = (float*)(a.ws + WS_DS);
    const int l = F.lane, g = l >> 4, c = l & 15, w = F.wave;
    for (int it = blockIdx.x; it < 640; it += gridDim.x) {
        int base, n, h; bool smp; ret_item(it, base, n, h, smp);
        __syncthreads();
        ret_stage<false, true>(a, F, base, n, h, smp);
        __syncthreads();
        const LAS bf16* Lvt = (const LAS bf16*)(F.lds + RL_VT); const LAS bf16* Lkf = (const LAS bf16*)(F.lds + RL_KTF); const LAS bf16* Lkb = (const LAS bf16*)(F.lds + RL_KTB);
        f32x4 acc[2][4];
#pragma unroll
        for (int d = 0; d < 2; ++d)
#pragma unroll
            for (int nd = 0; nd < 4; ++nd) acc[d][nd] = (f32x4){0.f, 0.f, 0.f, 0.f};
#pragma unroll
        for (int s = 0; s < 4; ++s) { const bf16x8 av = *(const LAS bf16x8*)(Lvt + (16 * w + c) * RVP + 32 * s + 8 * g);
#pragma unroll
            for (int nd = 0; nd < 4; ++nd) { const bf16x8 bf_ = *(const LAS bf16x8*)(Lkf + (16 * nd + c) * RVP + 32 * s + 8 * g), bb_ = *(const LAS bf16x8*)(Lkb + (16 * nd + c) * RVP + 32 * s + 8 * g);
                acc[0][nd] = MFMA16(av, bf_, acc[0][nd]); acc[1][nd] = MFMA16(av, bb_, acc[1][nd]); } }
#pragma unroll
        for (int d = 0; d < 2; ++d) { float* o = DS + ((size_t)it * 2 + d) * 8192;
#pragma unroll
            for (int nd = 0; nd < 4; ++nd)
#pragma unroll
                for (int r = 0; r < 4; ++r) o[(16 * w + 4 * g + r) * 64 + 16 * nd + c] = acc[d][nd][r]; }
    }
}

__device__ __forceinline__ void ret_rb(const Args& a, Frame& F) {
    const float* DS = (const float*)(a.ws + WS_DS); bf16* SP = (bf16*)(a.ws + WS_SP);
    for (int cid = blockIdx.x; cid < 160; cid += gridDim.x) {
        const bool smp = cid < 32; const int q = smp ? cid : cid - 32;
        const int dir = q & 1, h = (q >> 1) & 3, sq = q >> 3, N = smp ? 32 : 2;
        const float gch = exp2f(128.f * lg2gamma(dir ? 3 - h : h));
        const int idx = F.tid * 16, e = idx >> 6, d0 = idx & 63;
        float S[16];
        if (smp) { const float* S0 = a.state_ret + ((size_t)(sq * 2 + dir) * 4 + h) * 8192;
#pragma unroll
            for (int i = 0; i < 16; ++i) S[i] = S0[(size_t)(d0 + i) * 128 + e]; }
        else {
#pragma unroll
            for (int i = 0; i < 16; ++i) S[i] = 0.f; }
        for (int st = 0; st < N; ++st) { const int n = dir ? N - 1 - st : st;
            const int it = smp ? (sq * 32 + n) * 4 + h : 512 + (sq * 2 + n) * 4 + h;
            const float* dp = DS + ((size_t)it * 2 + dir) * 8192 + idx; bf16* sp = SP + ((size_t)it * 2 + dir) * 8192 + idx;
            f32x4 dv[4];
#pragma unroll
            for (int i = 0; i < 4; ++i) dv[i] = *(const f32x4*)(dp + 4 * i);
            v4u o0, o1; o0.x = pk2(S[0], S[1]); o0.y = pk2(S[2], S[3]); o0.z = pk2(S[4], S[5]); o0.w = pk2(S[6], S[7]);
            o1.x = pk2(S[8], S[9]); o1.y = pk2(S[10], S[11]); o1.z = pk2(S[12], S[13]); o1.w = pk2(S[14], S[15]);
            *(v4u*)sp = o0; *(v4u*)(sp + 8) = o1;
#pragma unroll
            for (int i = 0; i < 4; ++i) { S[4 * i] = gch * S[4 * i] + dv[i].x; S[4 * i + 1] = gch * S[4 * i + 1] + dv[i].y; S[4 * i + 2] = gch * S[4 * i + 2] + dv[i].z; S[4 * i + 3] = gch * S[4 * i + 3] + dv[i].w; } }
        if (!smp) { float* So = a.out + OUT_SR + ((size_t)(sq * 2 + dir) * 4 + h) * 8192;
#pragma unroll
            for (int i = 0; i < 16; ++i) So[(size_t)(d0 + i) * 128 + e] = S[i]; }
    }
}

__device__ __forceinline__ void ret_rc(const Args& a, Frame& F) {
    const bf16* P = (const bf16*)(a.ws + WS_P); const bf16* SP = (const bf16*)(a.ws + WS_SP); bf16* MIX = (bf16*)(a.ws + WS_MIX);
    const int l = F.lane, g = l >> 4, c = l & 15, w = F.wave;
    for (int it = blockIdx.x; it < 640; it += gridDim.x) {
        int base, n, h; bool smp; ret_item(it, base, n, h, smp);
        __syncthreads();
        ret_stage<true, false>(a, F, base, n, h, smp);
        __syncthreads();
        const LAS bf16* Lq = (const LAS bf16*)(F.lds + RL_Q); const LAS bf16* Lk = (const LAS bf16*)(F.lds + RL_K); const LAS bf16* Lvt = (const LAS bf16*)(F.lds + RL_VT);
        const float lgf = lg2gamma(h), lgb = lg2gamma(3 - h);
        const int il = 16 * w + c;
        bf16x8 bq[2];
#pragma unroll
        for (int s = 0; s < 2; ++s) bq[s] = *(const LAS bf16x8*)(Lq + il * RQP + 32 * s + 8 * g);
        bf16x8 pb[4];
#pragma unroll
        for (int s = 0; s < 4; ++s) { f32x4 st2[2];
#pragma unroll
            for (int hh = 0; hh < 2; ++hh) { const int mt = 2 * s + hh; f32x4 acc = (f32x4){0.f, 0.f, 0.f, 0.f};
#pragma unroll
                for (int s2 = 0; s2 < 2; ++s2) { const bf16x8 ak = *(const LAS bf16x8*)(Lk + (16 * mt + c) * RQP + 32 * s2 + 8 * g); acc = MFMA16(ak, bq[s2], acc); }
#pragma unroll
                for (int r = 0; r < 4; ++r) { const int j = 16 * mt + 4 * g + r; const float dm = j < il ? exp2f((float)(il - j) * lgf) : (j > il ? exp2f((float)(j - il) * lgb) : 2.f); acc[r] *= dm; }
                st2[hh] = acc; }
            v4u pw; pw.x = pk2(st2[0][0], st2[0][1]); pw.y = pk2(st2[0][2], st2[0][3]); pw.z = pk2(st2[1][0], st2[1][1]); pw.w = pk2(st2[1][2], st2[1][3]);
            pb[s] = __builtin_bit_cast(bf16x8, pw); }
        const bf16* spf = SP + ((size_t)it * 2 + 0) * 8192; const bf16* spb = SP + ((size_t)it * 2 + 1) * 8192;
        const float xf = exp2f((float)(il + 1) * lgf), xb = exp2f((float)(128 - il) * lgb);
        f32x4 O[8]; float sm = 0.f;
#pragma unroll
        for (int me = 0; me < 8; ++me) { f32x4 cf = (f32x4){0.f, 0.f, 0.f, 0.f}, cb = cf;
#pragma unroll
            for (int s2 = 0; s2 < 2; ++s2) { const bf16x8 af = *(const bf16x8*)(spf + (16 * me + c) * 64 + 32 * s2 + 8 * g), ab = *(const bf16x8*)(spb + (16 * me + c) * 64 + 32 * s2 + 8 * g);
                cf = MFMA16(af, bq[s2], cf); cb = MFMA16(ab, bq[s2], cb); }
            f32x4 acc = cf * xf + cb * xb;
#pragma unroll
            for (int s = 0; s < 4; ++s) { const s16x4 lo = *(const LAS s16x4*)(Lvt + (16 * me + c) * RVP + 32 * s + 4 * g), hi = *(const LAS s16x4*)(Lvt + (16 * me + c) * RVP + 32 * s + 16 + 4 * g);
                const bf16x8 av = __builtin_shufflevector(lo, hi, 0, 1, 2, 3, 4, 5, 6, 7); acc = MFMA16(av, pb[s], acc); }
            O[me] = acc; sm += (acc[0] + acc[1]) + (acc[2] + acc[3]); }
        sm += __shfl_xor(sm, 16); sm += __shfl_xor(sm, 32);
        const float mean = sm * (1.f / 128.f); float sv = 0.f;
#pragma unroll
        for (int me = 0; me < 8; ++me) { O[me] = O[me] - mean; sv += (O[me][0] * O[me][0] + O[me][1] * O[me][1]) + (O[me][2] * O[me][2] + O[me][3] * O[me][3]); }
        sv += __shfl_xor(sv, 16); sv += __shfl_xor(sv, 32);
        const float rstd = 1.f / sqrtf(sv * (1.f / 128.f) + 1e-5f);
        const size_t grow = (size_t)(base + 128 * n + il);
#pragma unroll
        for (int me = 0; me < 8; ++me) { const int e = 16 * me + 4 * g;
            const v2u gw2 = *(const v2u*)(P + grow * NPAD + C_GB + 128 * h + e); const float gt[4] = {bflo(gw2.x), bfhi(gw2.x), bflo(gw2.y), bfhi(gw2.y)};
            const f32x4 wv = *(const f32x4*)(a.gn_w + 128 * h + e), bv = *(const f32x4*)(a.gn_b + 128 * h + e);
            float y[4];
#pragma unroll
            for (int r = 0; r < 4; ++r) y[r] = (O[me][r] * rstd * wv[r] + bv[r]) * silu_f(gt[r]);
            v2u ow; ow.x = pk2(y[0], y[1]); ow.y = pk2(y[2], y[3]); *(v2u*)(MIX + grow * D + 512 + 128 * h + e) = ow; }
    }
}

constexpr int N_PHASES = 12;
#ifndef N_LAUNCHES
#define N_LAUNCHES 1
#endif
__global__ void __launch_bounds__(NWAVES * 64, 2) fwd(Args a) {
    extern __shared__ __attribute__((aligned(16))) unsigned char lds[];
    Frame F; F.lds = (LAS unsigned char*)lds; F.tid = threadIdx.x; F.lane = F.tid & 63; F.wave = __builtin_amdgcn_readfirstlane(F.tid >> 6);
    F.gw = blockIdx.x * NWAVES + F.wave; F.NGW = gridDim.x * NWAVES;
    const int lo = a.ph_lo, hi = a.ph_hi;
    const float* mod = (const float*)(a.ws + WS_CTL + CTL_MOD_OFF);
    volatile LAS unsigned* MISC = (volatile LAS unsigned*)(F.lds + MISC_OFF);
    for (int u = F.tid; u < (LDS_BYTES - LDSCTL_OFF) / 4; u += NWAVES * 64) ((LAS unsigned*)(F.lds + LDSCTL_OFF))[u] = 0u;
    __syncthreads();
    XcdBarrier bar; bar.bar = (unsigned*)(a.ws + WS_CTL) + CW_BAR; bar.x = 0; bar.st = nullptr;
    if (hi - lo > 1) bar = xcd_barrier_post((unsigned*)(a.ws + WS_CTL) + CW_BAR, MISC + 8);
#define IN(k) (lo <= (k) && (k) < hi)
#define SEAM(k) do { if (IN(k) && IN((k) + 1)) xcd_barrier(bar); } while (0)
    if (IN(0)) p0_prologue(a, F);
    SEAM(0);
    if (IN(1)) p1_h(a, F);
    SEAM(1);
    if (IN(2)) { pg8::Gemm g{(const pg8::bf16_t*)(a.ws + WS_H), (const pg8::bf16_t*)(a.ws + WS_WIN), NROW, NPAD, D}; pg8::StaticOrder S; S.init(NROW, NPAD, gridDim.x, (int)blockIdx.x);
        pg8::EpiBf16<0> E{(pg8::bf16_t*)(a.ws + WS_P), NPAD, nullptr};
        pg8::gemm_phase<pg8::EpiBf16<0>, pg8::StaticOrder, true, true>(F.lds, g, S, E); }
    SEAM(2);
    if (IN(3)) { p3a_prep(a, F); ret_ra(a, F); }
    SEAM(3);
    if (IN(4)) { ret_rb(a, F); p3b_delta_naive(a, F); }
    SEAM(4);
    if (IN(5)) ret_rc(a, F);
    SEAM(5);
    if (IN(6)) p5_combine(a, F);
    SEAM(6);
    if (IN(7)) { pg8::Gemm g{(const pg8::bf16_t*)(a.ws + WS_H), (const pg8::bf16_t*)(a.ws + WS_WO), NROW, D, D}; pg8::StaticOrder S; S.init(NROW, D, gridDim.x, (int)blockIdx.x);
        pg8::EpiResid E{a.x_prompt, a.x_sample - (size_t)NPR * D, a.out, D, nullptr, mod + 2048, MODW, ALPHA_DN};
        pg8::gemm_phase<pg8::EpiResid, pg8::StaticOrder, true, true>(F.lds, g, S, E); }
    SEAM(7);
    if (IN(8)) p6b_ln1(a, F);
    SEAM(8);
    if (IN(9)) { pg8::Gemm g{(const pg8::bf16_t*)(a.ws + WS_H), (const pg8::bf16_t*)(a.ws + WS_W1), NROW, FF, D}; pg8::StaticOrder S; S.init(NROW, FF, gridDim.x, (int)blockIdx.x);
        pg8::EpiBf16<2> E{(pg8::bf16_t*)(a.ws + WS_P), FF, a.b_ff1};
        pg8::gemm_phase<pg8::EpiBf16<2>, pg8::StaticOrder, true, true>(F.lds, g, S, E); }
    SEAM(9);
    if (IN(10)) { pg8::Gemm g{(const pg8::bf16_t*)(a.ws + WS_P), (const pg8::bf16_t*)(a.ws + WS_W2), NROW, D, FF}; pg8::StaticOrder S; S.init(NROW, D, gridDim.x, (int)blockIdx.x);
        pg8::EpiResid E{a.out, a.out, a.out, D, a.b_ff2, mod + 5120, MODW, ALPHA_DN};
        pg8::gemm_phase<pg8::EpiResid, pg8::StaticOrder, true, true>(F.lds, g, S, E); }
    SEAM(10);
    if (IN(11)) p8b_ln2(a, F);
#undef IN
#undef SEAM
}

extern "C" void kernel_launch(void* const* d_in, const int* in_sizes, int n_in, void* d_out, int out_size, void* d_ws, size_t ws_size, hipStream_t stream) {
    static int grid = 0;
    if (grid == 0) {
        if (n_in != 24 || ws_size < WS_END || (size_t)out_size != OUT_SR + (size_t)16 * 2 * 4 * 64 * 128) { fprintf(stderr, "kernel_launch: unexpected problem: n_in %d out %d ws %zu\n", n_in, out_size, ws_size); grid = -1; return; }
        int dev = 0, cus = 0, per_cu = 0;
        if (hipGetDevice(&dev) != hipSuccess || hipDeviceGetAttribute(&cus, hipDeviceAttributeMultiprocessorCount, dev) != hipSuccess) { grid = -1; return; }
        if (hipFuncSetAttribute((const void*)fwd, hipFuncAttributeMaxDynamicSharedMemorySize, LDS_BYTES) != hipSuccess) { fprintf(stderr, "kernel_launch: hipFuncSetAttribute failed\n"); grid = -1; return; }
        if (hipOccupancyMaxActiveBlocksPerMultiprocessor(&per_cu, (const void*)fwd, NWAVES * 64, LDS_BYTES) != hipSuccess || per_cu < 1) { fprintf(stderr, "kernel_launch: occupancy query says %d workgroups per CU\n", per_cu); (void)hipGetLastError(); grid = -1; return; }
        grid = cus;
    }
    if (grid < 0) return;
    (void)hipMemsetAsync((char*)d_ws + WS_CTL, 0, CTL_ZERO_BYTES, stream);
    Args a{};
    const float** ap = (const float**)&a;
    for (int i = 0; i < 24; ++i) ap[i] = (const float*)d_in[i];
    a.out = (float*)d_out; a.ws = (unsigned char*)d_ws;
    if (N_LAUNCHES == 1) { a.ph_lo = 0; a.ph_hi = N_PHASES; hipLaunchKernelGGL(fwd, dim3(grid), dim3(NWAVES * 64), LDS_BYTES, stream, a); }
    else for (int p = 0; p < N_PHASES; ++p) { a.ph_lo = p; a.ph_hi = p + 1; hipLaunchKernelGGL(fwd, dim3(grid), dim3(NWAVES * 64), LDS_BYTES, stream, a); }
}
```

```cpp
#include <hip/hip_runtime.h>
#include <cstdio>
#include <cstdint>
namespace pg8 {
#define PG8_LAS __attribute__((address_space(3)))
typedef unsigned short bf16_t;
typedef short bf16x8 __attribute__((ext_vector_type(8)));
typedef float f32x4 __attribute__((ext_vector_type(4)));
typedef unsigned u32x4 __attribute__((ext_vector_type(4)));
constexpr int BM = 256, BK = 64, HALF = 128, HTB = HALF * BK * 2  , STAGE_BYTES = 8 * HTB, NXCD = 8, WGM = 8;

__host__ __device__ __forceinline__ int lds_byte(int r, int c) { const int st = (r >> 4) * 2 + (c >> 5), rr = r & 15, cc = c & 31, ob = rr * 64 + cc * 2; return st * 1024 + (ob ^ (((ob >> 9) & 1) << 5)); }
__host__ __device__ __forceinline__ void stage_rc(int b, int& R, int& C) { const int st = b / 1024, sb = b % 1024, swz = sb ^ (((sb >> 9) & 1) << 5); R = (st >> 1) * 16 + swz / 64; C = (st & 1) * 32 + (swz % 64) / 2; }
__host__ __device__ __forceinline__ int perm32(int rho) { const int n = rho >> 4, i = rho & 15; return 8 * (i >> 2) + 4 * n + (i & 3); }

struct Unit { int pm, pn; };
struct Gemm { const bf16_t* A; const bf16_t* Bt; int M, N, K; };

struct StaticOrder {
    int nM, nN, nwg, G, c;
    __host__ __device__ void init(int M, int N, int G_, int c_) { nM = M / BM; nN = N / BM; nwg = nM * nN; G = G_; c = c_; }
    __host__ __device__ bool next(int i, Unit& u) const {
        const long L = (long)i * G + c; if (L >= nwg) return false;
        int wgid = (int)L; { const int q = nwg / NXCD, r = nwg % NXCD, xcd = wgid % NXCD, off = wgid / NXCD; wgid = (xcd < r ? xcd * (q + 1) : r * (q + 1) + (xcd - r) * q) + off; }
        const int nig = WGM * nN, gid = wgid / nig, fm = gid * WGM, gsz = (nM - fm) < WGM ? (nM - fm) : WGM;
        u.pm = fm + ((wgid % nig) % gsz); u.pn = (wgid % nig) / gsz; return true;
    }
    __device__ __forceinline__ void a_ready(const Unit&) const {}
    __device__ __forceinline__ void done(const Unit&) const {}
};

__device__ __forceinline__ unsigned cvt_pk_bf16(float lo, float hi) { unsigned r; asm volatile("v_cvt_pk_bf16_f32 %0, %1, %2" : "=v"(r) : "v"(lo), "v"(hi)); return r; }
template <int ACT> struct EpiBf16 {
    static constexpr bool PERM = true, AFTER_DRAIN = false;
    bf16_t* O; int ldc; const float* bias;
    __device__ __forceinline__ void operator()(const f32x4 (&acc)[2][2][4][2], const Unit& u, int wr, int wc, int fr, int fq) const {
        const int row0 = u.pm * BM + wr * 64 + fr; const int col0 = u.pn * BM + wc * 32 + 8 * fq;
        f32x4 bv[2][2];
#pragma unroll
        for (int bj = 0; bj < 2; ++bj)
#pragma unroll
            for (int n = 0; n < 2; ++n) bv[bj][n] = bias ? *(const f32x4*)(bias + col0 + bj * HALF + 4 * n) : (f32x4){0.f, 0.f, 0.f, 0.f};
#pragma unroll
        for (int ai = 0; ai < 2; ++ai)
#pragma unroll
            for (int m = 0; m < 4; ++m) { bf16_t* rowp = O + (size_t)(row0 + ai * HALF + m * 16) * ldc + col0;
#pragma unroll
                for (int bj = 0; bj < 2; ++bj) { f32x4 v0 = acc[ai][bj][m][0] + bv[bj][0], v1 = acc[ai][bj][m][1] + bv[bj][1];
                    if (ACT == 2) {
#pragma unroll
                        for (int i = 0; i < 4; ++i) { const float a = v0[i] > 0.f ? v0[i] : 0.f, b = v1[i] > 0.f ? v1[i] : 0.f; v0[i] = a * a; v1[i] = b * b; } }
                    u32x4 w; w.x = cvt_pk_bf16(v0[0], v0[1]); w.y = cvt_pk_bf16(v0[2], v0[3]); w.z = cvt_pk_bf16(v1[0], v1[1]); w.w = cvt_pk_bf16(v1[2], v1[3]);
                    *(u32x4*)(rowp + bj * HALF) = w; } }
    }
};
struct EpiResid {
    static constexpr bool PERM = false, AFTER_DRAIN = false;
    const float* base0; const float* base1; float* out; int ldc; const float* bias; const float* gate; int gate_pitch; float alpha;
    __device__ __forceinline__ void operator()(const f32x4 (&acc)[2][2][4][2], const Unit& u, int wr, int wc, int fr, int fq) const {
        const int row0 = u.pm * BM + wr * 64 + fr; const int col0 = u.pn * BM + wc * 32 + 4 * fq;
        const int r0 = u.pm * BM; const int vrow = r0 < 4096 ? 0 : 1 + ((r0 - 4096) >> 12);
        const float* gp = gate + (size_t)vrow * gate_pitch; const float* base = r0 < 4096 ? base0 : base1;
        f32x4 bv[2][2], gv[2][2];
#pragma unroll
        for (int bj = 0; bj < 2; ++bj)
#pragma unroll
            for (int n = 0; n < 2; ++n) { bv[bj][n] = bias ? *(const f32x4*)(bias + col0 + bj * HALF + n * 16) : (f32x4){0.f, 0.f, 0.f, 0.f}; gv[bj][n] = *(const f32x4*)(gp + col0 + bj * HALF + n * 16); }
#pragma unroll
        for (int ai = 0; ai < 2; ++ai)
#pragma unroll
            for (int m = 0; m < 4; ++m) { const size_t off = (size_t)(row0 + ai * HALF + m * 16) * ldc + col0;
#pragma unroll
                for (int bj = 0; bj < 2; ++bj)
#pragma unroll
                    for (int n = 0; n < 2; ++n) { const f32x4 bs = *(const f32x4*)(base + off + bj * HALF + n * 16);
                        const f32x4 o = bs * alpha + gv[bj][n] * (acc[ai][bj][m][n] + bv[bj][n]);
                        *(f32x4*)(out + off + bj * HALF + n * 16) = o; } }
    }
};

template <class Epi, class Sched, bool ALIGN_EPI = false, bool SP2 = false>
__device__ __forceinline__ void gemm_phase(PG8_LAS unsigned char* lds, const Gemm g, const Sched& S, const Epi& E) {
    const int tid = threadIdx.x, wid = __builtin_amdgcn_readfirstlane(tid >> 6), lane = tid & 63, wr = wid >> 2, wc = wid & 3, fr = lane & 15, fq = lane >> 4;
    const int K = g.K, nt = K / BK;
    unsigned voffA[2], voffB[2];
#pragma unroll
    for (int i = 0; i < 2; ++i) { int R, C; stage_rc(tid * 16 + i * 8192, R, C); const int Rb = Epi::PERM ? ((R & ~31) + perm32(R & 31)) : R;
        voffA[i] = (unsigned)(R * K + C) * 2u; voffB[i] = (unsigned)(Rb * K + C) * 2u; }
    const size_t kstep = (size_t)(BK * 2);
    const size_t hstep = (size_t)HALF * K * 2;
    const size_t tstep = 2 * hstep;
    const unsigned ldsw = (unsigned)wid * 1024u;
    const int aoff = lds_byte(wr * 64 + fr, fq * 8), boff = lds_byte(wc * 32 + fr, fq * 8);
#define PG8_SA(b, h) (((b) * 2 + (h)) * HTB)
#define PG8_SB(b, h) ((4 + (b) * 2 + (h)) * HTB)
#define PG8_STAGE(bufoff, gbase, voff) do { _Pragma("unroll") for (int _i = 0; _i < 2; ++_i) \
        __builtin_amdgcn_global_load_lds((const unsigned*)((const char*)(gbase) + (voff)[_i]), (PG8_LAS unsigned*)(lds + (bufoff) + ldsw + _i * 8192), 16, 0, 0); } while (0)
#define PG8_LDA(dst, b, h) do { _Pragma("unroll") for (int m = 0; m < 4; ++m) _Pragma("unroll") for (int k = 0; k < 2; ++k) dst[m][k] = *(const PG8_LAS bf16x8*)(lds + PG8_SA(b, h) + aoff + m * 2048 + k * 1024); } while (0)
#define PG8_LDB(dst, b, h) do { _Pragma("unroll") for (int n = 0; n < 2; ++n) _Pragma("unroll") for (int k = 0; k < 2; ++k) dst[n][k] = *(const PG8_LAS bf16x8*)(lds + PG8_SB(b, h) + boff + n * 2048 + k * 1024); } while (0)
#define PG8_MMA(ai, bj, At, Bt) do { __builtin_amdgcn_s_setprio(1); _Pragma("unroll") for (int m = 0; m < 4; ++m) _Pragma("unroll") for (int n = 0; n < 2; ++n) _Pragma("unroll") for (int k = 0; k < 2; ++k) \
        acc[ai][bj][m][n] = __builtin_amdgcn_mfma_f32_16x16x32_bf16(Bt[n][k], At[m][k], acc[ai][bj][m][n], 0, 0, 0); __builtin_amdgcn_s_setprio(0); } while (0)
#define PG8_WAIT_V(n) asm volatile("s_waitcnt vmcnt(" #n ")" ::: "memory")
#define PG8_WAIT_L(n) asm volatile("s_waitcnt lgkmcnt(" #n ")" ::: "memory")
#define PG8_BAR __builtin_amdgcn_s_barrier()
#define PG8_SCHED __builtin_amdgcn_sched_barrier(0)
    Unit cur, nxt; int ui = 0;
    if (!S.next(0, cur)) return;
    f32x4 acc[2][2][4][2];
#pragma unroll
    for (int a = 0; a < 2; ++a)
#pragma unroll
        for (int b = 0; b < 2; ++b)
#pragma unroll
            for (int m = 0; m < 4; ++m)
#pragma unroll
                for (int n = 0; n < 2; ++n) acc[a][b][m][n] = (f32x4){0.f, 0.f, 0.f, 0.f};
    bf16x8 At[4][2], B0[2][2], B1[2][2];
    const char* cA = (const char*)g.A + (size_t)cur.pm * tstep; const char* cB = (const char*)g.Bt + (size_t)cur.pn * tstep;
    S.a_ready(cur);
    if constexpr (SP2) {
        PG8_STAGE(PG8_SB(0, 0), cB, voffB); PG8_STAGE(PG8_SB(0, 1), cB + hstep, voffB); PG8_STAGE(PG8_SA(0, 0), cA, voffA); PG8_STAGE(PG8_SA(0, 1), cA + hstep, voffA);
        if (wr == 1) PG8_BAR;
        PG8_WAIT_V(2); PG8_BAR;
        PG8_STAGE(PG8_SB(1, 0), cB + kstep, voffB); PG8_STAGE(PG8_SA(1, 0), cA + kstep, voffA); PG8_STAGE(PG8_SB(1, 1), cB + hstep + kstep, voffB);
        PG8_WAIT_V(6); PG8_BAR;
    } else {
        PG8_STAGE(PG8_SB(0, 0), cB, voffB); PG8_STAGE(PG8_SA(0, 0), cA, voffA); PG8_STAGE(PG8_SB(0, 1), cB + hstep, voffB); PG8_STAGE(PG8_SA(0, 1), cA + hstep, voffA);
        if (wr == 1) PG8_BAR;
        PG8_WAIT_V(4); PG8_BAR;
        PG8_STAGE(PG8_SB(1, 0), cB + kstep, voffB); PG8_STAGE(PG8_SA(1, 0), cA + kstep, voffA); PG8_STAGE(PG8_SB(1, 1), cB + hstep + kstep, voffB);
        PG8_WAIT_V(6); PG8_BAR;
    }
    for (;;) {
        const bool has_next = S.next(ui + 1, nxt);
        const char* nA = has_next ? (const char*)g.A + (size_t)nxt.pm * tstep : cA; const char* nB = has_next ? (const char*)g.Bt + (size_t)nxt.pn * tstep : cB;
        for (int t = 0; t < nt; t += 2) {
            const bool last = (t == nt - 2);
            const char* a1 = cA + (size_t)(t + 1) * kstep;
            const char* a2 = last ? nA : cA + (size_t)(t + 2) * kstep; const char* b2 = last ? nB : cB + (size_t)(t + 2) * kstep;
            const char* a3 = a2 + kstep; const char* b3 = b2 + kstep;
            if (last && has_next) S.a_ready(nxt);
            if constexpr (SP2) {
            PG8_LDB(B0, 0, 0); PG8_LDB(B1, 0, 1); PG8_SCHED; PG8_LDA(At, 0, 0); PG8_STAGE(PG8_SA(1, 1), a1 + hstep, voffA);
            PG8_WAIT_V(8); PG8_WAIT_L(0); PG8_BAR; PG8_MMA(0, 0, At, B0); PG8_MMA(0, 1, At, B1); PG8_BAR; PG8_SCHED;
            PG8_LDA(At, 0, 1); PG8_STAGE(PG8_SB(0, 0), b2, voffB); PG8_STAGE(PG8_SB(0, 1), b2 + hstep, voffB); PG8_STAGE(PG8_SA(0, 0), a2, voffA);
            PG8_WAIT_V(8); PG8_WAIT_L(0); PG8_BAR; PG8_MMA(1, 0, At, B0); PG8_MMA(1, 1, At, B1); PG8_BAR; PG8_SCHED;
            PG8_LDB(B0, 1, 0); PG8_LDB(B1, 1, 1); PG8_SCHED; PG8_LDA(At, 1, 0); PG8_STAGE(PG8_SA(0, 1), a2 + hstep, voffA);
            PG8_WAIT_V(8); PG8_WAIT_L(0); PG8_BAR; PG8_MMA(0, 0, At, B0); PG8_MMA(0, 1, At, B1); PG8_BAR; PG8_SCHED;
            PG8_LDA(At, 1, 1); PG8_STAGE(PG8_SB(1, 0), b3, voffB); PG8_STAGE(PG8_SB(1, 1), b3 + hstep, voffB); PG8_STAGE(PG8_SA(1, 0), a3, voffA);
            PG8_WAIT_V(8); PG8_WAIT_L(0); PG8_BAR; PG8_MMA(1, 0, At, B0); PG8_MMA(1, 1, At, B1); PG8_BAR; PG8_SCHED;
            } else {
            PG8_LDB(B0, 0, 0); PG8_SCHED; PG8_LDA(At, 0, 0); PG8_STAGE(PG8_SA(1, 1), a1 + hstep, voffA);
            PG8_WAIT_L(8); PG8_BAR; PG8_WAIT_L(0); PG8_MMA(0, 0, At, B0); PG8_BAR; PG8_SCHED;
            PG8_LDB(B1, 0, 1); PG8_STAGE(PG8_SB(0, 0), b2, voffB);
            PG8_BAR; PG8_WAIT_L(0); PG8_MMA(0, 1, At, B1); PG8_BAR;
            PG8_LDA(At, 0, 1); PG8_STAGE(PG8_SA(0, 0), a2, voffA);
            PG8_BAR; PG8_WAIT_L(0); PG8_MMA(1, 0, At, B0); PG8_BAR; PG8_SCHED;
            PG8_STAGE(PG8_SB(0, 1), b2 + hstep, voffB);
            PG8_WAIT_V(6); PG8_BAR; PG8_MMA(1, 1, At, B1); PG8_BAR;
            PG8_LDB(B0, 1, 0); PG8_SCHED; PG8_LDA(At, 1, 0); PG8_STAGE(PG8_SA(0, 1), a2 + hstep, voffA);
            PG8_WAIT_L(8); PG8_BAR; PG8_WAIT_L(0); PG8_MMA(0, 0, At, B0); PG8_BAR; PG8_SCHED;
            PG8_LDB(B1, 1, 1); PG8_STAGE(PG8_SB(1, 0), b3, voffB);
            PG8_BAR; PG8_WAIT_L(0); PG8_MMA(0, 1, At, B1); PG8_BAR;
            PG8_LDA(At, 1, 1); PG8_STAGE(PG8_SA(1, 0), a3, voffA);
            PG8_BAR; PG8_WAIT_L(0); PG8_MMA(1, 0, At, B0); PG8_BAR; PG8_SCHED;
            PG8_STAGE(PG8_SB(1, 1), b3 + hstep, voffB);
            PG8_WAIT_V(6); PG8_BAR; PG8_MMA(1, 1, At, B1); PG8_BAR;
            }
        }
        if constexpr (ALIGN_EPI) { if (wr == 0) PG8_BAR; }
        if constexpr (!Epi::AFTER_DRAIN) { E(acc, cur, wr, wc, fr, fq); S.done(cur); }
        if (!has_next) break;
#pragma unroll
        for (int a = 0; a < 2; ++a)
#pragma unroll
            for (int b = 0; b < 2; ++b)
#pragma unroll
                for (int m = 0; m < 4; ++m)
#pragma unroll
                    for (int n = 0; n < 2; ++n) acc[a][b][m][n] = (f32x4){0.f, 0.f, 0.f, 0.f};
        cur = nxt; cA = nA; cB = nB; ++ui;
        if constexpr (ALIGN_EPI) { if (wr == 1) PG8_BAR; }
    }
    PG8_WAIT_V(0);
    if constexpr (!ALIGN_EPI) { if (wr == 0) PG8_BAR; }
    PG8_BAR;
    if constexpr (Epi::AFTER_DRAIN) { E.fused(acc, cur, wr, wc, fr, fq, lds, wid, lane); S.done(cur); }
#undef PG8_SA
#undef PG8_SB
#undef PG8_STAGE
#undef PG8_LDA
#undef PG8_LDB
#undef PG8_MMA
#undef PG8_WAIT_V
#undef PG8_WAIT_L
#undef PG8_BAR
#undef PG8_SCHED
}
}

constexpr int NWAVES = 8;
constexpr int D = 1024, FF = 4096, NROW = 20480, NPR = 4096;
constexpr int NPAD = 3840;
constexpr int C_QA = 0, C_KA = 512, C_VA = 1024, C_GA = 1536, C_QB = 2048, C_KB = 2304, C_VB = 2560, C_GB = 3072, C_AL = 3584, C_BE = 3592;
constexpr int NMODV = 5, MODW = 6144;
constexpr float ALPHA_DN = 1.189207115002721f;
constexpr size_t MiB = 1u << 20;
constexpr size_t WS_CTL = 0, CTL_ZERO_BYTES = 1 * MiB;
constexpr size_t CTL_MOD_OFF = 65536;
constexpr int CW_BAR = 4096;
constexpr int LDS_BYTES = 147456;
constexpr int LDSCTL_OFF = 131072, MISC_OFF = LDSCTL_OFF + 320;
constexpr size_t WS_WIN = 1 * MiB, WS_WO = 9 * MiB, WS_W1 = 11 * MiB, WS_W2 = 19 * MiB;
constexpr size_t WS_H = 27 * MiB;
constexpr size_t WS_MIX = WS_H;
constexpr size_t WS_P = 67 * MiB;
constexpr size_t WS_GB = 228 * MiB;
constexpr size_t WS_RB = 230 * MiB;
constexpr size_t WS_END = 250 * MiB;
constexpr size_t OUT_Y = (size_t)NROW * D, OUT_SD = OUT_Y, OUT_SR = OUT_SD + (size_t)16 * 2 * 4 * 128 * 128;

#define LAS __attribute__((address_space(3)))
typedef unsigned short bf16;
typedef unsigned v4u __attribute__((ext_vector_type(4)));
typedef unsigned v2u __attribute__((ext_vector_type(2)));
typedef float f32x4 __attribute__((ext_vector_type(4)));
#define LDS_WAIT() asm volatile("s_waitcnt lgkmcnt(0)" ::: "memory")
__device__ __forceinline__ unsigned f2bf(float f) { unsigned u = __builtin_bit_cast(unsigned, f); return (u + 0x7fffu + ((u >> 16) & 1u)) >> 16; }
__device__ __forceinline__ unsigned pk2(float lo, float hi) { return f2bf(lo) | (f2bf(hi) << 16); }
__device__ __forceinline__ float bf2f(unsigned short h) { return __builtin_bit_cast(float, (unsigned)h << 16); }
__device__ __forceinline__ float bflo(unsigned w) { return __builtin_bit_cast(float, w << 16); }
__device__ __forceinline__ float bfhi(unsigned w) { return __builtin_bit_cast(float, w & 0xffff0000u); }
__device__ __forceinline__ float wave_sum(float v) {
#pragma unroll
    for (int o = 1; o < 64; o <<= 1) v += __shfl_xor(v, o);
    return v;
}
__device__ __forceinline__ float g16_sum(float v) {
#pragma unroll
    for (int o = 1; o < 16; o <<= 1) v += __shfl_xor(v, o);
    return v;
}
__device__ __forceinline__ float silu_f(float x) { return x / (1.f + __expf(-x)); }

struct Args {
    const float *x_prompt, *x_sample, *c, *state_delta, *state_ret, *c_ctx, *w_mod, *b_mod, *w_in, *conv_w, *a_log, *dt_bias, *norm_a_w, *gn_w, *gn_b, *w_o,
                *ln1_w, *ln1_b, *w_ff1, *b_ff1, *w_ff2, *b_ff2, *ln2_w, *ln2_b;
    float* out; unsigned char* ws; int ph_lo, ph_hi;
};
struct Frame { LAS unsigned char* lds; int tid, lane, wave, gw, NGW; };

__device__ __forceinline__ const float* xrow_ptr(const Args& a, int r) { return r < NPR ? a.x_prompt + (size_t)r * D : a.x_sample + (size_t)(r - NPR) * D; }
__device__ __forceinline__ int vrow_of(int r) { return r < NPR ? 0 : 1 + ((r - NPR) >> 12); }

__device__ __forceinline__ int map_in(int nd) { return nd < 2048 ? nd : (nd < 3584 ? nd + 16 : (nd < 3600 ? nd - 3584 + 2048 : -1)); }
template <bool MAP> __device__ __forceinline__ void transpose_item(const float* W, int K, int N, int nblk, bf16* WT, LAS float* scr, int item, int lane) {
    const int kb = item / nblk, nb = item % nblk, k0 = 64 * kb, n0 = 32 * nb;
    const int nd = n0 + (lane & 31), ns = MAP ? map_in(nd) : nd;
#pragma unroll 8
    for (int i = 0; i < 32; ++i) { const int kk = 2 * i + (lane >> 5); scr[kk * 33 + (lane & 31)] = ns >= 0 ? W[(size_t)(k0 + kk) * N + ns] : 0.f; }
    LDS_WAIT(); asm volatile("" ::: "memory");
    const int c = lane & 7;
#pragma unroll
    for (int j = 0; j < 4; ++j) { const int n = (lane >> 3) + 8 * j; const LAS float* s = scr + (8 * c) * 33 + n;
        v4u o; o.x = pk2(s[0 * 33], s[1 * 33]); o.y = pk2(s[2 * 33], s[3 * 33]); o.z = pk2(s[4 * 33], s[5 * 33]); o.w = pk2(s[6 * 33], s[7 * 33]);
        *(v4u*)(WT + (size_t)(n0 + n) * K + k0 + 8 * c) = o; }
    LDS_WAIT(); asm volatile("" ::: "memory");
}
__device__ __forceinline__ void p0_prologue(const Args& a, Frame& F) {
    LAS float* scr = (LAS float*)(F.lds + F.wave * 16384);
    bf16* Win_t = (bf16*)(a.ws + WS_WIN);
    constexpr int I_IN = (D / 64) * (NPAD / 32);
    constexpr int I_MOD = 96 * 8;
    constexpr int NITEMS = I_MOD + I_IN;
    float* mod = (float*)(a.ws + WS_CTL + CTL_MOD_OFF);
    for (int it = F.gw; it < NITEMS; it += F.NGW) {
        int r = it;
        if (r < I_MOD) {
            const int cg = r % 96, ks = r / 96, e = cg * 64 + F.lane;
            float acc[NMODV];
#pragma unroll
            for (int v = 0; v < NMODV; ++v) acc[v] = 0.f;
            for (int dd = 0; dd < 128; ++dd) { const int d = ks * 128 + dd; const float wv = a.w_mod[(size_t)d * MODW + e];
#pragma unroll
                for (int v = 0; v < NMODV; ++v) { const float cv = v == 0 ? a.c_ctx[d] : a.c[(v - 1) * D + d]; acc[v] += silu_f(cv) * wv; } }
            const float bb = ks == 0 ? a.b_mod[e] : 0.f;
#pragma unroll
            for (int v = 0; v < NMODV; ++v) atomicAdd(mod + v * MODW + e, acc[v] + bb);
            continue; }
        r -= I_MOD;
        transpose_item<true>(a.w_in, D, 3600, NPAD / 32, Win_t, scr, r, F.lane);
    }
}
__device__ __forceinline__ void late_weights(const Args& a, Frame& F) {
    LAS float* scr = (LAS float*)(F.lds + F.wave * 16384);
    bf16* Wo_t = (bf16*)(a.ws + WS_WO); bf16* W1_t = (bf16*)(a.ws + WS_W1); bf16* W2_t = (bf16*)(a.ws + WS_W2);
    constexpr int I_O = (D / 64) * (D / 32), I_1 = (D / 64) * (FF / 32), I_2 = (FF / 64) * (D / 32);
    for (int it = F.gw; it < I_O + I_1 + I_2; it += F.NGW) {
        int r = it;
        if (r < I_O) { transpose_item<false>(a.w_o, D, D, D / 32, Wo_t, scr, r, F.lane); continue; } r -= I_O;
        if (r < I_1) { transpose_item<false>(a.w_ff1, D, FF, FF / 32, W1_t, scr, r, F.lane); continue; } r -= I_1;
        transpose_item<false>(a.w_ff2, FF, D, D / 32, W2_t, scr, r, F.lane);
    }
}

__device__ __forceinline__ void ln_stats(const f32x4 (&v)[4], float eps, float& mean, float& rstd) {
    float s = 0.f;
#pragma unroll
    for (int j = 0; j < 4; ++j) s += (v[j].x + v[j].y) + (v[j].z + v[j].w);
    mean = wave_sum(s) * (1.f / D); float s2 = 0.f;
#pragma unroll
    for (int j = 0; j < 4; ++j) { const f32x4 d = v[j] - mean; s2 += (d.x * d.x + d.y * d.y) + (d.z * d.z + d.w * d.w); }
    rstd = 1.f / sqrtf(wave_sum(s2) * (1.f / D) + eps);
}
__device__ __forceinline__ void p1_h(const Args& a, Frame& F) {
    const float* mod = (const float*)(a.ws + WS_CTL + CTL_MOD_OFF); bf16* H = (bf16*)(a.ws + WS_H);
    for (int r = F.gw; r < NROW; r += F.NGW) {
        const f32x4* xr = (const f32x4*)xrow_ptr(a, r) + F.lane; const float* mv = mod + (size_t)vrow_of(r) * MODW;
        f32x4 v[4];
#pragma unroll
        for (int j = 0; j < 4; ++j) v[j] = xr[64 * j];
        float mean, rstd; ln_stats(v, 1e-6f, mean, rstd);
        unsigned long long* o8 = (unsigned long long*)(H + (size_t)r * D) + F.lane;
#pragma unroll
        for (int j = 0; j < 4; ++j) { const f32x4 sh = *((const f32x4*)mv + F.lane + 64 * j), sc = *((const f32x4*)(mv + 1024) + F.lane + 64 * j);
            const f32x4 h = (v[j] - mean) * rstd * (sc + 1.f) + sh;
            o8[64 * j] = (unsigned long long)pk2(h.x, h.y) | ((unsigned long long)pk2(h.z, h.w) << 32); }
    }
}
#define XB_TMO      128
#define XB_XCNT(j)  (256  + 64 * (j))
#define XB_XSUB(j)  (1280 + 64 * (j))
#define XB_XGEN(j)  (2304 + 64 * (j))
#define XB_TOP      3328
#define XB_TOPGEN   3392
#define XCD_BAR_WORDS 3456
#define XB_SPIN_CAP (1u << 22)

__device__ __forceinline__ unsigned xb_ld(unsigned* p)              { return __hip_atomic_load(p, __ATOMIC_RELAXED, __HIP_MEMORY_SCOPE_AGENT); }
__device__ __forceinline__ unsigned xb_add(unsigned* p, unsigned v) { return __hip_atomic_fetch_add(p, v, __ATOMIC_RELAXED, __HIP_MEMORY_SCOPE_AGENT); }
__device__ __forceinline__ unsigned xb_xcc_id() { return (unsigned)__builtin_amdgcn_s_getreg((3 << 11) | 20) & 0xFu; }
#define XB_SPIN(cond, bar) do { unsigned _sp = 0; while (cond) { __builtin_amdgcn_s_sleep(1); \
    if ((++_sp & 255u) == 0u) { if (xb_ld(&(bar)[XB_TMO])) break; if (_sp > XB_SPIN_CAP) { atomicAdd(&(bar)[XB_TMO], 1u); break; } } } } while (0)

struct XcdBarrier {
    unsigned* bar; unsigned x;
    volatile LAS unsigned* st;
};

__device__ __forceinline__ XcdBarrier xcd_barrier_post(unsigned* bar, volatile LAS unsigned* st) {
    XcdBarrier b; b.bar = bar; b.x = xb_xcc_id(); b.st = st;
    if (threadIdx.x == 0) (void)xb_add(&bar[XB_XCNT(b.x)], 1u);
    return b;
}
__device__ __forceinline__ void xcd_barrier_complete(unsigned* bar, unsigned x, unsigned& nloc, unsigned& nx) {
    const unsigned G = gridDim.x * gridDim.y * gridDim.z;
    unsigned sum, cnt, mine, sp = 0u;
    for (;;) {
        sum = 0u; cnt = 0u; mine = 0u;
#pragma unroll
        for (unsigned j = 0; j < 16; ++j) { const unsigned c = xb_ld(&bar[XB_XCNT(j)]); sum += c; cnt += (c > 0u) ? 1u : 0u; mine = (j == x) ? c : mine; }
        if (sum == G) break;
        __builtin_amdgcn_s_sleep(1);
        if ((++sp & 255u) == 0u) { if (xb_ld(&bar[XB_TMO])) break; if (sp > XB_SPIN_CAP) { atomicAdd(&bar[XB_TMO], 1u); break; } }
    }
    nloc = mine > 0u ? mine : 1u; nx = cnt > 0u ? cnt : 1u;
}

__device__ __forceinline__ void xcd_barrier(const XcdBarrier& b) {
    asm volatile("s_waitcnt vmcnt(0)" ::: "memory");
    __syncthreads();
    if (threadIdx.x == 0) {
        unsigned* bar = b.bar;
        __builtin_amdgcn_s_waitcnt(0);
        unsigned nloc = b.st[0], nx = b.st[1];
        if (nloc == 0u) { xcd_barrier_complete(bar, b.x, nloc, nx); b.st[0] = nloc; b.st[1] = nx; }
        const unsigned old = xb_add(&bar[XB_XSUB(b.x)], 1u);
        const unsigned gen = old / nloc;
        if (old + 1u == (gen + 1u) * nloc) {
            __builtin_amdgcn_fence(__ATOMIC_RELEASE, "agent");
            asm volatile("s_waitcnt vmcnt(0)" ::: "memory");
            const unsigned og = xb_add(&bar[XB_TOP], 1u);
            const unsigned tg = og / nx;
            if (og + 1u == (tg + 1u) * nx) xb_add(&bar[XB_TOPGEN], 1u);
            else XB_SPIN(xb_ld(&bar[XB_TOPGEN]) == tg, bar);
            __builtin_amdgcn_fence(__ATOMIC_ACQUIRE, "agent");
            xb_add(&bar[XB_XGEN(b.x)], 1u);
            asm volatile("s_waitcnt vmcnt(0)" ::: "memory");
        } else {
            XB_SPIN(xb_ld(&bar[XB_XGEN(b.x)]) == gen, bar);
            __builtin_amdgcn_fence(__ATOMIC_ACQUIRE, "agent");
            asm volatile("s_waitcnt vmcnt(0)" ::: "memory");
        }
    }
    __syncthreads();
}
__device__ __forceinline__ void seq_of_row(int r, int& base, int& T, int& t) { if (r < NPR) { base = r & ~255; T = 256; t = r & 255; } else { const int q = r - NPR; base = NPR + (q & ~4095); T = 4096; t = q & 4095; } }
__device__ __forceinline__ void unpack8(const v4u w, float (&f)[8]) { f[0] = bflo(w.x); f[1] = bfhi(w.x); f[2] = bflo(w.y); f[3] = bfhi(w.y); f[4] = bflo(w.z); f[5] = bfhi(w.z); f[6] = bflo(w.w); f[7] = bfhi(w.w); }
__device__ __forceinline__ v4u pack8(const float (&f)[8]) { v4u w; w.x = pk2(f[0], f[1]); w.y = pk2(f[2], f[3]); w.z = pk2(f[4], f[5]); w.w = pk2(f[6], f[7]); return w; }

__device__ __forceinline__ void p5_combine(const Args& a, Frame& F) {
    const bf16* P = (const bf16*)(a.ws + WS_P);
    bf16* MIX = (bf16*)(a.ws + WS_MIX); const int l = F.lane;
    for (int r = F.gw; r < NROW; r += F.NGW) {
        const bf16* rp = P + (size_t)r * NPAD;
        float x0[8], x1[8], gt[8], o[8];
        unpack8(*(const v4u*)(rp + 8 * l), x0); unpack8(*(const v4u*)(rp + 512 + 8 * l), x1); unpack8(*(const v4u*)(rp + C_GA + 8 * l), gt);
        float ss = 0.f;
#pragma unroll
        for (int i = 0; i < 8; ++i) { x0[i] += x1[i]; ss += x0[i] * x0[i]; }
        ss = g16_sum(ss); const float rs = 1.f / sqrtf(ss * (1.f / 128.f) + 1e-6f);
#pragma unroll
        for (int i = 0; i < 8; ++i) o[i] = x0[i] * rs * a.norm_a_w[(8 * l + i) & 127] * silu_f(gt[i]);
        *(v4u*)(MIX + (size_t)r * D + 8 * l) = pack8(o);
    }
}

__device__ __forceinline__ void p6b_ln1(const Args& a, Frame& F) {
    const float* mod = (const float*)(a.ws + WS_CTL + CTL_MOD_OFF); bf16* H2 = (bf16*)(a.ws + WS_H);
    for (int r = F.gw; r < NROW; r += F.NGW) {
        f32x4* zr = (f32x4*)(a.out + (size_t)r * D) + F.lane; const float* mv = mod + (size_t)vrow_of(r) * MODW;
        f32x4 v[4];
#pragma unroll
        for (int j = 0; j < 4; ++j) v[j] = zr[64 * j];
        float mean, rstd; ln_stats(v, 1e-6f, mean, rstd);
#pragma unroll
        for (int j = 0; j < 4; ++j) { const f32x4 w = *((const f32x4*)a.ln1_w + F.lane + 64 * j), b = *((const f32x4*)a.ln1_b + F.lane + 64 * j);
            v[j] = (v[j] - mean) * rstd * w + b; zr[64 * j] = v[j]; }
        ln_stats(v, 1e-6f, mean, rstd);
        unsigned long long* o8 = (unsigned long long*)(H2 + (size_t)r * D) + F.lane;
#pragma unroll
        for (int j = 0; j < 4; ++j) { const f32x4 sh = *((const f32x4*)(mv + 3072) + F.lane + 64 * j), sc = *((const f32x4*)(mv + 4096) + F.lane + 64 * j);
            const f32x4 h = (v[j] - mean) * rstd * (sc + 1.f) + sh;
            o8[64 * j] = (unsigned long long)pk2(h.x, h.y) | ((unsigned long long)pk2(h.z, h.w) << 32); }
    }
}
__device__ __forceinline__ void p8b_ln2(const Args& a, Frame& F) {
    for (int r = F.gw; r < NROW; r += F.NGW) {
        f32x4* zr = (f32x4*)(a.out + (size_t)r * D) + F.lane;
        f32x4 v[4];
#pragma unroll
        for (int j = 0; j < 4; ++j) v[j] = zr[64 * j];
        float mean, rstd; ln_stats(v, 1e-6f, mean, rstd);
#pragma unroll
        for (int j = 0; j < 4; ++j) { const f32x4 w = *((const f32x4*)a.ln2_w + F.lane + 64 * j), b = *((const f32x4*)a.ln2_b + F.lane + 64 * j);
            zr[64 * j] = (v[j] - mean) * rstd * w + b; }
    }
}
constexpr int RL_Q = 0, RL_K = 18432, RL_VT = 36864, RL_KTF = 71680, RL_KTB = 89088;
constexpr int RQP = 72, RVP = 136;
typedef short bf16x8 __attribute__((ext_vector_type(8)));
typedef short s16x4 __attribute__((ext_vector_type(4)));
#define MFMA16(a, b, c) __builtin_amdgcn_mfma_f32_16x16x32_bf16((a), (b), (c), 0, 0, 0)
constexpr size_t WS_SP = WS_RB;

__device__ __forceinline__ void ret_item(int it, int& base, int& n, int& h, bool& smp) {
    if (it < 512) { smp = true; h = it & 3; n = (it >> 2) & 31; base = NPR + (it >> 7) * 4096; }
    else { const int q = it - 512; smp = false; h = q & 3; n = (q >> 2) & 1; base = (q >> 3) * 256; }
}
__device__ __forceinline__ float lg2gamma(int hg) { return log2f(1.f - exp2f(-5.f - (float)hg)); }

template <bool NEED_QK, bool NEED_KT>
__device__ __forceinline__ void ret_stage(const Args& a, Frame& F, int base, int n, int h, bool smp) {
    const bf16* P = (const bf16*)(a.ws + WS_P);
    LAS bf16* Lq = (LAS bf16*)(F.lds + RL_Q); LAS bf16* Lk = (LAS bf16*)(F.lds + RL_K); LAS bf16* Lvt = (LAS bf16*)(F.lds + RL_VT);
    LAS bf16* Lkf = (LAS bf16*)(F.lds + RL_KTF); LAS bf16* Lkb = (LAS bf16*)(F.lds + RL_KTB);
    const int t = F.tid, row = t >> 2, pc = t & 3, tpos = 128 * n + row;
    const bf16* rp = P + (size_t)(base + tpos) * NPAD;
    { const int j0 = pc * 8;
      float q1[8], q2[8], k1[8], k2[8];
      if (NEED_QK) { unpack8(*(const v4u*)(rp + C_QB + 64 * h + j0), q1); unpack8(*(const v4u*)(rp + C_QB + 64 * h + 32 + j0), q2); }
      unpack8(*(const v4u*)(rp + C_KB + 64 * h + j0), k1); unpack8(*(const v4u*)(rp + C_KB + 64 * h + 32 + j0), k2);
      if (smp) { const float pos = (pc < 2) ? (float)(tpos >> 6) : (float)(tpos & 63);
#pragma unroll
          for (int i = 0; i < 8; ++i) { const int f = (j0 + i) & 15; const float ang = pos * exp2f(-(float)f * 0.83048202372184059f); float sn, cs; __sincosf(ang, &sn, &cs);
              if (NEED_QK) { const float x1 = q1[i], x2 = q2[i]; q1[i] = x1 * cs - x2 * sn; q2[i] = x1 * sn + x2 * cs; }
              const float y1 = k1[i], y2 = k2[i]; k1[i] = y1 * cs - y2 * sn; k2[i] = y1 * sn + y2 * cs; } }
      if (NEED_QK) {
#pragma unroll
          for (int i = 0; i < 8; ++i) { q1[i] *= 0.125f; q2[i] *= 0.125f; }
          *(LAS v4u*)(Lq + row * RQP + j0) = pack8(q1); *(LAS v4u*)(Lq + row * RQP + 32 + j0) = pack8(q2);
          *(LAS v4u*)(Lk + row * RQP + j0) = pack8(k1); *(LAS v4u*)(Lk + row * RQP + 32 + j0) = pack8(k2); }
      if (NEED_KT) { const float zf = exp2f((float)(127 - row) * lg2gamma(h)), zb = exp2f((float)row * lg2gamma(3 - h));
#pragma unroll
          for (int i = 0; i < 8; ++i) { Lkf[(j0 + i) * RVP + row] = (bf16)f2bf(k1[i] * zf); Lkf[(32 + j0 + i) * RVP + row] = (bf16)f2bf(k2[i] * zf);
              Lkb[(j0 + i) * RVP + row] = (bf16)f2bf(k1[i] * zb); Lkb[(32 + j0 + i) * RVP + row] = (bf16)f2bf(k2[i] * zb); } } }
    { const int e0 = pc * 32;
#pragma unroll
      for (int q4 = 0; q4 < 4; ++q4) { const v4u w = *(const v4u*)(rp + C_VB + 128 * h + e0 + 8 * q4); const unsigned ww[4] = {w.x, w.y, w.z, w.w};
#pragma unroll
          for (int i = 0; i < 4; ++i) { Lvt[(e0 + 8 * q4 + 2 * i) * RVP + row] = (bf16)(ww[i] & 0xffffu); Lvt[(e0 + 8 * q4 + 2 * i + 1) * RVP + row] = (bf16)(ww[i] >> 16); } } }
}

__device__ __forceinline__ void ret_ra(const Args& a, Frame& F) {
    bf16* DS = (bf16*)(a.ws + WS_SP);
    const int l = F.lane, g = l >> 4, c = l & 15, w = F.wave;
    for (int it = blockIdx.x; it < 640; it += gridDim.x) {
        int base, n, h; bool smp; ret_item(it, base, n, h, smp);
        __syncthreads();
        ret_stage<false, true>(a, F, base, n, h, smp);
        __syncthreads();
        const LAS bf16* Lvt = (const LAS bf16*)(F.lds + RL_VT); const LAS bf16* Lkf = (const LAS bf16*)(F.lds + RL_KTF); const LAS bf16* Lkb = (const LAS bf16*)(F.lds + RL_KTB);
        f32x4 acc[2][4];
#pragma unroll
        for (int d = 0; d < 2; ++d)
#pragma unroll
            for (int nd = 0; nd < 4; ++nd) acc[d][nd] = (f32x4){0.f, 0.f, 0.f, 0.f};
#pragma unroll
        for (int s = 0; s < 4; ++s) { const bf16x8 av = *(const LAS bf16x8*)(Lvt + (16 * w + c) * RVP + 32 * s + 8 * g);
#pragma unroll
            for (int nd = 0; nd < 4; ++nd) { const bf16x8 bf_ = *(const LAS bf16x8*)(Lkf + (16 * nd + c) * RVP + 32 * s + 8 * g), bb_ = *(const LAS bf16x8*)(Lkb + (16 * nd + c) * RVP + 32 * s + 8 * g);
                acc[0][nd] = MFMA16(av, bf_, acc[0][nd]); acc[1][nd] = MFMA16(av, bb_, acc[1][nd]); } }
#pragma unroll
        for (int d = 0; d < 2; ++d) { bf16* o = DS + ((size_t)it * 2 + d) * 8192;
#pragma unroll
            for (int nd = 0; nd < 4; ++nd)
#pragma unroll
                for (int r = 0; r < 4; ++r) o[(16 * w + 4 * g + r) * 64 + 16 * nd + c] = (bf16)f2bf(acc[d][nd][r]); }
    }
}

__device__ __forceinline__ void ret_rb(const Args& a, Frame& F) {
    bf16* SP = (bf16*)(a.ws + WS_SP);
    for (int cid = (int)gridDim.x - 1 - (int)blockIdx.x; cid < 160; cid += gridDim.x) {
        const bool smp = cid < 32; const int q = smp ? cid : cid - 32;
        const int dir = q & 1, h = (q >> 1) & 3, sq = q >> 3, N = smp ? 32 : 2;
        const float gch = exp2f(128.f * lg2gamma(dir ? 3 - h : h));
        const int idx = F.tid * 16, e = idx >> 6, d0 = idx & 63;
        float S[16];
        if (smp) { const float* S0 = a.state_ret + ((size_t)(sq * 2 + dir) * 4 + h) * 8192;
#pragma unroll
            for (int i = 0; i < 16; ++i) S[i] = S0[(size_t)(d0 + i) * 128 + e]; }
        else {
#pragma unroll
            for (int i = 0; i < 16; ++i) S[i] = 0.f; }
        for (int st = 0; st < N; ++st) { const int n = dir ? N - 1 - st : st;
            const int it = smp ? (sq * 32 + n) * 4 + h : 512 + (sq * 2 + n) * 4 + h;
            bf16* sp = SP + ((size_t)it * 2 + dir) * 8192 + idx;
            float dv[16]; { float t8[8]; unpack8(*(const v4u*)sp, t8);
#pragma unroll
                for (int i = 0; i < 8; ++i) dv[i] = t8[i];
                unpack8(*(const v4u*)(sp + 8), t8);
#pragma unroll
                for (int i = 0; i < 8; ++i) dv[8 + i] = t8[i]; }
            v4u o0, o1; o0.x = pk2(S[0], S[1]); o0.y = pk2(S[2], S[3]); o0.z = pk2(S[4], S[5]); o0.w = pk2(S[6], S[7]);
            o1.x = pk2(S[8], S[9]); o1.y = pk2(S[10], S[11]); o1.z = pk2(S[12], S[13]); o1.w = pk2(S[14], S[15]);
            *(v4u*)sp = o0; *(v4u*)(sp + 8) = o1;
#pragma unroll
            for (int i = 0; i < 16; ++i) S[i] = gch * S[i] + dv[i]; }
        if (!smp) { float* So = a.out + OUT_SR + ((size_t)(sq * 2 + dir) * 4 + h) * 8192;
#pragma unroll
            for (int i = 0; i < 16; ++i) So[(size_t)(d0 + i) * 128 + e] = S[i]; }
    }
}

__device__ __forceinline__ void ret_rc(const Args& a, Frame& F) {
    const bf16* P = (const bf16*)(a.ws + WS_P); const bf16* SP = (const bf16*)(a.ws + WS_SP); bf16* MIX = (bf16*)(a.ws + WS_MIX);
    const int l = F.lane, g = l >> 4, c = l & 15, w = F.wave;
    for (int it = blockIdx.x; it < 640; it += gridDim.x) {
        int base, n, h; bool smp; ret_item(it, base, n, h, smp);
        __syncthreads();
        ret_stage<true, false>(a, F, base, n, h, smp);
        __syncthreads();
        const LAS bf16* Lq = (const LAS bf16*)(F.lds + RL_Q); const LAS bf16* Lk = (const LAS bf16*)(F.lds + RL_K); const LAS bf16* Lvt = (const LAS bf16*)(F.lds + RL_VT);
        const float lgf = lg2gamma(h), lgb = lg2gamma(3 - h);
        const int il = 16 * w + c;
        bf16x8 bq[2];
#pragma unroll
        for (int s = 0; s < 2; ++s) bq[s] = *(const LAS bf16x8*)(Lq + il * RQP + 32 * s + 8 * g);
        bf16x8 pb[4];
#pragma unroll
        for (int s = 0; s < 4; ++s) { f32x4 st2[2];
#pragma unroll
            for (int hh = 0; hh < 2; ++hh) { const int mt = 2 * s + hh; f32x4 acc = (f32x4){0.f, 0.f, 0.f, 0.f};
#pragma unroll
                for (int s2 = 0; s2 < 2; ++s2) { const bf16x8 ak = *(const LAS bf16x8*)(Lk + (16 * mt + c) * RQP + 32 * s2 + 8 * g); acc = MFMA16(ak, bq[s2], acc); }
#pragma unroll
                for (int r = 0; r < 4; ++r) { const int j = 16 * mt + 4 * g + r; const float dm = j < il ? exp2f((float)(il - j) * lgf) : (j > il ? exp2f((float)(j - il) * lgb) : 2.f); acc[r] *= dm; }
                st2[hh] = acc; }
            v4u pw; pw.x = pk2(st2[0][0], st2[0][1]); pw.y = pk2(st2[0][2], st2[0][3]); pw.z = pk2(st2[1][0], st2[1][1]); pw.w = pk2(st2[1][2], st2[1][3]);
            pb[s] = __builtin_bit_cast(bf16x8, pw); }
        const bf16* spf = SP + ((size_t)it * 2 + 0) * 8192; const bf16* spb = SP + ((size_t)it * 2 + 1) * 8192;
        const float xf = exp2f((float)(il + 1) * lgf), xb = exp2f((float)(128 - il) * lgb);
        f32x4 O[8]; float sm = 0.f;
#pragma unroll
        for (int me = 0; me < 8; ++me) { f32x4 cf = (f32x4){0.f, 0.f, 0.f, 0.f}, cb = cf;
#pragma unroll
            for (int s2 = 0; s2 < 2; ++s2) { const bf16x8 af = *(const bf16x8*)(spf + (16 * me + c) * 64 + 32 * s2 + 8 * g), ab = *(const bf16x8*)(spb + (16 * me + c) * 64 + 32 * s2 + 8 * g);
                cf = MFMA16(af, bq[s2], cf); cb = MFMA16(ab, bq[s2], cb); }
            f32x4 acc = cf * xf + cb * xb;
#pragma unroll
            for (int s = 0; s < 4; ++s) { const s16x4 lo = *(const LAS s16x4*)(Lvt + (16 * me + c) * RVP + 32 * s + 4 * g), hi = *(const LAS s16x4*)(Lvt + (16 * me + c) * RVP + 32 * s + 16 + 4 * g);
                const bf16x8 av = __builtin_shufflevector(lo, hi, 0, 1, 2, 3, 4, 5, 6, 7); acc = MFMA16(av, pb[s], acc); }
            O[me] = acc; sm += (acc[0] + acc[1]) + (acc[2] + acc[3]); }
        sm += __shfl_xor(sm, 16); sm += __shfl_xor(sm, 32);
        const float mean = sm * (1.f / 128.f); float sv = 0.f;
#pragma unroll
        for (int me = 0; me < 8; ++me) { O[me] = O[me] - mean; sv += (O[me][0] * O[me][0] + O[me][1] * O[me][1]) + (O[me][2] * O[me][2] + O[me][3] * O[me][3]); }
        sv += __shfl_xor(sv, 16); sv += __shfl_xor(sv, 32);
        const float rstd = 1.f / sqrtf(sv * (1.f / 128.f) + 1e-5f);
        const size_t grow = (size_t)(base + 128 * n + il);
#pragma unroll
        for (int me = 0; me < 8; ++me) { const int e = 16 * me + 4 * g;
            const v2u gw2 = *(const v2u*)(P + grow * NPAD + C_GB + 128 * h + e); const float gt[4] = {bflo(gw2.x), bfhi(gw2.x), bflo(gw2.y), bfhi(gw2.y)};
            const f32x4 wv = *(const f32x4*)(a.gn_w + 128 * h + e), bv = *(const f32x4*)(a.gn_b + 128 * h + e);
            float y[4];
#pragma unroll
            for (int r = 0; r < 4; ++r) y[r] = (O[me][r] * rstd * wv[r] + bv[r]) * silu_f(gt[r]);
            v2u ow; ow.x = pk2(y[0], y[1]); ow.y = pk2(y[2], y[3]); *(v2u*)(MIX + grow * D + 512 + 128 * h + e) = ow; }
    }
}
constexpr size_t WS_QK = WS_H;
constexpr size_t OUT_WF = 0, OUT_UF = 40 * MiB;
constexpr size_t WS_QKF = 1 * MiB;
constexpr size_t WS_SM = 21 * MiB;
constexpr int DL_Q = 0, DL_K = 17408, DL_KT = 34816, DL_VT = 53248, DL_M0 = 71680, DL_M1 = 90112, DL_SM = 108544;
constexpr int DQP = 136, DTP = 72, DMP = 72;

__device__ __forceinline__ void delta_item(int ci, int& base, int& T, int& n, int& h) {
    if (ci < 1024) { h = ci & 3; n = (ci >> 2) & 63; base = NPR + (ci >> 8) * 4096; T = 4096; }
    else { const int q = ci - 1024; h = q & 3; n = (q >> 2) & 3; base = (q >> 4) * 256; T = 256; }
}
__device__ __forceinline__ bf16x8 pack_tiles(const f32x4& t0, const f32x4& t1) {
    v4u pw; pw.x = pk2(t0[0], t0[1]); pw.y = pk2(t0[2], t0[3]); pw.z = pk2(t1[0], t1[1]); pw.w = pk2(t1[2], t1[3]); return __builtin_bit_cast(bf16x8, pw);
}
template <bool FLIP>
__device__ __forceinline__ void tri_inv(LAS float* M, LAS float* Tl, float sw, float su, int lane) {
#pragma unroll 8
    for (int i = 0; i < 64; ++i) Tl[i * 65 + lane] = 0.f;
#pragma unroll 1
    for (int ip = 0; ip < 64; ++ip) {
        float a0 = (lane == ip) ? 1.f : 0.f, a1 = 0.f;
        const int nq = (ip + 3) >> 2;
        const LAS float* mrow = FLIP ? M + (63 - ip) * DMP + 60 : M + ip * DMP;
#pragma unroll 2
        for (int q = 0; q < nq; ++q) {
            const f32x4 m4 = FLIP ? *(const LAS f32x4*)(mrow - 4 * q) : *(const LAS f32x4*)(mrow + 4 * q);
            const float m0 = FLIP ? m4.w : m4.x, m1 = FLIP ? m4.z : m4.y, m2 = FLIP ? m4.y : m4.z, m3 = FLIP ? m4.x : m4.w;
            const LAS float* tp = Tl + (4 * q) * 65 + lane;
            a0 -= m0 * tp[0]; a1 -= m1 * tp[65]; a0 -= m2 * tp[130]; a1 -= m3 * tp[195]; }
        Tl[ip * 65 + lane] = a0 + a1; }
    LDS_WAIT(); asm volatile("" ::: "memory");
    LAS bf16* Tw = (LAS bf16*)M; LAS bf16* Tu = Tw + 64 * DTP;
    const int cp = FLIP ? 63 - lane : lane;
#pragma unroll 4
    for (int ip = 0; ip < 64; ++ip) { const int cr = FLIP ? 63 - ip : ip; const float t = Tl[ip * 65 + lane]; Tw[cr * DTP + cp] = (bf16)f2bf(t * sw); Tu[cr * DTP + cp] = (bf16)f2bf(t * su); }
}

__device__ __forceinline__ void delta_prep(const Args& a, Frame& F) {
    const bf16* P = (const bf16*)(a.ws + WS_P);
    LAS bf16* Lq = (LAS bf16*)(F.lds + DL_Q); LAS bf16* Lk = (LAS bf16*)(F.lds + DL_K); LAS bf16* LkT = (LAS bf16*)(F.lds + DL_KT); LAS bf16* LvT = (LAS bf16*)(F.lds + DL_VT);
    LAS float* LM0 = (LAS float*)(F.lds + DL_M0); LAS float* LM1 = (LAS float*)(F.lds + DL_M1);
    LAS float* Lg = (LAS float*)(F.lds + DL_SM); LAS float* Lbeta = Lg + 128; LAS float* Lgc = Lg + 256; LAS float* Lbe = Lg + 384;
    const int l = F.lane, g = l >> 4, c = l & 15, w = F.wave;
    for (int ci = blockIdx.x; ci < 1280; ci += gridDim.x) {
        int base, T, n, h; delta_item(ci, base, T, n, h);
        __syncthreads();
        { const int s = g, col = 512 * s + 128 * h + 8 * c; const bool act = l < 48;
          float cw[5][8];
#pragma unroll
          for (int kk = 0; kk < 5; ++kk) { const f32x4 w0 = act ? *(const f32x4*)(a.conv_w + kk * 1536 + col) : (f32x4){0.f, 0.f, 0.f, 0.f}, w1 = act ? *(const f32x4*)(a.conv_w + kk * 1536 + col + 4) : (f32x4){0.f, 0.f, 0.f, 0.f};
              cw[kk][0] = w0.x; cw[kk][1] = w0.y; cw[kk][2] = w0.z; cw[kk][3] = w0.w; cw[kk][4] = w1.x; cw[kk][5] = w1.y; cw[kk][6] = w1.z; cw[kk][7] = w1.w; }
#pragma unroll 2
          for (int rr = 0; rr < 8; ++rr) { const int row = 8 * w + rr, t = 64 * n + row;
              float acc[8];
#pragma unroll
              for (int i = 0; i < 8; ++i) acc[i] = 0.f;
#pragma unroll
              for (int kk = 0; kk < 5; ++kk) { const int tt = t + kk - 2;
                  if (act && tt >= 0 && tt < T) { float xv[8]; unpack8(*(const v4u*)(P + (size_t)(base + tt) * NPAD + col), xv);
#pragma unroll
                      for (int i = 0; i < 8; ++i) acc[i] += xv[i] * cw[kk][i]; } }
              float ss = 0.f;
#pragma unroll
              for (int i = 0; i < 8; ++i) { acc[i] = silu_f(acc[i]); ss += acc[i] * acc[i]; }
              ss = g16_sum(ss);
              const float sc = s == 2 ? 1.f : (1.f / sqrtf(ss + 1e-6f)) * (s == 0 ? 0.08838834764831845f : 1.f);
#pragma unroll
              for (int i = 0; i < 8; ++i) acc[i] *= sc;
              if (s == 0) *(LAS v4u*)(Lq + row * DQP + 8 * c) = pack8(acc);
              else if (s == 1) { *(LAS v4u*)(Lk + row * DQP + 8 * c) = pack8(acc);
#pragma unroll
                  for (int i = 0; i < 8; ++i) LkT[(8 * c + i) * DTP + row] = (bf16)f2bf(acc[i]); }
              else if (s == 2) {
#pragma unroll
                  for (int i = 0; i < 8; ++i) LvT[(8 * c + i) * DTP + row] = (bf16)f2bf(acc[i]); } } }
        if (F.tid < 128) { const int dir = F.tid >> 6, row = F.tid & 63, ix = dir * 4 + h; const bf16* rp = P + (size_t)(base + 64 * n + row) * NPAD;
            const float z = bf2f(rp[C_AL + ix]) + a.dt_bias[ix]; const float sp = z > 20.f ? z : log1pf(expf(z));
            Lg[dir * 64 + row] = -expf(a.a_log[ix]) * sp; Lbeta[dir * 64 + row] = 1.f / (1.f + expf(-bf2f(rp[C_BE + ix]))); }
        __syncthreads();
        if (w < 2) { const int dir = w; float v = Lg[dir * 64 + l];
#pragma unroll
            for (int off = 1; off < 64; off <<= 1) { const float t2 = dir ? __shfl_down(v, off) : __shfl_up(v, off); if (dir ? (l + off < 64) : (l >= off)) v += t2; }
            const float gl = __shfl(v, dir ? 0 : 63); const float eg = __expf(v), ekd = __expf(gl - v);
            Lgc[dir * 64 + l] = v; Lbe[dir * 64 + l] = Lbeta[dir * 64 + l] * eg;
            float* sm = (float*)(a.ws + WS_SM) + ((size_t)ci * 2 + dir) * 256; sm[l] = eg; sm[64 + l] = ekd; if (l == 0) sm[128] = __expf(gl); }
        __syncthreads();
        { const int it = w >> 1;
#pragma unroll
          for (int jj2 = 0; jj2 < 2; ++jj2) { const int jt = 2 * (w & 1) + jj2; f32x4 acc = (f32x4){0.f, 0.f, 0.f, 0.f};
#pragma unroll
              for (int s = 0; s < 4; ++s) { const bf16x8 av = *(const LAS bf16x8*)(Lk + (16 * it + c) * DQP + 32 * s + 8 * g), bv = *(const LAS bf16x8*)(Lk + (16 * jt + c) * DQP + 32 * s + 8 * g); acc = MFMA16(av, bv, acc); }
              const int j = 16 * jt + c; const float gfj = Lgc[j], gbj = Lgc[64 + j];
#pragma unroll
              for (int r = 0; r < 4; ++r) { const int i = 16 * it + 4 * g + r;
                  LM0[i * DMP + j] = i > j ? Lbeta[i] * acc[r] * __expf(Lgc[i] - gfj) : 0.f;
                  LM1[i * DMP + j] = i < j ? Lbeta[64 + i] * acc[r] * __expf(Lgc[64 + i] - gbj) : 0.f; } }
          const int m = w & 3, sp2 = w >> 2; f32x4 tf[2], tb[2];
#pragma unroll
          for (int hh = 0; hh < 2; ++hh) { const int mt = 2 * sp2 + hh; f32x4 acc = (f32x4){0.f, 0.f, 0.f, 0.f};
#pragma unroll
              for (int s = 0; s < 4; ++s) { const bf16x8 av = *(const LAS bf16x8*)(Lk + (16 * mt + c) * DQP + 32 * s + 8 * g), bv = *(const LAS bf16x8*)(Lq + (16 * m + c) * DQP + 32 * s + 8 * g); acc = MFMA16(av, bv, acc); }
              const int cq = 16 * m + c; const float gfq = Lgc[cq], gbq = Lgc[64 + cq];
#pragma unroll
              for (int r = 0; r < 4; ++r) { const int cp = 16 * mt + 4 * g + r;
                  tf[hh][r] = cq >= cp ? acc[r] * __expf(gfq - Lgc[cp]) : 0.f; tb[hh][r] = cq <= cp ? acc[r] * __expf(gbq - Lgc[64 + cp]) : 0.f; } }
          bf16x8* qkf = (bf16x8*)(a.ws + WS_QKF) + ((size_t)ci * 2) * 512;
          qkf[(m * 2 + sp2) * 64 + l] = pack_tiles(tf[0], tf[1]); qkf[512 + (m * 2 + sp2) * 64 + l] = pack_tiles(tb[0], tb[1]);
          bf16x8* qf = (bf16x8*)(a.ws + WS_QK) + (size_t)ci * 2048; bf16x8* ktf = qf + 1024;
#pragma unroll
          for (int f2 = 0; f2 < 2; ++f2) { const int f = 2 * w + f2;
              { const int mq = f >> 2, s = f & 3; const s16x4 lo = *(const LAS s16x4*)(Lq + (16 * mq + c) * DQP + 32 * s + 4 * g), hi = *(const LAS s16x4*)(Lq + (16 * mq + c) * DQP + 32 * s + 16 + 4 * g);
                qf[f * 64 + l] = __builtin_shufflevector(lo, hi, 0, 1, 2, 3, 4, 5, 6, 7); }
              { const int mt = f >> 1, s = f & 1; const s16x4 lo = *(const LAS s16x4*)(LkT + (16 * mt + c) * DTP + 32 * s + 4 * g), hi = *(const LAS s16x4*)(LkT + (16 * mt + c) * DTP + 32 * s + 16 + 4 * g);
                ktf[f * 64 + l] = __builtin_shufflevector(lo, hi, 0, 1, 2, 3, 4, 5, 6, 7); } } }
        __syncthreads();
        if (w == 0) tri_inv<false>(LM0, (LAS float*)(F.lds + DL_Q), Lbe[l], Lbeta[l], l);
        else if (w == 1) tri_inv<true>(LM1, (LAS float*)(F.lds + DL_K), Lbe[64 + 63 - l], Lbeta[64 + 63 - l], l);
        __syncthreads();
        { const int dir = w >> 2, wq = w & 3; const LAS bf16* Tw = (const LAS bf16*)(dir ? LM1 : LM0); const LAS bf16* Tu = Tw + 64 * DTP;
          bf16x8* wf = (bf16x8*)((unsigned char*)a.out + OUT_WF) + ((size_t)ci * 2 + dir) * 1024;
          bf16x8 bt[2];
#pragma unroll
          for (int sp = 0; sp < 2; ++sp) bt[sp] = *(const LAS bf16x8*)(Tw + (16 * wq + c) * DTP + 32 * sp + 8 * g);
#pragma unroll
          for (int s = 0; s < 4; ++s) { f32x4 t2[2];
#pragma unroll
              for (int hh = 0; hh < 2; ++hh) { const int mt = 2 * s + hh; f32x4 acc = (f32x4){0.f, 0.f, 0.f, 0.f};
#pragma unroll
                  for (int sp = 0; sp < 2; ++sp) { const bf16x8 av = *(const LAS bf16x8*)(LkT + (16 * mt + c) * DTP + 32 * sp + 8 * g); acc = MFMA16(av, bt[sp], acc); }
                  t2[hh] = acc; }
              wf[(wq * 4 + s) * 64 + l] = pack_tiles(t2[0], t2[1]); }
          v4u* uf = (v4u*)((unsigned char*)a.out + OUT_UF) + ((size_t)ci * 2 + dir) * 1024;
#pragma unroll
          for (int n2 = 0; n2 < 2; ++n2) { const int ne = 2 * wq + n2; bf16x8 bv[2]; f32x4 ut[4];
#pragma unroll
              for (int sp = 0; sp < 2; ++sp) bv[sp] = *(const LAS bf16x8*)(LvT + (16 * ne + c) * DTP + 32 * sp + 8 * g);
#pragma unroll
              for (int m = 0; m < 4; ++m) { f32x4 acc = (f32x4){0.f, 0.f, 0.f, 0.f};
#pragma unroll
                  for (int sp = 0; sp < 2; ++sp) { const bf16x8 av = *(const LAS bf16x8*)(Tu + (16 * m + c) * DTP + 32 * sp + 8 * g); acc = MFMA16(av, bv[sp], acc); }
                  ut[m] = acc; }
              v4u o0, o1; o0.x = pk2(ut[0][0], ut[0][1]); o0.y = pk2(ut[0][2], ut[0][3]); o0.z = pk2(ut[1][0], ut[1][1]); o0.w = pk2(ut[1][2], ut[1][3]);
              o1.x = pk2(ut[2][0], ut[2][1]); o1.y = pk2(ut[2][2], ut[2][3]); o1.z = pk2(ut[3][0], ut[3][1]); o1.w = pk2(ut[3][2], ut[3][3]);
              uf[(ne * 64 + l) * 2] = o0; uf[(ne * 64 + l) * 2 + 1] = o1; } }
    }
}

constexpr int DB_BUF = 57344;
__device__ __forceinline__ void delta_scan(const Args& a, Frame& F) {
    const int b = blockIdx.x; if (b >= 160) return;
    const bool smp = b < 32; const int q = smp ? b : b - 32;
    const int dir = q & 1, h = (q >> 1) & 3, sq = q >> 3, N = smp ? 64 : 4, base = smp ? NPR + sq * 4096 : sq * 256;
    const int l = F.lane, g = l >> 4, c = l & 15, j = F.wave;
    bf16* P = (bf16*)(a.ws + WS_P);
    const unsigned char* gQK = a.ws + WS_QK; const unsigned char* gWF = (const unsigned char*)a.out + OUT_WF; const unsigned char* gQKF = a.ws + WS_QKF;
    const unsigned char* gUF = (const unsigned char*)a.out + OUT_UF; const float* gSM = (const float*)(a.ws + WS_SM);
    f32x4 S[8];
    if (smp) { const float* S0 = a.state_delta + ((size_t)(sq * 2 + dir) * 4 + h) * 16384;
#pragma unroll
        for (int mt = 0; mt < 8; ++mt)
#pragma unroll
            for (int r = 0; r < 4; ++r) S[mt][r] = S0[(size_t)(16 * mt + 4 * g + r) * 128 + 16 * j + c]; }
    else {
#pragma unroll
        for (int mt = 0; mt < 8; ++mt) S[mt] = (f32x4){0.f, 0.f, 0.f, 0.f}; }
#define DB_CI(st) ({ const int n_ = dir ? N - 1 - (st) : (st); smp ? (sq * 64 + n_) * 4 + h : 1024 + (sq * 4 + n_) * 4 + h; })
#define DB_DMA(st, buf) do { const int ci_ = DB_CI(st); _Pragma("unroll") for (int i_ = 0; i_ < 7; ++i_) { const int qd = 7 * j + i_; \
        const unsigned char* src = qd < 32 ? gQK + (size_t)ci_ * 32768 + qd * 1024 : (qd < 48 ? gWF + ((size_t)ci_ * 2 + dir) * 16384 + (qd - 32) * 1024 : gQKF + ((size_t)ci_ * 2 + dir) * 8192 + (qd - 48) * 1024); \
        __builtin_amdgcn_global_load_lds((const unsigned*)(src + l * 16), (LAS unsigned*)(F.lds + (buf) * DB_BUF + qd * 1024), 16, 0, 0); } } while (0)
    __syncthreads();
    DB_DMA(0, 0);
    v4u nu0, nu1; f32x4 neg[4], nek[4]; float ngl;
    { const int ci0 = DB_CI(0); const v4u* up = (const v4u*)(gUF + ((size_t)ci0 * 2 + dir) * 16384) + (j * 64 + l) * 2; nu0 = up[0]; nu1 = up[1];
      const float* sm = gSM + ((size_t)ci0 * 2 + dir) * 256;
#pragma unroll
      for (int m = 0; m < 4; ++m) { neg[m] = *(const f32x4*)(sm + 16 * m + 4 * g); nek[m] = *(const f32x4*)(sm + 64 + 16 * m + 4 * g); }
      ngl = sm[128]; }
    for (int st = 0; st < N; ++st) {
        asm volatile("s_waitcnt vmcnt(0)" ::: "memory");
        __syncthreads();
        const v4u u0 = nu0, u1 = nu1; f32x4 eg[4], ek[4];
#pragma unroll
        for (int m = 0; m < 4; ++m) { eg[m] = neg[m]; ek[m] = nek[m]; }
        const float gl = ngl;
        const int n = dir ? N - 1 - st : st;
        if (st + 1 < N) { DB_DMA(st + 1, (st + 1) & 1);
            const int ci1 = DB_CI(st + 1); const v4u* up = (const v4u*)(gUF + ((size_t)ci1 * 2 + dir) * 16384) + (j * 64 + l) * 2; nu0 = up[0]; nu1 = up[1];
            const float* sm = gSM + ((size_t)ci1 * 2 + dir) * 256;
#pragma unroll
            for (int m = 0; m < 4; ++m) { neg[m] = *(const f32x4*)(sm + 16 * m + 4 * g); nek[m] = *(const f32x4*)(sm + 64 + 16 * m + 4 * g); }
            ngl = sm[128]; }
        const LAS bf16x8* bufp = (const LAS bf16x8*)(F.lds + (st & 1) * DB_BUF);
        const LAS bf16x8* QF = bufp; const LAS bf16x8* KTF = bufp + 1024; const LAS bf16x8* WF = bufp + 2048; const LAS bf16x8* QKF = bufp + 3072;
        bf16x8 Sb[4];
#pragma unroll
        for (int s = 0; s < 4; ++s) Sb[s] = pack_tiles(S[2 * s], S[2 * s + 1]);
        const float uu[16] = {bflo(u0.x), bfhi(u0.x), bflo(u0.y), bfhi(u0.y), bflo(u0.z), bfhi(u0.z), bflo(u0.w), bfhi(u0.w), bflo(u1.x), bfhi(u1.x), bflo(u1.y), bfhi(u1.y), bflo(u1.z), bfhi(u1.z), bflo(u1.w), bfhi(u1.w)};
        f32x4 vn[4];
#pragma unroll
        for (int m = 0; m < 4; ++m) { f32x4 acc = (f32x4){0.f, 0.f, 0.f, 0.f};
#pragma unroll
            for (int s = 0; s < 4; ++s) acc = MFMA16(WF[(m * 4 + s) * 64 + l], Sb[s], acc);
#pragma unroll
            for (int r = 0; r < 4; ++r) vn[m][r] = uu[4 * m + r] - acc[r]; }
        bf16x8 vb[2], vk[2];
#pragma unroll
        for (int s = 0; s < 2; ++s) { vb[s] = pack_tiles(vn[2 * s], vn[2 * s + 1]); vk[s] = pack_tiles(vn[2 * s] * ek[2 * s], vn[2 * s + 1] * ek[2 * s + 1]); }
#pragma unroll
        for (int m = 0; m < 4; ++m) { f32x4 acc = (f32x4){0.f, 0.f, 0.f, 0.f};
#pragma unroll
            for (int s = 0; s < 4; ++s) acc = MFMA16(QF[(m * 4 + s) * 64 + l], Sb[s], acc);
            acc = acc * eg[m];
#pragma unroll
            for (int s = 0; s < 2; ++s) acc = MFMA16(QKF[(m * 2 + s) * 64 + l], vb[s], acc);
            bf16* op = P + (size_t)(base + 64 * n + 16 * m + 4 * g) * NPAD + dir * 512 + h * 128 + 16 * j + c;
#pragma unroll
            for (int r = 0; r < 4; ++r) op[(size_t)r * NPAD] = (bf16)f2bf(acc[r]); }
#pragma unroll
        for (int mt = 0; mt < 8; ++mt) { f32x4 acc = S[mt] * gl;
#pragma unroll
            for (int s = 0; s < 2; ++s) acc = MFMA16(KTF[(mt * 2 + s) * 64 + l], vk[s], acc);
            S[mt] = acc; }
    }
    if (!smp) { float* So = a.out + OUT_SD + ((size_t)(sq * 2 + dir) * 4 + h) * 16384;
#pragma unroll
        for (int mt = 0; mt < 8; ++mt)
#pragma unroll
            for (int r = 0; r < 4; ++r) So[(size_t)(16 * mt + 4 * g + r) * 128 + 16 * j + c] = S[mt][r]; }
#undef DB_CI
#undef DB_DMA
}

constexpr int N_PHASES = 12;
#ifndef N_LAUNCHES
#define N_LAUNCHES 1
#endif
__global__ void __launch_bounds__(NWAVES * 64, 2) fwd(Args a) {
    extern __shared__ __attribute__((aligned(16))) unsigned char lds[];
    Frame F; F.lds = (LAS unsigned char*)lds; F.tid = threadIdx.x; F.lane = F.tid & 63; F.wave = __builtin_amdgcn_readfirstlane(F.tid >> 6);
    F.gw = blockIdx.x * NWAVES + F.wave; F.NGW = gridDim.x * NWAVES;
    const int lo = a.ph_lo, hi = a.ph_hi;
    const float* mod = (const float*)(a.ws + WS_CTL + CTL_MOD_OFF);
    volatile LAS unsigned* MISC = (volatile LAS unsigned*)(F.lds + MISC_OFF);
    for (int u = F.tid; u < (LDS_BYTES - LDSCTL_OFF) / 4; u += NWAVES * 64) ((LAS unsigned*)(F.lds + LDSCTL_OFF))[u] = 0u;
    __syncthreads();
    XcdBarrier bar; bar.bar = (unsigned*)(a.ws + WS_CTL) + CW_BAR; bar.x = 0; bar.st = nullptr;
    if (hi - lo > 1) bar = xcd_barrier_post((unsigned*)(a.ws + WS_CTL) + CW_BAR, MISC + 8);
#define IN(k) (lo <= (k) && (k) < hi)
#define SEAM(k) do { if (IN(k) && IN((k) + 1)) xcd_barrier(bar); } while (0)
    if (IN(0)) p0_prologue(a, F);
    SEAM(0);
    if (IN(1)) p1_h(a, F);
    SEAM(1);
    if (IN(2)) { pg8::Gemm g{(const pg8::bf16_t*)(a.ws + WS_H), (const pg8::bf16_t*)(a.ws + WS_WIN), NROW, NPAD, D}; pg8::StaticOrder S; S.init(NROW, NPAD, gridDim.x, (int)blockIdx.x);
        pg8::EpiBf16<0> E{(pg8::bf16_t*)(a.ws + WS_P), NPAD, nullptr};
        pg8::gemm_phase<pg8::EpiBf16<0>, pg8::StaticOrder, true, true>(F.lds, g, S, E); }
    SEAM(2);
    if (IN(3)) { delta_prep(a, F); ret_ra(a, F); }
    SEAM(3);
    if (IN(4)) { delta_scan(a, F); ret_rb(a, F); }
    SEAM(4);
    if (IN(5)) { ret_rc(a, F); __syncthreads(); late_weights(a, F); }
    SEAM(5);
    if (IN(6)) p5_combine(a, F);
    SEAM(6);
    if (IN(7)) { pg8::Gemm g{(const pg8::bf16_t*)(a.ws + WS_H), (const pg8::bf16_t*)(a.ws + WS_WO), NROW, D, D}; pg8::StaticOrder S; S.init(NROW, D, gridDim.x, (int)blockIdx.x);
        pg8::EpiResid E{a.x_prompt, a.x_sample - (size_t)NPR * D, a.out, D, nullptr, mod + 2048, MODW, ALPHA_DN};
        pg8::gemm_phase<pg8::EpiResid, pg8::StaticOrder, true, true>(F.lds, g, S, E); }
    SEAM(7);
    if (IN(8)) p6b_ln1(a, F);
    SEAM(8);
    if (IN(9)) { pg8::Gemm g{(const pg8::bf16_t*)(a.ws + WS_H), (const pg8::bf16_t*)(a.ws + WS_W1), NROW, FF, D}; pg8::StaticOrder S; S.init(NROW, FF, gridDim.x, (int)blockIdx.x);
        pg8::EpiBf16<2> E{(pg8::bf16_t*)(a.ws + WS_P), FF, a.b_ff1};
        pg8::gemm_phase<pg8::EpiBf16<2>, pg8::StaticOrder, true, true>(F.lds, g, S, E); }
    SEAM(9);
    if (IN(10)) { pg8::Gemm g{(const pg8::bf16_t*)(a.ws + WS_P), (const pg8::bf16_t*)(a.ws + WS_W2), NROW, D, FF}; pg8::StaticOrder S; S.init(NROW, D, gridDim.x, (int)blockIdx.x);
        pg8::EpiResid E{a.out, a.out, a.out, D, a.b_ff2, mod + 5120, MODW, ALPHA_DN};
        pg8::gemm_phase<pg8::EpiResid, pg8::StaticOrder, true, true>(F.lds, g, S, E); }
    SEAM(10);
    if (IN(11)) p8b_ln2(a, F);
#undef IN
#undef SEAM
}

extern "C" void kernel_launch(void* const* d_in, const int* in_sizes, int n_in, void* d_out, int out_size, void* d_ws, size_t ws_size, hipStream_t stream) {
    static int grid = 0;
    if (grid == 0) {
        if (n_in != 24 || ws_size < WS_END || (size_t)out_size != OUT_SR + (size_t)16 * 2 * 4 * 64 * 128) { fprintf(stderr, "kernel_launch: unexpected problem: n_in %d out %d ws %zu\n", n_in, out_size, ws_size); grid = -1; return; }
        int dev = 0, cus = 0, per_cu = 0;
        if (hipGetDevice(&dev) != hipSuccess || hipDeviceGetAttribute(&cus, hipDeviceAttributeMultiprocessorCount, dev) != hipSuccess) { grid = -1; return; }
        if (hipFuncSetAttribute((const void*)fwd, hipFuncAttributeMaxDynamicSharedMemorySize, LDS_BYTES) != hipSuccess) { fprintf(stderr, "kernel_launch: hipFuncSetAttribute failed\n"); grid = -1; return; }
        if (hipOccupancyMaxActiveBlocksPerMultiprocessor(&per_cu, (const void*)fwd, NWAVES * 64, LDS_BYTES) != hipSuccess || per_cu < 1) { fprintf(stderr, "kernel_launch: occupancy query says %d workgroups per CU\n", per_cu); (void)hipGetLastError(); grid = -1; return; }
        grid = cus;
    }
    if (grid < 0) return;
    (void)hipMemsetAsync((char*)d_ws + WS_CTL, 0, CTL_ZERO_BYTES, stream);
    Args a{};
    const float** ap = (const float**)&a;
    for (int i = 0; i < 24; ++i) ap[i] = (const float*)d_in[i];
    a.out = (float*)d_out; a.ws = (unsigned char*)d_ws;
    if (N_LAUNCHES == 1) { a.ph_lo = 0; a.ph_hi = N_PHASES; hipLaunchKernelGGL(fwd, dim3(grid), dim3(NWAVES * 64), LDS_BYTES, stream, a); }
    else for (int p = 0; p < N_PHASES; ++p) { a.ph_lo = p; a.ph_hi = p + 1; hipLaunchKernelGGL(fwd, dim3(grid), dim3(NWAVES * 64), LDS_BYTES, stream, a); }
}
```

```cpp
#include <hip/hip_runtime.h>
#include <cstdio>
#include <cstdint>
namespace pg8 {
#define PG8_LAS __attribute__((address_space(3)))
typedef unsigned short bf16_t;
typedef short bf16x8 __attribute__((ext_vector_type(8)));
typedef float f32x4 __attribute__((ext_vector_type(4)));
typedef unsigned u32x4 __attribute__((ext_vector_type(4)));
constexpr int BM = 256, BK = 64, HALF = 128, HTB = HALF * BK * 2  , STAGE_BYTES = 8 * HTB, NXCD = 8, WGM = 8;

__host__ __device__ __forceinline__ int lds_byte(int r, int c) { const int st = (r >> 4) * 2 + (c >> 5), rr = r & 15, cc = c & 31, ob = rr * 64 + cc * 2; return st * 1024 + (ob ^ (((ob >> 9) & 1) << 5)); }
__host__ __device__ __forceinline__ void stage_rc(int b, int& R, int& C) { const int st = b / 1024, sb = b % 1024, swz = sb ^ (((sb >> 9) & 1) << 5); R = (st >> 1) * 16 + swz / 64; C = (st & 1) * 32 + (swz % 64) / 2; }
__host__ __device__ __forceinline__ int perm32(int rho) { const int n = rho >> 4, i = rho & 15; return 8 * (i >> 2) + 4 * n + (i & 3); }

struct Unit { int pm, pn; };
struct Gemm { const bf16_t* A; const bf16_t* Bt; int M, N, K; };

struct StaticOrder {
    int nM, nN, nwg, G, c;
    __host__ __device__ void init(int M, int N, int G_, int c_) { nM = M / BM; nN = N / BM; nwg = nM * nN; G = G_; c = c_; }
    __host__ __device__ bool next(int i, Unit& u) const {
        const long L = (long)i * G + c; if (L >= nwg) return false;
        int wgid = (int)L; { const int q = nwg / NXCD, r = nwg % NXCD, xcd = wgid % NXCD, off = wgid / NXCD; wgid = (xcd < r ? xcd * (q + 1) : r * (q + 1) + (xcd - r) * q) + off; }
        const int nig = WGM * nN, gid = wgid / nig, fm = gid * WGM, gsz = (nM - fm) < WGM ? (nM - fm) : WGM;
        u.pm = fm + ((wgid % nig) % gsz); u.pn = (wgid % nig) / gsz; return true;
    }
    __device__ __forceinline__ void a_ready(const Unit&) const {}
    __device__ __forceinline__ void done(const Unit&) const {}
};

__device__ __forceinline__ unsigned cvt_pk_bf16(float lo, float hi) { unsigned r; asm volatile("v_cvt_pk_bf16_f32 %0, %1, %2" : "=v"(r) : "v"(lo), "v"(hi)); return r; }
template <int ACT> struct EpiBf16 {
    static constexpr bool PERM = true, AFTER_DRAIN = false;
    bf16_t* O; int ldc; const float* bias;
    __device__ __forceinline__ void operator()(const f32x4 (&acc)[2][2][4][2], const Unit& u, int wr, int wc, int fr, int fq) const {
        const int row0 = u.pm * BM + wr * 64 + fr; const int col0 = u.pn * BM + wc * 32 + 8 * fq;
        f32x4 bv[2][2];
#pragma unroll
        for (int bj = 0; bj < 2; ++bj)
#pragma unroll
            for (int n = 0; n < 2; ++n) bv[bj][n] = bias ? *(const f32x4*)(bias + col0 + bj * HALF + 4 * n) : (f32x4){0.f, 0.f, 0.f, 0.f};
#pragma unroll
        for (int ai = 0; ai < 2; ++ai)
#pragma unroll
            for (int m = 0; m < 4; ++m) { bf16_t* rowp = O + (size_t)(row0 + ai * HALF + m * 16) * ldc + col0;
#pragma unroll
                for (int bj = 0; bj < 2; ++bj) { f32x4 v0 = acc[ai][bj][m][0] + bv[bj][0], v1 = acc[ai][bj][m][1] + bv[bj][1];
                    if (ACT == 2) {
#pragma unroll
                        for (int i = 0; i < 4; ++i) { const float a = v0[i] > 0.f ? v0[i] : 0.f, b = v1[i] > 0.f ? v1[i] : 0.f; v0[i] = a * a; v1[i] = b * b; } }
                    u32x4 w; w.x = cvt_pk_bf16(v0[0], v0[1]); w.y = cvt_pk_bf16(v0[2], v0[3]); w.z = cvt_pk_bf16(v1[0], v1[1]); w.w = cvt_pk_bf16(v1[2], v1[3]);
                    *(u32x4*)(rowp + bj * HALF) = w; } }
    }
};
struct EpiResid {
    static constexpr bool PERM = false, AFTER_DRAIN = false;
    const float* base0; const float* base1; float* out; int ldc; const float* bias; const float* gate; int gate_pitch; float alpha;
    __device__ __forceinline__ void operator()(const f32x4 (&acc)[2][2][4][2], const Unit& u, int wr, int wc, int fr, int fq) const {
        const int row0 = u.pm * BM + wr * 64 + fr; const int col0 = u.pn * BM + wc * 32 + 4 * fq;
        const int r0 = u.pm * BM; const int vrow = r0 < 4096 ? 0 : 1 + ((r0 - 4096) >> 12);
        const float* gp = gate + (size_t)vrow * gate_pitch; const float* base = r0 < 4096 ? base0 : base1;
        f32x4 bv[2][2], gv[2][2];
#pragma unroll
        for (int bj = 0; bj < 2; ++bj)
#pragma unroll
            for (int n = 0; n < 2; ++n) { bv[bj][n] = bias ? *(const f32x4*)(bias + col0 + bj * HALF + n * 16) : (f32x4){0.f, 0.f, 0.f, 0.f}; gv[bj][n] = *(const f32x4*)(gp + col0 + bj * HALF + n * 16); }
#pragma unroll
        for (int ai = 0; ai < 2; ++ai)
#pragma unroll
            for (int m = 0; m < 4; ++m) { const size_t off = (size_t)(row0 + ai * HALF + m * 16) * ldc + col0;
#pragma unroll
                for (int bj = 0; bj < 2; ++bj)
#pragma unroll
                    for (int n = 0; n < 2; ++n) { const f32x4 bs = *(const f32x4*)(base + off + bj * HALF + n * 16);
                        const f32x4 o = bs * alpha + gv[bj][n] * (acc[ai][bj][m][n] + bv[bj][n]);
                        *(f32x4*)(out + off + bj * HALF + n * 16) = o; } }
    }
};

template <class Epi, class Sched, bool ALIGN_EPI = false, bool SP2 = false>
__device__ __forceinline__ void gemm_phase(PG8_LAS unsigned char* lds, const Gemm g, const Sched& S, const Epi& E) {
    const int tid = threadIdx.x, wid = __builtin_amdgcn_readfirstlane(tid >> 6), lane = tid & 63, wr = wid >> 2, wc = wid & 3, fr = lane & 15, fq = lane >> 4;
    const int K = g.K, nt = K / BK;
    unsigned voffA[2], voffB[2];
#pragma unroll
    for (int i = 0; i < 2; ++i) { int R, C; stage_rc(tid * 16 + i * 8192, R, C); const int Rb = Epi::PERM ? ((R & ~31) + perm32(R & 31)) : R;
        voffA[i] = (unsigned)(R * K + C) * 2u; voffB[i] = (unsigned)(Rb * K + C) * 2u; }
    const size_t kstep = (size_t)(BK * 2);
    const size_t hstep = (size_t)HALF * K * 2;
    const size_t tstep = 2 * hstep;
    const unsigned ldsw = (unsigned)wid * 1024u;
    const int aoff = lds_byte(wr * 64 + fr, fq * 8), boff = lds_byte(wc * 32 + fr, fq * 8);
#define PG8_SA(b, h) (((b) * 2 + (h)) * HTB)
#define PG8_SB(b, h) ((4 + (b) * 2 + (h)) * HTB)
#define PG8_STAGE(bufoff, gbase, voff) do { _Pragma("unroll") for (int _i = 0; _i < 2; ++_i) \
        __builtin_amdgcn_global_load_lds((const unsigned*)((const char*)(gbase) + (voff)[_i]), (PG8_LAS unsigned*)(lds + (bufoff) + ldsw + _i * 8192), 16, 0, 0); } while (0)
#define PG8_LDA(dst, b, h) do { _Pragma("unroll") for (int m = 0; m < 4; ++m) _Pragma("unroll") for (int k = 0; k < 2; ++k) dst[m][k] = *(const PG8_LAS bf16x8*)(lds + PG8_SA(b, h) + aoff + m * 2048 + k * 1024); } while (0)
#define PG8_LDB(dst, b, h) do { _Pragma("unroll") for (int n = 0; n < 2; ++n) _Pragma("unroll") for (int k = 0; k < 2; ++k) dst[n][k] = *(const PG8_LAS bf16x8*)(lds + PG8_SB(b, h) + boff + n * 2048 + k * 1024); } while (0)
#define PG8_MMA(ai, bj, At, Bt) do { __builtin_amdgcn_s_setprio(1); _Pragma("unroll") for (int m = 0; m < 4; ++m) _Pragma("unroll") for (int n = 0; n < 2; ++n) _Pragma("unroll") for (int k = 0; k < 2; ++k) \
        acc[ai][bj][m][n] = __builtin_amdgcn_mfma_f32_16x16x32_bf16(Bt[n][k], At[m][k], acc[ai][bj][m][n], 0, 0, 0); __builtin_amdgcn_s_setprio(0); } while (0)
#define PG8_WAIT_V(n) asm volatile("s_waitcnt vmcnt(" #n ")" ::: "memory")
#define PG8_WAIT_L(n) asm volatile("s_waitcnt lgkmcnt(" #n ")" ::: "memory")
#define PG8_BAR __builtin_amdgcn_s_barrier()
#define PG8_SCHED __builtin_amdgcn_sched_barrier(0)
    Unit cur, nxt; int ui = 0;
    if (!S.next(0, cur)) return;
    f32x4 acc[2][2][4][2];
#pragma unroll
    for (int a = 0; a < 2; ++a)
#pragma unroll
        for (int b = 0; b < 2; ++b)
#pragma unroll
            for (int m = 0; m < 4; ++m)
#pragma unroll
                for (int n = 0; n < 2; ++n) acc[a][b][m][n] = (f32x4){0.f, 0.f, 0.f, 0.f};
    bf16x8 At[4][2], B0[2][2], B1[2][2];
    const char* cA = (const char*)g.A + (size_t)cur.pm * tstep; const char* cB = (const char*)g.Bt + (size_t)cur.pn * tstep;
    S.a_ready(cur);
    if constexpr (SP2) {
        PG8_STAGE(PG8_SB(0, 0), cB, voffB); PG8_STAGE(PG8_SB(0, 1), cB + hstep, voffB); PG8_STAGE(PG8_SA(0, 0), cA, voffA); PG8_STAGE(PG8_SA(0, 1), cA + hstep, voffA);
        if (wr == 1) PG8_BAR;
        PG8_WAIT_V(2); PG8_BAR;
        PG8_STAGE(PG8_SB(1, 0), cB + kstep, voffB); PG8_STAGE(PG8_SA(1, 0), cA + kstep, voffA); PG8_STAGE(PG8_SB(1, 1), cB + hstep + kstep, voffB);
        PG8_WAIT_V(6); PG8_BAR;
    } else {
        PG8_STAGE(PG8_SB(0, 0), cB, voffB); PG8_STAGE(PG8_SA(0, 0), cA, voffA); PG8_STAGE(PG8_SB(0, 1), cB + hstep, voffB); PG8_STAGE(PG8_SA(0, 1), cA + hstep, voffA);
        if (wr == 1) PG8_BAR;
        PG8_WAIT_V(4); PG8_BAR;
        PG8_STAGE(PG8_SB(1, 0), cB + kstep, voffB); PG8_STAGE(PG8_SA(1, 0), cA + kstep, voffA); PG8_STAGE(PG8_SB(1, 1), cB + hstep + kstep, voffB);
        PG8_WAIT_V(6); PG8_BAR;
    }
    for (;;) {
        const bool has_next = S.next(ui + 1, nxt);
        const char* nA = has_next ? (const char*)g.A + (size_t)nxt.pm * tstep : cA; const char* nB = has_next ? (const char*)g.Bt + (size_t)nxt.pn * tstep : cB;
        for (int t = 0; t < nt; t += 2) {
            const bool last = (t == nt - 2);
            const char* a1 = cA + (size_t)(t + 1) * kstep;
            const char* a2 = last ? nA : cA + (size_t)(t + 2) * kstep; const char* b2 = last ? nB : cB + (size_t)(t + 2) * kstep;
            const char* a3 = a2 + kstep; const char* b3 = b2 + kstep;
            if (last && has_next) S.a_ready(nxt);
            if constexpr (SP2) {
            PG8_LDB(B0, 0, 0); PG8_LDB(B1, 0, 1); PG8_SCHED; PG8_LDA(At, 0, 0); PG8_STAGE(PG8_SA(1, 1), a1 + hstep, voffA);
            PG8_WAIT_V(8); PG8_WAIT_L(0); PG8_BAR; PG8_MMA(0, 0, At, B0); PG8_MMA(0, 1, At, B1); PG8_BAR; PG8_SCHED;
            PG8_LDA(At, 0, 1); PG8_STAGE(PG8_SB(0, 0), b2, voffB); PG8_STAGE(PG8_SB(0, 1), b2 + hstep, voffB); PG8_STAGE(PG8_SA(0, 0), a2, voffA);
            PG8_WAIT_V(8); PG8_WAIT_L(0); PG8_BAR; PG8_MMA(1, 0, At, B0); PG8_MMA(1, 1, At, B1); PG8_BAR; PG8_SCHED;
            PG8_LDB(B0, 1, 0); PG8_LDB(B1, 1, 1); PG8_SCHED; PG8_LDA(At, 1, 0); PG8_STAGE(PG8_SA(0, 1), a2 + hstep, voffA);
            PG8_WAIT_V(8); PG8_WAIT_L(0); PG8_BAR; PG8_MMA(0, 0, At, B0); PG8_MMA(0, 1, At, B1); PG8_BAR; PG8_SCHED;
            PG8_LDA(At, 1, 1); PG8_STAGE(PG8_SB(1, 0), b3, voffB); PG8_STAGE(PG8_SB(1, 1), b3 + hstep, voffB); PG8_STAGE(PG8_SA(1, 0), a3, voffA);
            PG8_WAIT_V(8); PG8_WAIT_L(0); PG8_BAR; PG8_MMA(1, 0, At, B0); PG8_MMA(1, 1, At, B1); PG8_BAR; PG8_SCHED;
            } else {
            PG8_LDB(B0, 0, 0); PG8_SCHED; PG8_LDA(At, 0, 0); PG8_STAGE(PG8_SA(1, 1), a1 + hstep, voffA);
            PG8_WAIT_L(8); PG8_BAR; PG8_WAIT_L(0); PG8_MMA(0, 0, At, B0); PG8_BAR; PG8_SCHED;
            PG8_LDB(B1, 0, 1); PG8_STAGE(PG8_SB(0, 0), b2, voffB);
            PG8_BAR; PG8_WAIT_L(0); PG8_MMA(0, 1, At, B1); PG8_BAR;
            PG8_LDA(At, 0, 1); PG8_STAGE(PG8_SA(0, 0), a2, voffA);
            PG8_BAR; PG8_WAIT_L(0); PG8_MMA(1, 0, At, B0); PG8_BAR; PG8_SCHED;
            PG8_STAGE(PG8_SB(0, 1), b2 + hstep, voffB);
            PG8_WAIT_V(6); PG8_BAR; PG8_MMA(1, 1, At, B1); PG8_BAR;
            PG8_LDB(B0, 1, 0); PG8_SCHED; PG8_LDA(At, 1, 0); PG8_STAGE(PG8_SA(0, 1), a2 + hstep, voffA);
            PG8_WAIT_L(8); PG8_BAR; PG8_WAIT_L(0); PG8_MMA(0, 0, At, B0); PG8_BAR; PG8_SCHED;
            PG8_LDB(B1, 1, 1); PG8_STAGE(PG8_SB(1, 0), b3, voffB);
            PG8_BAR; PG8_WAIT_L(0); PG8_MMA(0, 1, At, B1); PG8_BAR;
            PG8_LDA(At, 1, 1); PG8_STAGE(PG8_SA(1, 0), a3, voffA);
            PG8_BAR; PG8_WAIT_L(0); PG8_MMA(1, 0, At, B0); PG8_BAR; PG8_SCHED;
            PG8_STAGE(PG8_SB(1, 1), b3 + hstep, voffB);
            PG8_WAIT_V(6); PG8_BAR; PG8_MMA(1, 1, At, B1); PG8_BAR;
            }
        }
        if constexpr (ALIGN_EPI) { if (wr == 0) PG8_BAR; }
        if constexpr (!Epi::AFTER_DRAIN) { E(acc, cur, wr, wc, fr, fq); S.done(cur); }
        if (!has_next) break;
#pragma unroll
        for (int a = 0; a < 2; ++a)
#pragma unroll
            for (int b = 0; b < 2; ++b)
#pragma unroll
                for (int m = 0; m < 4; ++m)
#pragma unroll
                    for (int n = 0; n < 2; ++n) acc[a][b][m][n] = (f32x4){0.f, 0.f, 0.f, 0.f};
        cur = nxt; cA = nA; cB = nB; ++ui;
        if constexpr (ALIGN_EPI) { if (wr == 1) PG8_BAR; }
    }
    PG8_WAIT_V(0);
    if constexpr (!ALIGN_EPI) { if (wr == 0) PG8_BAR; }
    PG8_BAR;
    if constexpr (Epi::AFTER_DRAIN) { E.fused(acc, cur, wr, wc, fr, fq, lds, wid, lane); S.done(cur); }
#undef PG8_SA
#undef PG8_SB
#undef PG8_STAGE
#undef PG8_LDA
#undef PG8_LDB
#undef PG8_MMA
#undef PG8_WAIT_V
#undef PG8_WAIT_L
#undef PG8_BAR
#undef PG8_SCHED
}
}

constexpr int NWAVES = 8;
constexpr int D = 1024, FF = 4096, NROW = 20480, NPR = 4096;
constexpr int NPAD = 3840;
constexpr int C_QA = 0, C_KA = 512, C_VA = 1024, C_GA = 1536, C_QB = 2048, C_KB = 2304, C_VB = 2560, C_GB = 3072, C_AL = 3584, C_BE = 3592;
constexpr int NMODV = 5, MODW = 6144;
constexpr float ALPHA_DN = 1.189207115002721f;
constexpr size_t MiB = 1u << 20;
constexpr size_t WS_CTL = 0, CTL_ZERO_BYTES = 1 * MiB;
constexpr size_t CTL_MOD_OFF = 65536;
constexpr int CW_BAR = 4096;
constexpr int LDS_BYTES = 147456;
constexpr int LDSCTL_OFF = 146432, MISC_OFF = LDSCTL_OFF + 320;
constexpr size_t WS_WIN = 1 * MiB, WS_WO = 9 * MiB, WS_W1 = 11 * MiB, WS_W2 = 19 * MiB;
constexpr size_t WS_H = 27 * MiB;
constexpr size_t WS_MIX = WS_H;
constexpr size_t WS_P = 67 * MiB;
constexpr size_t WS_GB = 228 * MiB;
constexpr size_t WS_RB = 230 * MiB;
constexpr size_t WS_END = 250 * MiB;
constexpr size_t OUT_Y = (size_t)NROW * D, OUT_SD = OUT_Y, OUT_SR = OUT_SD + (size_t)16 * 2 * 4 * 128 * 128;

#define LAS __attribute__((address_space(3)))
typedef unsigned short bf16;
typedef unsigned v4u __attribute__((ext_vector_type(4)));
typedef unsigned v2u __attribute__((ext_vector_type(2)));
typedef float f32x4 __attribute__((ext_vector_type(4)));
#define LDS_WAIT() asm volatile("s_waitcnt lgkmcnt(0)" ::: "memory")
__device__ __forceinline__ unsigned f2bf(float f) { unsigned u = __builtin_bit_cast(unsigned, f); return (u + 0x7fffu + ((u >> 16) & 1u)) >> 16; }
__device__ __forceinline__ unsigned pk2(float lo, float hi) { return f2bf(lo) | (f2bf(hi) << 16); }
__device__ __forceinline__ float bf2f(unsigned short h) { return __builtin_bit_cast(float, (unsigned)h << 16); }
__device__ __forceinline__ float bflo(unsigned w) { return __builtin_bit_cast(float, w << 16); }
__device__ __forceinline__ float bfhi(unsigned w) { return __builtin_bit_cast(float, w & 0xffff0000u); }
__device__ __forceinline__ float wave_sum(float v) {
#pragma unroll
    for (int o = 1; o < 64; o <<= 1) v += __shfl_xor(v, o);
    return v;
}
__device__ __forceinline__ float g16_sum(float v) {
#pragma unroll
    for (int o = 1; o < 16; o <<= 1) v += __shfl_xor(v, o);
    return v;
}
__device__ __forceinline__ float silu_f(float x) { return x / (1.f + __expf(-x)); }

struct Args {
    const float *x_prompt, *x_sample, *c, *state_delta, *state_ret, *c_ctx, *w_mod, *b_mod, *w_in, *conv_w, *a_log, *dt_bias, *norm_a_w, *gn_w, *gn_b, *w_o,
                *ln1_w, *ln1_b, *w_ff1, *b_ff1, *w_ff2, *b_ff2, *ln2_w, *ln2_b;
    float* out; unsigned char* ws; int ph_lo, ph_hi;
};
struct Frame { LAS unsigned char* lds; int tid, lane, wave, gw, NGW; };

__device__ __forceinline__ const float* xrow_ptr(const Args& a, int r) { return r < NPR ? a.x_prompt + (size_t)r * D : a.x_sample + (size_t)(r - NPR) * D; }
__device__ __forceinline__ int vrow_of(int r) { return r < NPR ? 0 : 1 + ((r - NPR) >> 12); }

__device__ __forceinline__ int map_in(int nd) { return nd < 2048 ? nd : (nd < 3584 ? nd + 16 : (nd < 3600 ? nd - 3584 + 2048 : -1)); }
template <bool MAP> __device__ __forceinline__ void transpose_item(const float* W, int K, int N, int nblk, bf16* WT, LAS float* scr, int item, int lane) {
    const int kb = item / nblk, nb = item % nblk, k0 = 64 * kb, n0 = 32 * nb;
    const int nd = n0 + (lane & 31), ns = MAP ? map_in(nd) : nd;
#pragma unroll 8
    for (int i = 0; i < 32; ++i) { const int kk = 2 * i + (lane >> 5); scr[kk * 33 + (lane & 31)] = ns >= 0 ? W[(size_t)(k0 + kk) * N + ns] : 0.f; }
    LDS_WAIT(); asm volatile("" ::: "memory");
    const int c = lane & 7;
#pragma unroll
    for (int j = 0; j < 4; ++j) { const int n = (lane >> 3) + 8 * j; const LAS float* s = scr + (8 * c) * 33 + n;
        v4u o; o.x = pk2(s[0 * 33], s[1 * 33]); o.y = pk2(s[2 * 33], s[3 * 33]); o.z = pk2(s[4 * 33], s[5 * 33]); o.w = pk2(s[6 * 33], s[7 * 33]);
        *(v4u*)(WT + (size_t)(n0 + n) * K + k0 + 8 * c) = o; }
    LDS_WAIT(); asm volatile("" ::: "memory");
}
__device__ __forceinline__ void p0_prologue(const Args& a, Frame& F) {
    LAS float* scr = (LAS float*)(F.lds + F.wave * 16384);
    bf16* Win_t = (bf16*)(a.ws + WS_WIN);
    constexpr int I_IN = (D / 64) * (NPAD / 32);
    constexpr int I_MOD = 24 * 32;
    constexpr int NITEMS = I_MOD + I_IN;
    float* mod = (float*)(a.ws + WS_CTL + CTL_MOD_OFF);
    for (int it = F.gw; it < NITEMS; it += F.NGW) {
        int r = it;
        if (r < I_MOD) {
            const int cg = r % 24, ks = r / 24, e = cg * 256 + F.lane, k0 = ks * 32;
            LDS_WAIT(); asm volatile("" ::: "memory");
            if (F.lane < 32) {
#pragma unroll
                for (int v = 0; v < NMODV; ++v) { const float cv = v == 0 ? a.c_ctx[k0 + F.lane] : a.c[(v - 1) * D + k0 + F.lane]; scr[v * 32 + F.lane] = silu_f(cv); } }
            LDS_WAIT(); asm volatile("" ::: "memory");
            float acc[NMODV][4];
#pragma unroll
            for (int v = 0; v < NMODV; ++v)
#pragma unroll
                for (int i = 0; i < 4; ++i) acc[v][i] = 0.f;
#pragma unroll 8
            for (int dd = 0; dd < 32; ++dd) { const float* wp = a.w_mod + (size_t)(k0 + dd) * MODW + e; const float w0 = wp[0], w1 = wp[64], w2 = wp[128], w3 = wp[192];
#pragma unroll
                for (int v = 0; v < NMODV; ++v) { const float sv = scr[v * 32 + dd]; acc[v][0] += w0 * sv; acc[v][1] += w1 * sv; acc[v][2] += w2 * sv; acc[v][3] += w3 * sv; } }
#pragma unroll
            for (int i = 0; i < 4; ++i) { const float bb = ks == 0 ? a.b_mod[e + 64 * i] : 0.f;
#pragma unroll
                for (int v = 0; v < NMODV; ++v) atomicAdd(mod + v * MODW + e + 64 * i, acc[v][i] + bb); }
            continue; }
        r -= I_MOD;
        transpose_item<true>(a.w_in, D, 3600, NPAD / 32, Win_t, scr, r, F.lane);
    }
}
__device__ __forceinline__ void late_weights(const Args& a, Frame& F) {
    LAS float* scr = (LAS float*)(F.lds + F.wave * 16384);
    bf16* Wo_t = (bf16*)(a.ws + WS_WO); bf16* W1_t = (bf16*)(a.ws + WS_W1); bf16* W2_t = (bf16*)(a.ws + WS_W2);
    constexpr int I_O = (D / 64) * (D / 32), I_1 = (D / 64) * (FF / 32), I_2 = (FF / 64) * (D / 32);
    for (int it = F.gw; it < I_O + I_1 + I_2; it += F.NGW) {
        int r = it;
        if (r < I_O) { transpose_item<false>(a.w_o, D, D, D / 32, Wo_t, scr, r, F.lane); continue; } r -= I_O;
        if (r < I_1) { transpose_item<false>(a.w_ff1, D, FF, FF / 32, W1_t, scr, r, F.lane); continue; } r -= I_1;
        transpose_item<false>(a.w_ff2, FF, D, D / 32, W2_t, scr, r, F.lane);
    }
}

__device__ __forceinline__ void ln_stats(const f32x4 (&v)[4], float eps, float& mean, float& rstd) {
    float s = 0.f;
#pragma unroll
    for (int j = 0; j < 4; ++j) s += (v[j].x + v[j].y) + (v[j].z + v[j].w);
    mean = wave_sum(s) * (1.f / D); float s2 = 0.f;
#pragma unroll
    for (int j = 0; j < 4; ++j) { const f32x4 d = v[j] - mean; s2 += (d.x * d.x + d.y * d.y) + (d.z * d.z + d.w * d.w); }
    rstd = 1.f / sqrtf(wave_sum(s2) * (1.f / D) + eps);
}
__device__ __forceinline__ void p1_h(const Args& a, Frame& F) {
    const float* mod = (const float*)(a.ws + WS_CTL + CTL_MOD_OFF); bf16* H = (bf16*)(a.ws + WS_H);
    for (int r = F.gw; r < NROW; r += F.NGW) {
        const f32x4* xr = (const f32x4*)xrow_ptr(a, r) + F.lane; const float* mv = mod + (size_t)vrow_of(r) * MODW;
        f32x4 v[4];
#pragma unroll
        for (int j = 0; j < 4; ++j) v[j] = xr[64 * j];
        float mean, rstd; ln_stats(v, 1e-6f, mean, rstd);
        unsigned long long* o8 = (unsigned long long*)(H + (size_t)r * D) + F.lane;
#pragma unroll
        for (int j = 0; j < 4; ++j) { const f32x4 sh = *((const f32x4*)mv + F.lane + 64 * j), sc = *((const f32x4*)(mv + 1024) + F.lane + 64 * j);
            const f32x4 h = (v[j] - mean) * rstd * (sc + 1.f) + sh;
            o8[64 * j] = (unsigned long long)pk2(h.x, h.y) | ((unsigned long long)pk2(h.z, h.w) << 32); }
    }
}
#define XB_TMO      128
#define XB_XCNT(j)  (256  + 64 * (j))
#define XB_XSUB(j)  (1280 + 64 * (j))
#define XB_XGEN(j)  (2304 + 64 * (j))
#define XB_TOP      3328
#define XB_TOPGEN   3392
#define XCD_BAR_WORDS 3456
#define XB_SPIN_CAP (1u << 22)

__device__ __forceinline__ unsigned xb_ld(unsigned* p)              { return __hip_atomic_load(p, __ATOMIC_RELAXED, __HIP_MEMORY_SCOPE_AGENT); }
__device__ __forceinline__ unsigned xb_add(unsigned* p, unsigned v) { return __hip_atomic_fetch_add(p, v, __ATOMIC_RELAXED, __HIP_MEMORY_SCOPE_AGENT); }
__device__ __forceinline__ unsigned xb_xcc_id() { return (unsigned)__builtin_amdgcn_s_getreg((3 << 11) | 20) & 0xFu; }
#define XB_SPIN(cond, bar) do { unsigned _sp = 0; while (cond) { __builtin_amdgcn_s_sleep(1); \
    if ((++_sp & 255u) == 0u) { if (xb_ld(&(bar)[XB_TMO])) break; if (_sp > XB_SPIN_CAP) { atomicAdd(&(bar)[XB_TMO], 1u); break; } } } } while (0)

struct XcdBarrier {
    unsigned* bar; unsigned x;
    volatile LAS unsigned* st;
};

__device__ __forceinline__ XcdBarrier xcd_barrier_post(unsigned* bar, volatile LAS unsigned* st) {
    XcdBarrier b; b.bar = bar; b.x = xb_xcc_id(); b.st = st;
    if (threadIdx.x == 0) (void)xb_add(&bar[XB_XCNT(b.x)], 1u);
    return b;
}
__device__ __forceinline__ void xcd_barrier_complete(unsigned* bar, unsigned x, unsigned& nloc, unsigned& nx) {
    const unsigned G = gridDim.x * gridDim.y * gridDim.z;
    unsigned sum, cnt, mine, sp = 0u;
    for (;;) {
        sum = 0u; cnt = 0u; mine = 0u;
#pragma unroll
        for (unsigned j = 0; j < 16; ++j) { const unsigned c = xb_ld(&bar[XB_XCNT(j)]); sum += c; cnt += (c > 0u) ? 1u : 0u; mine = (j == x) ? c : mine; }
        if (sum == G) break;
        __builtin_amdgcn_s_sleep(1);
        if ((++sp & 255u) == 0u) { if (xb_ld(&bar[XB_TMO])) break; if (sp > XB_SPIN_CAP) { atomicAdd(&bar[XB_TMO], 1u); break; } }
    }
    nloc = mine > 0u ? mine : 1u; nx = cnt > 0u ? cnt : 1u;
}

__device__ __forceinline__ void xcd_barrier(const XcdBarrier& b) {
    asm volatile("s_waitcnt vmcnt(0)" ::: "memory");
    __syncthreads();
    if (threadIdx.x == 0) {
        unsigned* bar = b.bar;
        __builtin_amdgcn_s_waitcnt(0);
        unsigned nloc = b.st[0], nx = b.st[1];
        if (nloc == 0u) { xcd_barrier_complete(bar, b.x, nloc, nx); b.st[0] = nloc; b.st[1] = nx; }
        const unsigned old = xb_add(&bar[XB_XSUB(b.x)], 1u);
        const unsigned gen = old / nloc;
        if (old + 1u == (gen + 1u) * nloc) {
            __builtin_amdgcn_fence(__ATOMIC_RELEASE, "agent");
            asm volatile("s_waitcnt vmcnt(0)" ::: "memory");
            const unsigned og = xb_add(&bar[XB_TOP], 1u);
            const unsigned tg = og / nx;
            if (og + 1u == (tg + 1u) * nx) xb_add(&bar[XB_TOPGEN], 1u);
            else XB_SPIN(xb_ld(&bar[XB_TOPGEN]) == tg, bar);
            __builtin_amdgcn_fence(__ATOMIC_ACQUIRE, "agent");
            xb_add(&bar[XB_XGEN(b.x)], 1u);
            asm volatile("s_waitcnt vmcnt(0)" ::: "memory");
        } else {
            XB_SPIN(xb_ld(&bar[XB_XGEN(b.x)]) == gen, bar);
            __builtin_amdgcn_fence(__ATOMIC_ACQUIRE, "agent");
            asm volatile("s_waitcnt vmcnt(0)" ::: "memory");
        }
    }
    __syncthreads();
}
__device__ __forceinline__ void seq_of_row(int r, int& base, int& T, int& t) { if (r < NPR) { base = r & ~255; T = 256; t = r & 255; } else { const int q = r - NPR; base = NPR + (q & ~4095); T = 4096; t = q & 4095; } }
__device__ __forceinline__ void unpack8(const v4u w, float (&f)[8]) { f[0] = bflo(w.x); f[1] = bfhi(w.x); f[2] = bflo(w.y); f[3] = bfhi(w.y); f[4] = bflo(w.z); f[5] = bfhi(w.z); f[6] = bflo(w.w); f[7] = bfhi(w.w); }
__device__ __forceinline__ v4u pack8(const float (&f)[8]) { v4u w; w.x = pk2(f[0], f[1]); w.y = pk2(f[2], f[3]); w.z = pk2(f[4], f[5]); w.w = pk2(f[6], f[7]); return w; }

__device__ __forceinline__ void p5_combine(const Args& a, Frame& F) {
    const bf16* P = (const bf16*)(a.ws + WS_P);
    bf16* MIX = (bf16*)(a.ws + WS_MIX); const int l = F.lane;
    for (int r = F.gw; r < NROW; r += F.NGW) {
        const bf16* rp = P + (size_t)r * NPAD;
        float x0[8], x1[8], gt[8], o[8];
        unpack8(*(const v4u*)(rp + 8 * l), x0); unpack8(*(const v4u*)(rp + 512 + 8 * l), x1); unpack8(*(const v4u*)(rp + C_GA + 8 * l), gt);
        float ss = 0.f;
#pragma unroll
        for (int i = 0; i < 8; ++i) { x0[i] += x1[i]; ss += x0[i] * x0[i]; }
        ss = g16_sum(ss); const float rs = 1.f / sqrtf(ss * (1.f / 128.f) + 1e-6f);
#pragma unroll
        for (int i = 0; i < 8; ++i) o[i] = x0[i] * rs * a.norm_a_w[(8 * l + i) & 127] * silu_f(gt[i]);
        *(v4u*)(MIX + (size_t)r * D + 8 * l) = pack8(o);
    }
}

__device__ __forceinline__ void p6b_ln1(const Args& a, Frame& F) {
    const float* mod = (const float*)(a.ws + WS_CTL + CTL_MOD_OFF); bf16* H2 = (bf16*)(a.ws + WS_H);
    for (int r = F.gw; r < NROW; r += F.NGW) {
        f32x4* zr = (f32x4*)(a.out + (size_t)r * D) + F.lane; const float* mv = mod + (size_t)vrow_of(r) * MODW;
        f32x4 v[4];
#pragma unroll
        for (int j = 0; j < 4; ++j) v[j] = zr[64 * j];
        float mean, rstd; ln_stats(v, 1e-6f, mean, rstd);
#pragma unroll
        for (int j = 0; j < 4; ++j) { const f32x4 w = *((const f32x4*)a.ln1_w + F.lane + 64 * j), b = *((const f32x4*)a.ln1_b + F.lane + 64 * j);
            v[j] = (v[j] - mean) * rstd * w + b; zr[64 * j] = v[j]; }
        ln_stats(v, 1e-6f, mean, rstd);
        unsigned long long* o8 = (unsigned long long*)(H2 + (size_t)r * D) + F.lane;
#pragma unroll
        for (int j = 0; j < 4; ++j) { const f32x4 sh = *((const f32x4*)(mv + 3072) + F.lane + 64 * j), sc = *((const f32x4*)(mv + 4096) + F.lane + 64 * j);
            const f32x4 h = (v[j] - mean) * rstd * (sc + 1.f) + sh;
            o8[64 * j] = (unsigned long long)pk2(h.x, h.y) | ((unsigned long long)pk2(h.z, h.w) << 32); }
    }
}
__device__ __forceinline__ void p8b_ln2(const Args& a, Frame& F) {
    for (int r = F.gw; r < NROW; r += F.NGW) {
        f32x4* zr = (f32x4*)(a.out + (size_t)r * D) + F.lane;
        f32x4 v[4];
#pragma unroll
        for (int j = 0; j < 4; ++j) v[j] = zr[64 * j];
        float mean, rstd; ln_stats(v, 1e-6f, mean, rstd);
#pragma unroll
        for (int j = 0; j < 4; ++j) { const f32x4 w = *((const f32x4*)a.ln2_w + F.lane + 64 * j), b = *((const f32x4*)a.ln2_b + F.lane + 64 * j);
            zr[64 * j] = (v[j] - mean) * rstd * w + b; }
    }
}
constexpr int RL_Q = 0, RL_K = 18432, RL_VT = 36864, RL_KTF = 71680, RL_KTB = 89088;
constexpr int RQP = 72, RVP = 136;
typedef short bf16x8 __attribute__((ext_vector_type(8)));
typedef short s16x4 __attribute__((ext_vector_type(4)));
#define MFMA16(a, b, c) __builtin_amdgcn_mfma_f32_16x16x32_bf16((a), (b), (c), 0, 0, 0)
constexpr size_t WS_SP = WS_RB;

__device__ __forceinline__ void ret_item(int it, int& base, int& n, int& h, bool& smp) {
    if (it < 512) { smp = true; h = it & 3; n = (it >> 2) & 31; base = NPR + (it >> 7) * 4096; }
    else { const int q = it - 512; smp = false; h = q & 3; n = (q >> 2) & 1; base = (q >> 3) * 256; }
}
__device__ __forceinline__ float lg2gamma(int hg) { return log2f(1.f - exp2f(-5.f - (float)hg)); }

template <bool NEED_QK, bool NEED_KT>
__device__ __forceinline__ void ret_stage(const Args& a, Frame& F, int base, int n, int h, bool smp) {
    const bf16* P = (const bf16*)(a.ws + WS_P);
    LAS bf16* Lq = (LAS bf16*)(F.lds + RL_Q); LAS bf16* Lk = (LAS bf16*)(F.lds + RL_K); LAS bf16* Lvt = (LAS bf16*)(F.lds + RL_VT);
    LAS bf16* Lkf = (LAS bf16*)(F.lds + RL_KTF); LAS bf16* Lkb = (LAS bf16*)(F.lds + RL_KTB);
    const int t = F.tid, row = t >> 2, pc = t & 3, tpos = 128 * n + row;
    const bf16* rp = P + (size_t)(base + tpos) * NPAD;
    { const int j0 = pc * 8;
      float q1[8], q2[8], k1[8], k2[8];
      if (NEED_QK) { unpack8(*(const v4u*)(rp + C_QB + 64 * h + j0), q1); unpack8(*(const v4u*)(rp + C_QB + 64 * h + 32 + j0), q2); }
      unpack8(*(const v4u*)(rp + C_KB + 64 * h + j0), k1); unpack8(*(const v4u*)(rp + C_KB + 64 * h + 32 + j0), k2);
      if (smp) { const float pos = (pc < 2) ? (float)(tpos >> 6) : (float)(tpos & 63);
#pragma unroll
          for (int i = 0; i < 8; ++i) { const int f = (j0 + i) & 15; const float ang = pos * exp2f(-(float)f * 0.83048202372184059f); float sn, cs; __sincosf(ang, &sn, &cs);
              if (NEED_QK) { const float x1 = q1[i], x2 = q2[i]; q1[i] = x1 * cs - x2 * sn; q2[i] = x1 * sn + x2 * cs; }
              const float y1 = k1[i], y2 = k2[i]; k1[i] = y1 * cs - y2 * sn; k2[i] = y1 * sn + y2 * cs; } }
      if (NEED_QK) {
#pragma unroll
          for (int i = 0; i < 8; ++i) { q1[i] *= 0.125f; q2[i] *= 0.125f; }
          *(LAS v4u*)(Lq + row * RQP + j0) = pack8(q1); *(LAS v4u*)(Lq + row * RQP + 32 + j0) = pack8(q2);
          *(LAS v4u*)(Lk + row * RQP + j0) = pack8(k1); *(LAS v4u*)(Lk + row * RQP + 32 + j0) = pack8(k2); }
      if (NEED_KT) { const float zf = exp2f((float)(127 - row) * lg2gamma(h)), zb = exp2f((float)row * lg2gamma(3 - h));
#pragma unroll
          for (int i = 0; i < 8; ++i) { Lkf[(j0 + i) * RVP + row] = (bf16)f2bf(k1[i] * zf); Lkf[(32 + j0 + i) * RVP + row] = (bf16)f2bf(k2[i] * zf);
              Lkb[(j0 + i) * RVP + row] = (bf16)f2bf(k1[i] * zb); Lkb[(32 + j0 + i) * RVP + row] = (bf16)f2bf(k2[i] * zb); } } }
    { const int e0 = pc * 32;
#pragma unroll
      for (int q4 = 0; q4 < 4; ++q4) { const v4u w = *(const v4u*)(rp + C_VB + 128 * h + e0 + 8 * q4); const unsigned ww[4] = {w.x, w.y, w.z, w.w};
#pragma unroll
          for (int i = 0; i < 4; ++i) { Lvt[(e0 + 8 * q4 + 2 * i) * RVP + row] = (bf16)(ww[i] & 0xffffu); Lvt[(e0 + 8 * q4 + 2 * i + 1) * RVP + row] = (bf16)(ww[i] >> 16); } } }
}

__device__ __forceinline__ void ret_ra(const Args& a, Frame& F) {
    bf16* DS = (bf16*)(a.ws + WS_SP);
    const int l = F.lane, g = l >> 4, c = l & 15, w = F.wave;
    for (int it = blockIdx.x; it < 640; it += gridDim.x) {
        int base, n, h; bool smp; ret_item(it, base, n, h, smp);
        __syncthreads();
        ret_stage<false, true>(a, F, base, n, h, smp);
        __syncthreads();
        const LAS bf16* Lvt = (const LAS bf16*)(F.lds + RL_VT); const LAS bf16* Lkf = (const LAS bf16*)(F.lds + RL_KTF); const LAS bf16* Lkb = (const LAS bf16*)(F.lds + RL_KTB);
        f32x4 acc[2][4];
#pragma unroll
        for (int d = 0; d < 2; ++d)
#pragma unroll
            for (int nd = 0; nd < 4; ++nd) acc[d][nd] = (f32x4){0.f, 0.f, 0.f, 0.f};
#pragma unroll
        for (int s = 0; s < 4; ++s) { const bf16x8 av = *(const LAS bf16x8*)(Lvt + (16 * w + c) * RVP + 32 * s + 8 * g);
#pragma unroll
            for (int nd = 0; nd < 4; ++nd) { const bf16x8 bf_ = *(const LAS bf16x8*)(Lkf + (16 * nd + c) * RVP + 32 * s + 8 * g), bb_ = *(const LAS bf16x8*)(Lkb + (16 * nd + c) * RVP + 32 * s + 8 * g);
                acc[0][nd] = MFMA16(av, bf_, acc[0][nd]); acc[1][nd] = MFMA16(av, bb_, acc[1][nd]); } }
#pragma unroll
        for (int d = 0; d < 2; ++d) { bf16* o = DS + ((size_t)it * 2 + d) * 8192;
#pragma unroll
            for (int nd = 0; nd < 4; ++nd)
#pragma unroll
                for (int r = 0; r < 4; ++r) o[(16 * w + 4 * g + r) * 64 + 16 * nd + c] = (bf16)f2bf(acc[d][nd][r]); }
    }
}

__device__ __forceinline__ void ret_rb(const Args& a, Frame& F) {
    bf16* SP = (bf16*)(a.ws + WS_SP);
    for (int cid = (int)gridDim.x - 1 - (int)blockIdx.x; cid < 160; cid += gridDim.x) {
        const bool smp = cid < 32; const int q = smp ? cid : cid - 32;
        const int dir = q & 1, h = (q >> 1) & 3, sq = q >> 3, N = smp ? 32 : 2;
        const float gch = exp2f(128.f * lg2gamma(dir ? 3 - h : h));
        const int idx = F.tid * 16, e = idx >> 6, d0 = idx & 63;
        float S[16];
        if (smp) { const float* S0 = a.state_ret + ((size_t)(sq * 2 + dir) * 4 + h) * 8192;
#pragma unroll
            for (int i = 0; i < 16; ++i) S[i] = S0[(size_t)(d0 + i) * 128 + e]; }
        else {
#pragma unroll
            for (int i = 0; i < 16; ++i) S[i] = 0.f; }
        for (int st = 0; st < N; ++st) { const int n = dir ? N - 1 - st : st;
            const int it = smp ? (sq * 32 + n) * 4 + h : 512 + (sq * 2 + n) * 4 + h;
            bf16* sp = SP + ((size_t)it * 2 + dir) * 8192 + idx;
            float dv[16]; { float t8[8]; unpack8(*(const v4u*)sp, t8);
#pragma unroll
                for (int i = 0; i < 8; ++i) dv[i] = t8[i];
                unpack8(*(const v4u*)(sp + 8), t8);
#pragma unroll
                for (int i = 0; i < 8; ++i) dv[8 + i] = t8[i]; }
            v4u o0, o1; o0.x = pk2(S[0], S[1]); o0.y = pk2(S[2], S[3]); o0.z = pk2(S[4], S[5]); o0.w = pk2(S[6], S[7]);
            o1.x = pk2(S[8], S[9]); o1.y = pk2(S[10], S[11]); o1.z = pk2(S[12], S[13]); o1.w = pk2(S[14], S[15]);
            *(v4u*)sp = o0; *(v4u*)(sp + 8) = o1;
#pragma unroll
            for (int i = 0; i < 16; ++i) S[i] = gch * S[i] + dv[i]; }
        if (!smp) { float* So = a.out + OUT_SR + ((size_t)(sq * 2 + dir) * 4 + h) * 8192;
#pragma unroll
            for (int i = 0; i < 16; ++i) So[(size_t)(d0 + i) * 128 + e] = S[i]; }
    }
}

__device__ __forceinline__ void ret_rc(const Args& a, Frame& F) {
    const bf16* P = (const bf16*)(a.ws + WS_P); const bf16* SP = (const bf16*)(a.ws + WS_SP); bf16* MIX = (bf16*)(a.ws + WS_MIX);
    const int l = F.lane, g = l >> 4, c = l & 15, w = F.wave;
    for (int it = blockIdx.x; it < 640; it += gridDim.x) {
        int base, n, h; bool smp; ret_item(it, base, n, h, smp);
        __syncthreads();
        ret_stage<true, false>(a, F, base, n, h, smp);
        __syncthreads();
        const LAS bf16* Lq = (const LAS bf16*)(F.lds + RL_Q); const LAS bf16* Lk = (const LAS bf16*)(F.lds + RL_K); const LAS bf16* Lvt = (const LAS bf16*)(F.lds + RL_VT);
        const float lgf = lg2gamma(h), lgb = lg2gamma(3 - h);
        const int il = 16 * w + c;
        bf16x8 bq[2];
#pragma unroll
        for (int s = 0; s < 2; ++s) bq[s] = *(const LAS bf16x8*)(Lq + il * RQP + 32 * s + 8 * g);
        bf16x8 pb[4];
#pragma unroll
        for (int s = 0; s < 4; ++s) { f32x4 st2[2];
#pragma unroll
            for (int hh = 0; hh < 2; ++hh) { const int mt = 2 * s + hh; f32x4 acc = (f32x4){0.f, 0.f, 0.f, 0.f};
#pragma unroll
                for (int s2 = 0; s2 < 2; ++s2) { const bf16x8 ak = *(const LAS bf16x8*)(Lk + (16 * mt + c) * RQP + 32 * s2 + 8 * g); acc = MFMA16(ak, bq[s2], acc); }
#pragma unroll
                for (int r = 0; r < 4; ++r) { const int j = 16 * mt + 4 * g + r; const float dm = j < il ? exp2f((float)(il - j) * lgf) : (j > il ? exp2f((float)(j - il) * lgb) : 2.f); acc[r] *= dm; }
                st2[hh] = acc; }
            v4u pw; pw.x = pk2(st2[0][0], st2[0][1]); pw.y = pk2(st2[0][2], st2[0][3]); pw.z = pk2(st2[1][0], st2[1][1]); pw.w = pk2(st2[1][2], st2[1][3]);
            pb[s] = __builtin_bit_cast(bf16x8, pw); }
        const bf16* spf = SP + ((size_t)it * 2 + 0) * 8192; const bf16* spb = SP + ((size_t)it * 2 + 1) * 8192;
        const float xf = exp2f((float)(il + 1) * lgf), xb = exp2f((float)(128 - il) * lgb);
        f32x4 O[8]; float sm = 0.f;
#pragma unroll
        for (int me = 0; me < 8; ++me) { f32x4 cf = (f32x4){0.f, 0.f, 0.f, 0.f}, cb = cf;
#pragma unroll
            for (int s2 = 0; s2 < 2; ++s2) { const bf16x8 af = *(const bf16x8*)(spf + (16 * me + c) * 64 + 32 * s2 + 8 * g), ab = *(const bf16x8*)(spb + (16 * me + c) * 64 + 32 * s2 + 8 * g);
                cf = MFMA16(af, bq[s2], cf); cb = MFMA16(ab, bq[s2], cb); }
            f32x4 acc = cf * xf + cb * xb;
#pragma unroll
            for (int s = 0; s < 4; ++s) { const s16x4 lo = *(const LAS s16x4*)(Lvt + (16 * me + c) * RVP + 32 * s + 4 * g), hi = *(const LAS s16x4*)(Lvt + (16 * me + c) * RVP + 32 * s + 16 + 4 * g);
                const bf16x8 av = __builtin_shufflevector(lo, hi, 0, 1, 2, 3, 4, 5, 6, 7); acc = MFMA16(av, pb[s], acc); }
            O[me] = acc; sm += (acc[0] + acc[1]) + (acc[2] + acc[3]); }
        sm += __shfl_xor(sm, 16); sm += __shfl_xor(sm, 32);
        const float mean = sm * (1.f / 128.f); float sv = 0.f;
#pragma unroll
        for (int me = 0; me < 8; ++me) { O[me] = O[me] - mean; sv += (O[me][0] * O[me][0] + O[me][1] * O[me][1]) + (O[me][2] * O[me][2] + O[me][3] * O[me][3]); }
        sv += __shfl_xor(sv, 16); sv += __shfl_xor(sv, 32);
        const float rstd = 1.f / sqrtf(sv * (1.f / 128.f) + 1e-5f);
        const size_t grow = (size_t)(base + 128 * n + il);
#pragma unroll
        for (int me = 0; me < 8; ++me) { const int e = 16 * me + 4 * g;
            const v2u gw2 = *(const v2u*)(P + grow * NPAD + C_GB + 128 * h + e); const float gt[4] = {bflo(gw2.x), bfhi(gw2.x), bflo(gw2.y), bfhi(gw2.y)};
            const f32x4 wv = *(const f32x4*)(a.gn_w + 128 * h + e), bv = *(const f32x4*)(a.gn_b + 128 * h + e);
            float y[4];
#pragma unroll
            for (int r = 0; r < 4; ++r) y[r] = (O[me][r] * rstd * wv[r] + bv[r]) * silu_f(gt[r]);
            v2u ow; ow.x = pk2(y[0], y[1]); ow.y = pk2(y[2], y[3]); *(v2u*)(MIX + grow * D + 512 + 128 * h + e) = ow; }
    }
}
constexpr size_t WS_QK = WS_H;
constexpr size_t OUT_WF = 0, OUT_UF = 40 * MiB;
constexpr size_t WS_QKF = 1 * MiB;
constexpr size_t WS_SM = 21 * MiB;
constexpr int DL_Q = 0, DL_K = 17408, DL_KT = 34816, DL_VT = 53248, DL_M0 = 71680, DL_M1 = 90112, DL_SM = 108544;
constexpr int DQP = 136, DTP = 72, DMP = 72;

__device__ __forceinline__ void delta_item(int ci, int& base, int& T, int& n, int& h) {
    if (ci < 1024) { h = ci & 3; n = (ci >> 2) & 63; base = NPR + (ci >> 8) * 4096; T = 4096; }
    else { const int q = ci - 1024; h = q & 3; n = (q >> 2) & 3; base = (q >> 4) * 256; T = 256; }
}
__device__ __forceinline__ bf16x8 pack_tiles(const f32x4& t0, const f32x4& t1) {
    v4u pw; pw.x = pk2(t0[0], t0[1]); pw.y = pk2(t0[2], t0[3]); pw.z = pk2(t1[0], t1[1]); pw.w = pk2(t1[2], t1[3]); return __builtin_bit_cast(bf16x8, pw);
}
constexpr int TLP = 68;
template <bool FLIP> __device__ __forceinline__ f32x4 ld_m4(const LAS float* M, int i, int j0) {
    if (!FLIP) return *(const LAS f32x4*)(M + i * DMP + j0);
    const f32x4 t = *(const LAS f32x4*)(M + (63 - i) * DMP + 60 - j0); return (f32x4){t.w, t.z, t.y, t.x};
}
template <bool FLIP>
__device__ __forceinline__ void tri_inv(LAS float* M, LAS float* Tl, float sw, float su, int lane) {
    const int g = lane >> 4, c = lane & 15;
#pragma unroll 8
    for (int i = 0; i < 64; ++i) Tl[i * TLP + lane] = 0.f;
    { float Dr[16];
#pragma unroll
      for (int i = 0; i < 16; ++i) { float a0 = (c == i) ? 1.f : 0.f, a1 = 0.f;
#pragma unroll
          for (int x = 0; x < 4; ++x) if (4 * x < i) { const f32x4 m4 = ld_m4<FLIP>(M, 16 * g + i, 16 * g + 4 * x);
              a0 -= m4.x * Dr[4 * x]; if (4 * x + 1 < i) a1 -= m4.y * Dr[4 * x + 1]; if (4 * x + 2 < i) a0 -= m4.z * Dr[4 * x + 2]; if (4 * x + 3 < i) a1 -= m4.w * Dr[4 * x + 3]; }
          Dr[i] = a0 + a1; }
#pragma unroll
      for (int i = 0; i < 16; ++i) Tl[(16 * g + i) * TLP + 16 * g + c] = Dr[i]; }
#pragma unroll
    for (int bc = 0; bc < 3; ++bc)
#pragma unroll
        for (int b = bc + 1; b < 4; ++b) {
            f32x4 y = (f32x4){0.f, 0.f, 0.f, 0.f};
#pragma unroll
            for (int k = bc; k < b; ++k) { const f32x4 av = ld_m4<FLIP>(M, 16 * b + c, 16 * k + 4 * g);
                const LAS float* tp = Tl + (16 * k + 4 * g) * TLP + 16 * bc + c;
                const float b0 = tp[0], b1 = tp[TLP], b2 = tp[2 * TLP], b3 = tp[3 * TLP];
                y = __builtin_amdgcn_mfma_f32_16x16x4f32(av.x, b0, y, 0, 0, 0); y = __builtin_amdgcn_mfma_f32_16x16x4f32(av.y, b1, y, 0, 0, 0);
                y = __builtin_amdgcn_mfma_f32_16x16x4f32(av.z, b2, y, 0, 0, 0); y = __builtin_amdgcn_mfma_f32_16x16x4f32(av.w, b3, y, 0, 0, 0); }
            const f32x4 dv = *(const LAS f32x4*)(Tl + (16 * b + c) * TLP + 16 * b + 4 * g);
            f32x4 z = (f32x4){0.f, 0.f, 0.f, 0.f};
            z = __builtin_amdgcn_mfma_f32_16x16x4f32(dv.x, y[0], z, 0, 0, 0); z = __builtin_amdgcn_mfma_f32_16x16x4f32(dv.y, y[1], z, 0, 0, 0);
            z = __builtin_amdgcn_mfma_f32_16x16x4f32(dv.z, y[2], z, 0, 0, 0); z = __builtin_amdgcn_mfma_f32_16x16x4f32(dv.w, y[3], z, 0, 0, 0);
            LAS float* op = Tl + (16 * b + 4 * g) * TLP + 16 * bc + c;
            op[0] = -z[0]; op[TLP] = -z[1]; op[2 * TLP] = -z[2]; op[3 * TLP] = -z[3];
        }
    LDS_WAIT(); asm volatile("" ::: "memory");
    LAS bf16* Tw = (LAS bf16*)M; LAS bf16* Tu = Tw + 64 * DTP;
    const int cp = FLIP ? 63 - lane : lane;
#pragma unroll 8
    for (int ip = 0; ip < 64; ++ip) { const int cr = FLIP ? 63 - ip : ip; const float t = Tl[ip * TLP + lane]; Tw[cr * DTP + cp] = (bf16)f2bf(t * sw); Tu[cr * DTP + cp] = (bf16)f2bf(t * su); }
}

__device__ __forceinline__ void delta_prep(const Args& a, Frame& F) {
    const bf16* P = (const bf16*)(a.ws + WS_P);
    LAS bf16* Lq = (LAS bf16*)(F.lds + DL_Q); LAS bf16* Lk = (LAS bf16*)(F.lds + DL_K); LAS bf16* LkT = (LAS bf16*)(F.lds + DL_KT); LAS bf16* LvT = (LAS bf16*)(F.lds + DL_VT);
    LAS float* LM0 = (LAS float*)(F.lds + DL_M0); LAS float* LM1 = (LAS float*)(F.lds + DL_M1);
    LAS float* Lg = (LAS float*)(F.lds + DL_SM); LAS float* Lbeta = Lg + 128; LAS float* Lgc = Lg + 256; LAS float* Lbe = Lg + 384;
    const int l0 = F.lane, w = F.wave;
    for (int ci = blockIdx.x; ci < 1280; ci += gridDim.x) {
        int l = l0; asm volatile("" : "+v"(l));
        const int g = l >> 4, c = l & 15;
        int base, T, n, h; delta_item(ci, base, T, n, h);
        __syncthreads();
        { const int s = g, col = 512 * s + 128 * h + 8 * c; const bool act = l < 48;
          v4u xp[12];
#pragma unroll
          for (int rr = 0; rr < 12; ++rr) { const int tt = 64 * n + 8 * w - 2 + rr;
              xp[rr] = (act && tt >= 0 && tt < T) ? *(const v4u*)(P + (size_t)(base + tt) * NPAD + col) : (v4u){0u, 0u, 0u, 0u}; }
          float cw[5][8];
#pragma unroll
          for (int kk = 0; kk < 5; ++kk) { const f32x4 w0 = act ? *(const f32x4*)(a.conv_w + kk * 1536 + col) : (f32x4){0.f, 0.f, 0.f, 0.f}, w1 = act ? *(const f32x4*)(a.conv_w + kk * 1536 + col + 4) : (f32x4){0.f, 0.f, 0.f, 0.f};
              cw[kk][0] = w0.x; cw[kk][1] = w0.y; cw[kk][2] = w0.z; cw[kk][3] = w0.w; cw[kk][4] = w1.x; cw[kk][5] = w1.y; cw[kk][6] = w1.z; cw[kk][7] = w1.w; }
          unsigned ot[8][4];
#pragma unroll
          for (int rr = 0; rr < 8; ++rr) {
              float acc[8];
#pragma unroll
              for (int i = 0; i < 8; ++i) acc[i] = 0.f;
#pragma unroll
              for (int kk = 0; kk < 5; ++kk) { float xv[8]; unpack8(xp[rr + kk], xv);
#pragma unroll
                  for (int i = 0; i < 8; ++i) acc[i] += xv[i] * cw[kk][i]; }
              float ss = 0.f;
#pragma unroll
              for (int i = 0; i < 8; ++i) { acc[i] = silu_f(acc[i]); ss += acc[i] * acc[i]; }
              ss = g16_sum(ss);
              const float sc = s == 2 ? 1.f : (1.f / sqrtf(ss + 1e-6f)) * (s == 0 ? 0.08838834764831845f : 1.f);
#pragma unroll
              for (int p = 0; p < 4; ++p) ot[rr][p] = pk2(acc[2 * p] * sc, acc[2 * p + 1] * sc); }
          if (s < 2) { LAS bf16* dst = s == 0 ? Lq : Lk;
#pragma unroll
              for (int rr = 0; rr < 8; ++rr) *(LAS v4u*)(dst + (8 * w + rr) * DQP + 8 * c) = (v4u){ot[rr][0], ot[rr][1], ot[rr][2], ot[rr][3]}; }
          if (s == 1 || s == 2) { LAS bf16* dst = s == 1 ? LkT : LvT;
#pragma unroll
              for (int p = 0; p < 4; ++p) { v4u lo, hi;
                  lo.x = (ot[0][p] & 0xffffu) | (ot[1][p] << 16); lo.y = (ot[2][p] & 0xffffu) | (ot[3][p] << 16); lo.z = (ot[4][p] & 0xffffu) | (ot[5][p] << 16); lo.w = (ot[6][p] & 0xffffu) | (ot[7][p] << 16);
                  hi.x = (ot[0][p] >> 16) | (ot[1][p] & 0xffff0000u); hi.y = (ot[2][p] >> 16) | (ot[3][p] & 0xffff0000u); hi.z = (ot[4][p] >> 16) | (ot[5][p] & 0xffff0000u); hi.w = (ot[6][p] >> 16) | (ot[7][p] & 0xffff0000u);
                  *(LAS v4u*)(dst + (8 * c + 2 * p) * DTP + 8 * w) = lo; *(LAS v4u*)(dst + (8 * c + 2 * p + 1) * DTP + 8 * w) = hi; } } }
        if (F.tid < 128) { const int dir = F.tid >> 6, row = F.tid & 63, ix = dir * 4 + h; const bf16* rp = P + (size_t)(base + 64 * n + row) * NPAD;
            const float z = bf2f(rp[C_AL + ix]) + a.dt_bias[ix]; const float sp = z > 20.f ? z : log1pf(expf(z));
            Lg[dir * 64 + row] = -expf(a.a_log[ix]) * sp; Lbeta[dir * 64 + row] = 1.f / (1.f + expf(-bf2f(rp[C_BE + ix]))); }
        __syncthreads();
        if (w < 2) { const int dir = w; float v = Lg[dir * 64 + l];
#pragma unroll
            for (int off = 1; off < 64; off <<= 1) { const float t2 = dir ? __shfl_down(v, off) : __shfl_up(v, off); if (dir ? (l + off < 64) : (l >= off)) v += t2; }
            const float gl = __shfl(v, dir ? 0 : 63); const float eg = __expf(v), ekd = __expf(gl - v);
            Lgc[dir * 64 + l] = v; Lbe[dir * 64 + l] = Lbeta[dir * 64 + l] * eg;
            float* sm = (float*)(a.ws + WS_SM) + ((size_t)ci * 2 + dir) * 256; sm[l] = eg; sm[64 + l] = ekd; if (l == 0) sm[128] = __expf(gl); }
        __syncthreads();
        { const int it = w >> 1;
#pragma unroll
          for (int jj2 = 0; jj2 < 2; ++jj2) { const int jt = 2 * (w & 1) + jj2; f32x4 acc = (f32x4){0.f, 0.f, 0.f, 0.f};
#pragma unroll
              for (int s = 0; s < 4; ++s) { const bf16x8 av = *(const LAS bf16x8*)(Lk + (16 * it + c) * DQP + 32 * s + 8 * g), bv = *(const LAS bf16x8*)(Lk + (16 * jt + c) * DQP + 32 * s + 8 * g); acc = MFMA16(av, bv, acc); }
              const int j = 16 * jt + c; const float gfj = Lgc[j], gbj = Lgc[64 + j];
#pragma unroll
              for (int r = 0; r < 4; ++r) { const int i = 16 * it + 4 * g + r;
                  LM0[i * DMP + j] = i > j ? Lbeta[i] * acc[r] * __expf(Lgc[i] - gfj) : 0.f;
                  LM1[i * DMP + j] = i < j ? Lbeta[64 + i] * acc[r] * __expf(Lgc[64 + i] - gbj) : 0.f; } }
          const int m = w & 3, sp2 = w >> 2; f32x4 tf[2], tb[2];
#pragma unroll
          for (int hh = 0; hh < 2; ++hh) { const int mt = 2 * sp2 + hh; f32x4 acc = (f32x4){0.f, 0.f, 0.f, 0.f};
#pragma unroll
              for (int s = 0; s < 4; ++s) { const bf16x8 av = *(const LAS bf16x8*)(Lk + (16 * mt + c) * DQP + 32 * s + 8 * g), bv = *(const LAS bf16x8*)(Lq + (16 * m + c) * DQP + 32 * s + 8 * g); acc = MFMA16(av, bv, acc); }
              const int cq = 16 * m + c; const float gfq = Lgc[cq], gbq = Lgc[64 + cq];
#pragma unroll
              for (int r = 0; r < 4; ++r) { const int cp = 16 * mt + 4 * g + r;
                  tf[hh][r] = cq >= cp ? acc[r] * __expf(gfq - Lgc[cp]) : 0.f; tb[hh][r] = cq <= cp ? acc[r] * __expf(gbq - Lgc[64 + cp]) : 0.f; } }
          bf16x8* qkf = (bf16x8*)(a.ws + WS_QKF) + ((size_t)ci * 2) * 512;
          qkf[(m * 2 + sp2) * 64 + l] = pack_tiles(tf[0], tf[1]); qkf[512 + (m * 2 + sp2) * 64 + l] = pack_tiles(tb[0], tb[1]);
          bf16x8* qf = (bf16x8*)(a.ws + WS_QK) + (size_t)ci * 2048; bf16x8* ktf = qf + 1024;
#pragma unroll
          for (int f2 = 0; f2 < 2; ++f2) { const int f = 2 * w + f2;
              { const int mq = f >> 2, s = f & 3; const s16x4 lo = *(const LAS s16x4*)(Lq + (16 * mq + c) * DQP + 32 * s + 4 * g), hi = *(const LAS s16x4*)(Lq + (16 * mq + c) * DQP + 32 * s + 16 + 4 * g);
                qf[f * 64 + l] = __builtin_shufflevector(lo, hi, 0, 1, 2, 3, 4, 5, 6, 7); }
              { const int mt = f >> 1, s = f & 1; const s16x4 lo = *(const LAS s16x4*)(LkT + (16 * mt + c) * DTP + 32 * s + 4 * g), hi = *(const LAS s16x4*)(LkT + (16 * mt + c) * DTP + 32 * s + 16 + 4 * g);
                ktf[f * 64 + l] = __builtin_shufflevector(lo, hi, 0, 1, 2, 3, 4, 5, 6, 7); } } }
        __syncthreads();
        if (w == 0) tri_inv<false>(LM0, (LAS float*)(F.lds + DL_Q), Lbe[l], Lbeta[l], l);
        else if (w == 1) tri_inv<true>(LM1, (LAS float*)(F.lds + DL_K), Lbe[64 + 63 - l], Lbeta[64 + 63 - l], l);
        __syncthreads();
        { const int dir = w >> 2, wq = w & 3; const LAS bf16* Tw = (const LAS bf16*)(dir ? LM1 : LM0); const LAS bf16* Tu = Tw + 64 * DTP;
          bf16x8* wf = (bf16x8*)((unsigned char*)a.out + OUT_WF) + ((size_t)ci * 2 + dir) * 1024;
          bf16x8 bt[2];
#pragma unroll
          for (int sp = 0; sp < 2; ++sp) bt[sp] = *(const LAS bf16x8*)(Tw + (16 * wq + c) * DTP + 32 * sp + 8 * g);
#pragma unroll
          for (int s = 0; s < 4; ++s) { f32x4 t2[2];
#pragma unroll
              for (int hh = 0; hh < 2; ++hh) { const int mt = 2 * s + hh; f32x4 acc = (f32x4){0.f, 0.f, 0.f, 0.f};
#pragma unroll
                  for (int sp = 0; sp < 2; ++sp) { const bf16x8 av = *(const LAS bf16x8*)(LkT + (16 * mt + c) * DTP + 32 * sp + 8 * g); acc = MFMA16(av, bt[sp], acc); }
                  t2[hh] = acc; }
              wf[(wq * 4 + s) * 64 + l] = pack_tiles(t2[0], t2[1]); }
          v4u* uf = (v4u*)((unsigned char*)a.out + OUT_UF) + ((size_t)ci * 2 + dir) * 1024;
#pragma unroll
          for (int n2 = 0; n2 < 2; ++n2) { const int ne = 2 * wq + n2; bf16x8 bv[2]; f32x4 ut[4];
#pragma unroll
              for (int sp = 0; sp < 2; ++sp) bv[sp] = *(const LAS bf16x8*)(LvT + (16 * ne + c) * DTP + 32 * sp + 8 * g);
#pragma unroll
              for (int m = 0; m < 4; ++m) { f32x4 acc = (f32x4){0.f, 0.f, 0.f, 0.f};
#pragma unroll
                  for (int sp = 0; sp < 2; ++sp) { const bf16x8 av = *(const LAS bf16x8*)(Tu + (16 * m + c) * DTP + 32 * sp + 8 * g); acc = MFMA16(av, bv[sp], acc); }
                  ut[m] = acc; }
              v4u o0, o1; o0.x = pk2(ut[0][0], ut[0][1]); o0.y = pk2(ut[0][2], ut[0][3]); o0.z = pk2(ut[1][0], ut[1][1]); o0.w = pk2(ut[1][2], ut[1][3]);
              o1.x = pk2(ut[2][0], ut[2][1]); o1.y = pk2(ut[2][2], ut[2][3]); o1.z = pk2(ut[3][0], ut[3][1]); o1.w = pk2(ut[3][2], ut[3][3]);
              uf[(ne * 64 + l) * 2] = o0; uf[(ne * 64 + l) * 2 + 1] = o1; } }
    }
}

__device__ __forceinline__ void ds_compute(Frame& F, bf16* P, v4u (&RS)[17], int st, int base, int dir, int h, int j, int N) {
    const int l = F.lane, g = l >> 4, c = l & 15, w = F.wave & 3;
    f32x4 S[8];
#pragma unroll
    for (int mt = 0; mt < 8; ++mt) S[mt] = __builtin_bit_cast(f32x4, RS[mt]);
    const int n = dir ? N - 1 - st : st;
    const LAS unsigned char* slot = F.lds + (st & 1) * 66560;
    const LAS bf16x8* QF = (const LAS bf16x8*)slot; const LAS bf16x8* KTF = QF + 1024; const LAS bf16x8* WF = QF + 2048; const LAS bf16x8* QKF = QF + 3072;
    const LAS v4u* up = (const LAS v4u*)(slot + 57344) + (w * 64 + l) * 2; const LAS float* sm = (const LAS float*)(slot + 65536);
    const v4u u0 = up[0], u1 = up[1];
    const unsigned uw[8] = {u0.x, u0.y, u0.z, u0.w, u1.x, u1.y, u1.z, u1.w};
    bf16x8 Sb[4];
#pragma unroll
    for (int s = 0; s < 4; ++s) Sb[s] = pack_tiles(S[2 * s], S[2 * s + 1]);
    f32x4 vn[4];
#pragma unroll
    for (int m = 0; m < 4; ++m) { f32x4 acc = (f32x4){0.f, 0.f, 0.f, 0.f};
#pragma unroll
        for (int s = 0; s < 4; ++s) acc = MFMA16(WF[(m * 4 + s) * 64 + l], Sb[s], acc);
        vn[m][0] = bflo(uw[2 * m]) - acc[0]; vn[m][1] = bfhi(uw[2 * m]) - acc[1]; vn[m][2] = bflo(uw[2 * m + 1]) - acc[2]; vn[m][3] = bfhi(uw[2 * m + 1]) - acc[3]; }
    bf16x8 vb[2], vk[2];
#pragma unroll
    for (int s = 0; s < 2; ++s) { vb[s] = pack_tiles(vn[2 * s], vn[2 * s + 1]);
        const f32x4 e0 = *(const LAS f32x4*)(sm + 64 + 32 * s + 4 * g), e1 = *(const LAS f32x4*)(sm + 64 + 32 * s + 16 + 4 * g);
        vk[s] = pack_tiles(vn[2 * s] * e0, vn[2 * s + 1] * e1); }
    const float gl = sm[128];
#pragma unroll
    for (int m = 0; m < 4; ++m) { f32x4 acc = (f32x4){0.f, 0.f, 0.f, 0.f};
#pragma unroll
        for (int s = 0; s < 4; ++s) acc = MFMA16(QF[(m * 4 + s) * 64 + l], Sb[s], acc);
        acc = acc * *(const LAS f32x4*)(sm + 16 * m + 4 * g);
#pragma unroll
        for (int s = 0; s < 2; ++s) acc = MFMA16(QKF[(m * 2 + s) * 64 + l], vb[s], acc);
        bf16* op = P + (size_t)(base + 64 * n + 16 * m + 4 * g) * NPAD + dir * 512 + h * 128 + 16 * j + c;
#pragma unroll
        for (int r = 0; r < 4; ++r) op[(size_t)r * NPAD] = (bf16)f2bf(acc[r]); }
#pragma unroll
    for (int mt = 0; mt < 8; ++mt) { f32x4 acc = S[mt] * gl;
#pragma unroll
        for (int s = 0; s < 2; ++s) acc = MFMA16(KTF[(mt * 2 + s) * 64 + l], vk[s], acc);
        S[mt] = acc; }
#pragma unroll
    for (int mt = 0; mt < 8; ++mt) RS[mt] = __builtin_bit_cast(v4u, S[mt]);
}
constexpr int DS_SLOT = 66560;
__device__ __forceinline__ void delta_scan_sample(const Args& a, Frame& F) {
    const int b = blockIdx.x, q = b >> 1, half = b & 1;
    const int dir = q & 1, h = (q >> 1) & 3, sq = q >> 3, N = 64, base = NPR + sq * 4096;
    const int l = F.lane, g = l >> 4, c = l & 15, w = F.wave, j = 4 * half + (w & 3);
    const bool loader = w >= 4; const int lw = w & 3;
    bf16* P = (bf16*)(a.ws + WS_P);
    const unsigned char* gQK = a.ws + WS_QK; const unsigned char* gWF = (const unsigned char*)a.out + OUT_WF; const unsigned char* gQKF = a.ws + WS_QKF;
    const unsigned char* gUF = (const unsigned char*)a.out + OUT_UF; const unsigned char* gSM = a.ws + WS_SM;
#define DS_CI(st) (((sq * 64 + (dir ? N - 1 - (st) : (st))) * 4 + h))
#define DS_SRC(ci_, p) ((p) < 32 ? gQK + (size_t)(ci_) * 32768 + (p) * 1024 : (p) < 48 ? gWF + ((size_t)(ci_) * 2 + dir) * 16384 + ((p) - 32) * 1024 : \
        (p) < 56 ? gQKF + ((size_t)(ci_) * 2 + dir) * 8192 + ((p) - 48) * 1024 : (p) < 64 ? gUF + ((size_t)(ci_) * 2 + dir) * 16384 + half * 8192 + ((p) - 56) * 1024 : gSM + ((size_t)(ci_) * 2 + dir) * 1024)
#define DS_LOAD(SET, st) do { const int ci_ = DS_CI(st); _Pragma("unroll") for (int i_ = 0; i_ < 17; ++i_) { const int p_ = lw + 4 * i_; if (p_ < 65) SET[i_] = *(const v4u*)(DS_SRC(ci_, p_) + l * 16); } } while (0)
#define DS_WRITE(SET, slot) do { _Pragma("unroll") for (int i_ = 0; i_ < 17; ++i_) { const int p_ = lw + 4 * i_; if (p_ < 65) *(LAS v4u*)(F.lds + (slot) * DS_SLOT + p_ * 1024 + l * 16) = SET[i_]; } } while (0)
    v4u r0[17], r1[17];
    __syncthreads();
    if (loader) { DS_LOAD(r0, 0); DS_LOAD(r1, 1); DS_WRITE(r0, 0); DS_LOAD(r0, 2); }
    else { const float* S0 = a.state_delta + ((size_t)(sq * 2 + dir) * 4 + h) * 16384;
#pragma unroll
        for (int mt = 0; mt < 8; ++mt) { f32x4 t;
#pragma unroll
            for (int r = 0; r < 4; ++r) t[r] = S0[(size_t)(16 * mt + 4 * g + r) * 128 + 16 * j + c];
            r1[mt] = __builtin_bit_cast(v4u, t); }
    }
#define DS_STEP(st, SET) do { if ((st) < N) { \
        __syncthreads(); \
        if (loader) { if ((st) + 1 < N) { DS_WRITE(SET, ((st) + 1) & 1); if ((st) + 3 < N) DS_LOAD(SET, (st) + 3); } } \
        else { ds_compute(F, P, r1, (st), base, dir, h, j, N); } } } while (0)
    for (int st0 = 0; st0 < N; st0 += 2) { DS_STEP(st0, r1); DS_STEP(st0 + 1, r0); }
#undef DS_CI
#undef DS_SRC
#undef DS_LOAD
#undef DS_WRITE
#undef DS_STEP
}

constexpr int DB_BUF = 57344;
__device__ __forceinline__ void delta_scan(const Args& a, Frame& F) {
    const int b = blockIdx.x; if (b >= 192) return;
    if (b < 64) { delta_scan_sample(a, F); return; }
    const bool smp = b < 64; const int q = smp ? (b >> 1) : b - 64, half = b & 1;
    const int dir = q & 1, h = (q >> 1) & 3, sq = q >> 3, N = smp ? 64 : 4, base = smp ? NPR + sq * 4096 : sq * 256;
    const int l = F.lane, g = l >> 4, c = l & 15, j = smp ? 4 * half + (F.wave & 3) : F.wave, dj = F.wave;
    const bool act = smp ? F.wave < 4 : true;
    bf16* P = (bf16*)(a.ws + WS_P);
    const unsigned char* gQK = a.ws + WS_QK; const unsigned char* gWF = (const unsigned char*)a.out + OUT_WF; const unsigned char* gQKF = a.ws + WS_QKF;
    const unsigned char* gUF = (const unsigned char*)a.out + OUT_UF; const float* gSM = (const float*)(a.ws + WS_SM);
    f32x4 S[8];
    if (smp) { const float* S0 = a.state_delta + ((size_t)(sq * 2 + dir) * 4 + h) * 16384;
#pragma unroll
        for (int mt = 0; mt < 8; ++mt)
#pragma unroll
            for (int r = 0; r < 4; ++r) S[mt][r] = S0[(size_t)(16 * mt + 4 * g + r) * 128 + 16 * j + c]; }
    else {
#pragma unroll
        for (int mt = 0; mt < 8; ++mt) S[mt] = (f32x4){0.f, 0.f, 0.f, 0.f}; }
#define DB_CI(st) ({ const int n_ = dir ? N - 1 - (st) : (st); smp ? (sq * 64 + n_) * 4 + h : 1024 + (sq * 4 + n_) * 4 + h; })
#define DB_DMA(st, buf) do { const int ci_ = DB_CI(st); _Pragma("unroll") for (int i_ = 0; i_ < 7; ++i_) { const int qd = 7 * dj + i_; \
        const unsigned char* src = qd < 32 ? gQK + (size_t)ci_ * 32768 + qd * 1024 : (qd < 48 ? gWF + ((size_t)ci_ * 2 + dir) * 16384 + (qd - 32) * 1024 : gQKF + ((size_t)ci_ * 2 + dir) * 8192 + (qd - 48) * 1024); \
        __builtin_amdgcn_global_load_lds((const unsigned*)(src + l * 16), (LAS unsigned*)(F.lds + (buf) * DB_BUF + qd * 1024), 16, 0, 0); } } while (0)
    __syncthreads();
    DB_DMA(0, 0);
    v4u nu0, nu1; f32x4 neg[4], nek[4]; float ngl;
    { const int ci0 = DB_CI(0); const v4u* up = (const v4u*)(gUF + ((size_t)ci0 * 2 + dir) * 16384) + (j * 64 + l) * 2; nu0 = up[0]; nu1 = up[1];
      const float* sm = gSM + ((size_t)ci0 * 2 + dir) * 256;
#pragma unroll
      for (int m = 0; m < 4; ++m) { neg[m] = *(const f32x4*)(sm + 16 * m + 4 * g); nek[m] = *(const f32x4*)(sm + 64 + 16 * m + 4 * g); }
      ngl = sm[128]; }
    unsigned po[8] = {0u, 0u, 0u, 0u, 0u, 0u, 0u, 0u}; int pn_ = 0;
    for (int st = 0; st < N; ++st) {
        asm volatile("s_waitcnt vmcnt(0)" ::: "memory");
        __syncthreads();
        if (act && st > 0) {
#pragma unroll
            for (int m = 0; m < 4; ++m) { bf16* op = P + (size_t)(base + 64 * pn_ + 16 * m + 4 * g) * NPAD + dir * 512 + h * 128 + 16 * j + c;
                op[0] = (bf16)(po[2 * m] & 0xffffu); op[(size_t)NPAD] = (bf16)(po[2 * m] >> 16); op[(size_t)2 * NPAD] = (bf16)(po[2 * m + 1] & 0xffffu); op[(size_t)3 * NPAD] = (bf16)(po[2 * m + 1] >> 16); } }
        const v4u u0 = nu0, u1 = nu1; f32x4 eg[4], ek[4];
#pragma unroll
        for (int m = 0; m < 4; ++m) { eg[m] = neg[m]; ek[m] = nek[m]; }
        const float gl = ngl;
        const int n = dir ? N - 1 - st : st;
        if (st + 1 < N) { DB_DMA(st + 1, (st + 1) & 1);
            const int ci1 = DB_CI(st + 1); const v4u* up = (const v4u*)(gUF + ((size_t)ci1 * 2 + dir) * 16384) + (j * 64 + l) * 2; nu0 = up[0]; nu1 = up[1];
            const float* sm = gSM + ((size_t)ci1 * 2 + dir) * 256;
#pragma unroll
            for (int m = 0; m < 4; ++m) { neg[m] = *(const f32x4*)(sm + 16 * m + 4 * g); nek[m] = *(const f32x4*)(sm + 64 + 16 * m + 4 * g); }
            ngl = sm[128]; }
        if (act) {
        const LAS bf16x8* bufp = (const LAS bf16x8*)(F.lds + (st & 1) * DB_BUF);
        const LAS bf16x8* QF = bufp; const LAS bf16x8* KTF = bufp + 1024; const LAS bf16x8* WF = bufp + 2048; const LAS bf16x8* QKF = bufp + 3072;
        bf16x8 Sb[4];
#pragma unroll
        for (int s = 0; s < 4; ++s) Sb[s] = pack_tiles(S[2 * s], S[2 * s + 1]);
        const float uu[16] = {bflo(u0.x), bfhi(u0.x), bflo(u0.y), bfhi(u0.y), bflo(u0.z), bfhi(u0.z), bflo(u0.w), bfhi(u0.w), bflo(u1.x), bfhi(u1.x), bflo(u1.y), bfhi(u1.y), bflo(u1.z), bfhi(u1.z), bflo(u1.w), bfhi(u1.w)};
        f32x4 vn[4];
#pragma unroll
        for (int m = 0; m < 4; ++m) { f32x4 acc = (f32x4){0.f, 0.f, 0.f, 0.f};
#pragma unroll
            for (int s = 0; s < 4; ++s) acc = MFMA16(WF[(m * 4 + s) * 64 + l], Sb[s], acc);
#pragma unroll
            for (int r = 0; r < 4; ++r) vn[m][r] = uu[4 * m + r] - acc[r]; }
        bf16x8 vb[2], vk[2];
#pragma unroll
        for (int s = 0; s < 2; ++s) { vb[s] = pack_tiles(vn[2 * s], vn[2 * s + 1]); vk[s] = pack_tiles(vn[2 * s] * ek[2 * s], vn[2 * s + 1] * ek[2 * s + 1]); }
#pragma unroll
        for (int m = 0; m < 4; ++m) { f32x4 acc = (f32x4){0.f, 0.f, 0.f, 0.f};
#pragma unroll
            for (int s = 0; s < 4; ++s) acc = MFMA16(QF[(m * 4 + s) * 64 + l], Sb[s], acc);
            acc = acc * eg[m];
#pragma unroll
            for (int s = 0; s < 2; ++s) acc = MFMA16(QKF[(m * 2 + s) * 64 + l], vb[s], acc);
            po[2 * m] = pk2(acc[0], acc[1]); po[2 * m + 1] = pk2(acc[2], acc[3]); }
        pn_ = n;
#pragma unroll
        for (int mt = 0; mt < 8; ++mt) { f32x4 acc = S[mt] * gl;
#pragma unroll
            for (int s = 0; s < 2; ++s) acc = MFMA16(KTF[(mt * 2 + s) * 64 + l], vk[s], acc);
            S[mt] = acc; }
        }
    }
    if (act) {
#pragma unroll
        for (int m = 0; m < 4; ++m) { bf16* op = P + (size_t)(base + 64 * pn_ + 16 * m + 4 * g) * NPAD + dir * 512 + h * 128 + 16 * j + c;
            op[0] = (bf16)(po[2 * m] & 0xffffu); op[(size_t)NPAD] = (bf16)(po[2 * m] >> 16); op[(size_t)2 * NPAD] = (bf16)(po[2 * m + 1] & 0xffffu); op[(size_t)3 * NPAD] = (bf16)(po[2 * m + 1] >> 16); } }
    if (!smp) { float* So = a.out + OUT_SD + ((size_t)(sq * 2 + dir) * 4 + h) * 16384;
#pragma unroll
        for (int mt = 0; mt < 8; ++mt)
#pragma unroll
            for (int r = 0; r < 4; ++r) So[(size_t)(16 * mt + 4 * g + r) * 128 + 16 * j + c] = S[mt][r]; }
#undef DB_CI
#undef DB_DMA
}

constexpr int N_PHASES = 12;
#ifndef PROBE_PHASE
#define PROBE_PHASE (-1)
#endif
#define PROBE_MULT 4
#ifndef N_LAUNCHES
#define N_LAUNCHES 1
#endif
__global__ void __launch_bounds__(NWAVES * 64, 2) fwd(Args a) {
    extern __shared__ __attribute__((aligned(16))) unsigned char lds[];
    Frame F; F.lds = (LAS unsigned char*)lds; F.tid = threadIdx.x; F.lane = F.tid & 63; F.wave = __builtin_amdgcn_readfirstlane(F.tid >> 6);
    F.gw = blockIdx.x * NWAVES + F.wave; F.NGW = gridDim.x * NWAVES;
    const int lo = a.ph_lo, hi = a.ph_hi;
    const float* mod = (const float*)(a.ws + WS_CTL + CTL_MOD_OFF);
    volatile LAS unsigned* MISC = (volatile LAS unsigned*)(F.lds + MISC_OFF);
    for (int u = F.tid; u < (LDS_BYTES - LDSCTL_OFF) / 4; u += NWAVES * 64) ((LAS unsigned*)(F.lds + LDSCTL_OFF))[u] = 0u;
    __syncthreads();
    XcdBarrier bar; bar.bar = (unsigned*)(a.ws + WS_CTL) + CW_BAR; bar.x = 0; bar.st = nullptr;
    if (hi - lo > 1) bar = xcd_barrier_post((unsigned*)(a.ws + WS_CTL) + CW_BAR, MISC + 8);
#define IN(k) (lo <= (k) && (k) < hi)
    unsigned long long pt0_ = 0, pt1_ = 0;
#define SEAM(k) do { if (PROBE_PHASE == (k)) pt1_ = 0; if (IN(k) && IN((k) + 1)) xcd_barrier(bar); if (PROBE_PHASE == (k)) pt1_ = __builtin_amdgcn_s_memrealtime(); if (PROBE_PHASE == (k) + 1) pt0_ = __builtin_amdgcn_s_memrealtime(); } while (0)
    if (PROBE_PHASE == 0) pt0_ = __builtin_amdgcn_s_memrealtime();
    if (IN(0)) p0_prologue(a, F);
    SEAM(0);
    if (IN(1)) p1_h(a, F);
    SEAM(1);
    if (IN(2)) { pg8::Gemm g{(const pg8::bf16_t*)(a.ws + WS_H), (const pg8::bf16_t*)(a.ws + WS_WIN), NROW, NPAD, D}; pg8::StaticOrder S; S.init(NROW, NPAD, gridDim.x, (int)blockIdx.x);
        pg8::EpiBf16<0> E{(pg8::bf16_t*)(a.ws + WS_P), NPAD, nullptr};
        pg8::gemm_phase<pg8::EpiBf16<0>, pg8::StaticOrder, true, true>(F.lds, g, S, E); }
    SEAM(2);
    if (IN(3)) { delta_prep(a, F); ret_ra(a, F); }
    SEAM(3);
    if (IN(4)) { delta_scan(a, F); ret_rb(a, F); }
    SEAM(4);
    if (IN(5)) { ret_rc(a, F); __syncthreads(); late_weights(a, F); }
    SEAM(5);
    if (IN(6)) p5_combine(a, F);
    SEAM(6);
    if (IN(7)) { pg8::Gemm g{(const pg8::bf16_t*)(a.ws + WS_H), (const pg8::bf16_t*)(a.ws + WS_WO), NROW, D, D}; pg8::StaticOrder S; S.init(NROW, D, gridDim.x, (int)blockIdx.x);
        pg8::EpiResid E{a.x_prompt, a.x_sample - (size_t)NPR * D, a.out, D, nullptr, mod + 2048, MODW, ALPHA_DN};
        pg8::gemm_phase<pg8::EpiResid, pg8::StaticOrder, true, true>(F.lds, g, S, E); }
    SEAM(7);
    if (IN(8)) p6b_ln1(a, F);
    SEAM(8);
    if (IN(9)) { pg8::Gemm g{(const pg8::bf16_t*)(a.ws + WS_H), (const pg8::bf16_t*)(a.ws + WS_W1), NROW, FF, D}; pg8::StaticOrder S; S.init(NROW, FF, gridDim.x, (int)blockIdx.x);
        pg8::EpiBf16<2> E{(pg8::bf16_t*)(a.ws + WS_P), FF, a.b_ff1};
        pg8::gemm_phase<pg8::EpiBf16<2>, pg8::StaticOrder, true, true>(F.lds, g, S, E); }
    SEAM(9);
    if (IN(10)) { pg8::Gemm g{(const pg8::bf16_t*)(a.ws + WS_P), (const pg8::bf16_t*)(a.ws + WS_W2), NROW, D, FF}; pg8::StaticOrder S; S.init(NROW, D, gridDim.x, (int)blockIdx.x);
        pg8::EpiResid E{a.out, a.out, a.out, D, a.b_ff2, mod + 5120, MODW, ALPHA_DN};
        pg8::gemm_phase<pg8::EpiResid, pg8::StaticOrder, true, true>(F.lds, g, S, E); }
    SEAM(10);
    if (IN(11)) p8b_ln2(a, F);
    if (PROBE_PHASE == 11) pt1_ = __builtin_amdgcn_s_memrealtime();
    if (PROBE_PHASE >= 0 && blockIdx.x == 0) { const unsigned long long want = (pt1_ - pt0_) * PROBE_MULT, s0_ = __builtin_amdgcn_s_memrealtime(); while (__builtin_amdgcn_s_memrealtime() - s0_ < want) __builtin_amdgcn_s_sleep(8); }
#undef IN
#undef SEAM
}

extern "C" void kernel_launch(void* const* d_in, const int* in_sizes, int n_in, void* d_out, int out_size, void* d_ws, size_t ws_size, hipStream_t stream) {
    static int grid = 0;
    if (grid == 0) {
        if (n_in != 24 || ws_size < WS_END || (size_t)out_size != OUT_SR + (size_t)16 * 2 * 4 * 64 * 128) { fprintf(stderr, "kernel_launch: unexpected problem: n_in %d out %d ws %zu\n", n_in, out_size, ws_size); grid = -1; return; }
        int dev = 0, cus = 0, per_cu = 0;
        if (hipGetDevice(&dev) != hipSuccess || hipDeviceGetAttribute(&cus, hipDeviceAttributeMultiprocessorCount, dev) != hipSuccess) { grid = -1; return; }
        if (hipFuncSetAttribute((const void*)fwd, hipFuncAttributeMaxDynamicSharedMemorySize, LDS_BYTES) != hipSuccess) { fprintf(stderr, "kernel_launch: hipFuncSetAttribute failed\n"); grid = -1; return; }
        if (hipOccupancyMaxActiveBlocksPerMultiprocessor(&per_cu, (const void*)fwd, NWAVES * 64, LDS_BYTES) != hipSuccess || per_cu < 1) { fprintf(stderr, "kernel_launch: occupancy query says %d workgroups per CU\n", per_cu); (void)hipGetLastError(); grid = -1; return; }
        grid = cus;
    }
    if (grid < 0) return;
    (void)hipMemsetAsync((char*)d_ws + WS_CTL, 0, CTL_ZERO_BYTES, stream);
    Args a{};
    const float** ap = (const float**)&a;
    for (int i = 0; i < 24; ++i) ap[i] = (const float*)d_in[i];
    a.out = (float*)d_out; a.ws = (unsigned char*)d_ws;
    if (N_LAUNCHES == 1) { a.ph_lo = 0; a.ph_hi = N_PHASES; hipLaunchKernelGGL(fwd, dim3(grid), dim3(NWAVES * 64), LDS_BYTES, stream, a); }
    else for (int p = 0; p < N_PHASES; ++p) { a.ph_lo = p; a.ph_hi = p + 1; hipLaunchKernelGGL(fwd, dim3(grid), dim3(NWAVES * 64), LDS_BYTES, stream, a); }
}
```

```cpp
#include <hip/hip_runtime.h>
#include <cstdio>
#include <cstdint>
namespace pg8 {
#define PG8_LAS __attribute__((address_space(3)))
typedef unsigned short bf16_t;
typedef short bf16x8 __attribute__((ext_vector_type(8)));
typedef float f32x4 __attribute__((ext_vector_type(4)));
typedef unsigned u32x4 __attribute__((ext_vector_type(4)));
constexpr int BM = 256, BK = 64, HALF = 128, HTB = HALF * BK * 2  , STAGE_BYTES = 8 * HTB, NXCD = 8, WGM = 8;

__host__ __device__ __forceinline__ int lds_byte(int r, int c) { const int st = (r >> 4) * 2 + (c >> 5), rr = r & 15, cc = c & 31, ob = rr * 64 + cc * 2; return st * 1024 + (ob ^ (((ob >> 9) & 1) << 5)); }
__host__ __device__ __forceinline__ void stage_rc(int b, int& R, int& C) { const int st = b / 1024, sb = b % 1024, swz = sb ^ (((sb >> 9) & 1) << 5); R = (st >> 1) * 16 + swz / 64; C = (st & 1) * 32 + (swz % 64) / 2; }
__host__ __device__ __forceinline__ int perm32(int rho) { const int n = rho >> 4, i = rho & 15; return 8 * (i >> 2) + 4 * n + (i & 3); }

struct Unit { int pm, pn, k0, nk, ks; };
struct Gemm { const bf16_t* A; const bf16_t* Bt; int M, N, K; };

struct StaticOrder {
    int nM, nN, nwg, G, c, nkt;
    __host__ __device__ void init(int M, int N, int K, int G_, int c_) { nM = M / BM; nN = N / BM; nwg = nM * nN; G = G_; c = c_; nkt = K / BK; }
    __host__ __device__ bool next(int i, Unit& u) const {
        const long L = (long)i * G + c; if (L >= nwg) return false;
        int wgid = (int)L; { const int q = nwg / NXCD, r = nwg % NXCD, xcd = wgid % NXCD, off = wgid / NXCD; wgid = (xcd < r ? xcd * (q + 1) : r * (q + 1) + (xcd - r) * q) + off; }
        const int nig = WGM * nN, gid = wgid / nig, fm = gid * WGM, gsz = (nM - fm) < WGM ? (nM - fm) : WGM;
        u.pm = fm + ((wgid % nig) % gsz); u.pn = (wgid % nig) / gsz; u.k0 = 0; u.nk = nkt; u.ks = -1; return true;
    }
    __device__ __forceinline__ void a_ready(const Unit&) const {}
    __device__ __forceinline__ void done(const Unit&) const {}
};


struct SplitTail {
    StaticOrder so; int c, nkt;
    __host__ __device__ void init(int K, int G_, int c_) { so.init(16384, 1024, K, G_, c_); c = c_; nkt = K / BK; }
    __host__ __device__ bool next(int i, Unit& u) const {
        if (i == 0) return so.next(0, u);
        if (i != 1) return false;
        const int xcd = c & 7, y = c >> 3, grp = xcd * 8 + (y >> 2);
        u.pn = y & 3; u.pm = 64 + (grp >> 2); u.ks = grp & 3; u.nk = nkt / 4; u.k0 = u.ks * u.nk; return true;
    }
    __device__ __forceinline__ void a_ready(const Unit&) const {}
    __device__ __forceinline__ void done(const Unit&) const {}
};
__device__ __forceinline__ unsigned cvt_pk_bf16(float lo, float hi) { unsigned r; asm volatile("v_cvt_pk_bf16_f32 %0, %1, %2" : "=v"(r) : "v"(lo), "v"(hi)); return r; }
template <int ACT> struct EpiBf16 {
    static constexpr bool PERM = true, AFTER_DRAIN = false;
    bf16_t* O; int ldc; const float* bias;
    __device__ __forceinline__ void operator()(const f32x4 (&acc)[2][2][4][2], const Unit& u, int wr, int wc, int fr, int fq) const {
        const int row0 = u.pm * BM + wr * 64 + fr; const int col0 = u.pn * BM + wc * 32 + 8 * fq;
        f32x4 bv[2][2];
#pragma unroll
        for (int bj = 0; bj < 2; ++bj)
#pragma unroll
            for (int n = 0; n < 2; ++n) bv[bj][n] = bias ? *(const f32x4*)(bias + col0 + bj * HALF + 4 * n) : (f32x4){0.f, 0.f, 0.f, 0.f};
#pragma unroll
        for (int ai = 0; ai < 2; ++ai)
#pragma unroll
            for (int m = 0; m < 4; ++m) { bf16_t* rowp = O + (size_t)(row0 + ai * HALF + m * 16) * ldc + col0;
#pragma unroll
                for (int bj = 0; bj < 2; ++bj) { f32x4 v0 = acc[ai][bj][m][0] + bv[bj][0], v1 = acc[ai][bj][m][1] + bv[bj][1];
                    if (ACT == 2) {
#pragma unroll
                        for (int i = 0; i < 4; ++i) { const float a = v0[i] > 0.f ? v0[i] : 0.f, b = v1[i] > 0.f ? v1[i] : 0.f; v0[i] = a * a; v1[i] = b * b; } }
                    u32x4 w; w.x = cvt_pk_bf16(v0[0], v0[1]); w.y = cvt_pk_bf16(v0[2], v0[3]); w.z = cvt_pk_bf16(v1[0], v1[1]); w.w = cvt_pk_bf16(v1[2], v1[3]);
                    *(u32x4*)(rowp + bj * HALF) = w; } }
    }
};
struct EpiResid {
    static constexpr bool PERM = false, AFTER_DRAIN = false;
    const float* base0; const float* base1; float* out; int ldc; const float* bias; const float* gate; int gate_pitch; float alpha;
    __device__ __forceinline__ void operator()(const f32x4 (&acc)[2][2][4][2], const Unit& u, int wr, int wc, int fr, int fq) const {
        const int row0 = u.pm * BM + wr * 64 + fr; const int col0 = u.pn * BM + wc * 32 + 4 * fq;
        const int r0 = u.pm * BM; const int vrow = r0 < 4096 ? 0 : 1 + ((r0 - 4096) >> 12);
        const float* gp = gate + (size_t)vrow * gate_pitch; const float* base = r0 < 4096 ? base0 : base1;
        f32x4 bv[2][2], gv[2][2];
#pragma unroll
        for (int bj = 0; bj < 2; ++bj)
#pragma unroll
            for (int n = 0; n < 2; ++n) { bv[bj][n] = bias ? *(const f32x4*)(bias + col0 + bj * HALF + n * 16) : (f32x4){0.f, 0.f, 0.f, 0.f}; gv[bj][n] = *(const f32x4*)(gp + col0 + bj * HALF + n * 16); }
#pragma unroll
        for (int ai = 0; ai < 2; ++ai)
#pragma unroll
            for (int m = 0; m < 4; ++m) { const size_t off = (size_t)(row0 + ai * HALF + m * 16) * ldc + col0;
#pragma unroll
                for (int bj = 0; bj < 2; ++bj)
#pragma unroll
                    for (int n = 0; n < 2; ++n) { const f32x4 bs = *(const f32x4*)(base + off + bj * HALF + n * 16);
                        const f32x4 o = bs * alpha + gv[bj][n] * (acc[ai][bj][m][n] + bv[bj][n]);
                        *(f32x4*)(out + off + bj * HALF + n * 16) = o; } }
    }
};

struct EpiSplit {
    static constexpr bool PERM = true, AFTER_DRAIN = false;
    bf16_t* O; bf16_t* slab0; bf16_t* slab1; int ldc;
    __device__ __forceinline__ void operator()(const f32x4 (&acc)[2][2][4][2], const Unit& u, int wr, int wc, int fr, int fq) const {
        const int col0 = u.pn * BM + wc * 32 + 8 * fq;
        bf16_t* base = u.ks < 0 ? O + (size_t)(u.pm * BM) * ldc : (u.ks < 2 ? slab0 : slab1) + ((size_t)(u.ks & 1) * 4096 + (size_t)(u.pm * BM - 16384)) * ldc;
#pragma unroll
        for (int ai = 0; ai < 2; ++ai)
#pragma unroll
            for (int m = 0; m < 4; ++m) { bf16_t* rowp = base + (size_t)(wr * 64 + fr + ai * HALF + m * 16) * ldc + col0;
#pragma unroll
                for (int bj = 0; bj < 2; ++bj) { const f32x4 v0 = acc[ai][bj][m][0], v1 = acc[ai][bj][m][1];
                    u32x4 w; w.x = cvt_pk_bf16(v0[0], v0[1]); w.y = cvt_pk_bf16(v0[2], v0[3]); w.z = cvt_pk_bf16(v1[0], v1[1]); w.w = cvt_pk_bf16(v1[2], v1[3]);
                    *(u32x4*)(rowp + bj * HALF) = w; } }
    }
};

template <class Epi, class Sched, bool ALIGN_EPI = false, bool SP2 = false>
__device__ __forceinline__ void gemm_phase(PG8_LAS unsigned char* lds, const Gemm g, const Sched& S, const Epi& E) {
    const int tid = threadIdx.x, wid = __builtin_amdgcn_readfirstlane(tid >> 6), lane = tid & 63, wr = wid >> 2, wc = wid & 3, fr = lane & 15, fq = lane >> 4;
    const int K = g.K;
    unsigned voffA[2], voffB[2];
#pragma unroll
    for (int i = 0; i < 2; ++i) { int R, C; stage_rc(tid * 16 + i * 8192, R, C); const int Rb = Epi::PERM ? ((R & ~31) + perm32(R & 31)) : R;
        voffA[i] = (unsigned)(R * K + C) * 2u; voffB[i] = (unsigned)(Rb * K + C) * 2u; }
    const size_t kstep = (size_t)(BK * 2);
    const size_t hstep = (size_t)HALF * K * 2;
    const size_t tstep = 2 * hstep;
    const unsigned ldsw = (unsigned)wid * 1024u;
    const int aoff = lds_byte(wr * 64 + fr, fq * 8), boff = lds_byte(wc * 32 + fr, fq * 8);
#define PG8_SA(b, h) (((b) * 2 + (h)) * HTB)
#define PG8_SB(b, h) ((4 + (b) * 2 + (h)) * HTB)
#define PG8_STAGE(bufoff, gbase, voff) do { _Pragma("unroll") for (int _i = 0; _i < 2; ++_i) \
        __builtin_amdgcn_global_load_lds((const unsigned*)((const char*)(gbase) + (voff)[_i]), (PG8_LAS unsigned*)(lds + (bufoff) + ldsw + _i * 8192), 16, 0, 0); } while (0)
#define PG8_LDA(dst, b, h) do { _Pragma("unroll") for (int m = 0; m < 4; ++m) _Pragma("unroll") for (int k = 0; k < 2; ++k) dst[m][k] = *(const PG8_LAS bf16x8*)(lds + PG8_SA(b, h) + aoff + m * 2048 + k * 1024); } while (0)
#define PG8_LDB(dst, b, h) do { _Pragma("unroll") for (int n = 0; n < 2; ++n) _Pragma("unroll") for (int k = 0; k < 2; ++k) dst[n][k] = *(const PG8_LAS bf16x8*)(lds + PG8_SB(b, h) + boff + n * 2048 + k * 1024); } while (0)
#define PG8_MMA(ai, bj, At, Bt) do { __builtin_amdgcn_s_setprio(1); _Pragma("unroll") for (int m = 0; m < 4; ++m) _Pragma("unroll") for (int n = 0; n < 2; ++n) _Pragma("unroll") for (int k = 0; k < 2; ++k) \
        acc[ai][bj][m][n] = __builtin_amdgcn_mfma_f32_16x16x32_bf16(Bt[n][k], At[m][k], acc[ai][bj][m][n], 0, 0, 0); __builtin_amdgcn_s_setprio(0); } while (0)
#define PG8_WAIT_V(n) asm volatile("s_waitcnt vmcnt(" #n ")" ::: "memory")
#define PG8_WAIT_L(n) asm volatile("s_waitcnt lgkmcnt(" #n ")" ::: "memory")
#define PG8_BAR __builtin_amdgcn_s_barrier()
#define PG8_SCHED __builtin_amdgcn_sched_barrier(0)
    Unit cur, nxt; int ui = 0;
    if (!S.next(0, cur)) return;
    f32x4 acc[2][2][4][2];
#pragma unroll
    for (int a = 0; a < 2; ++a)
#pragma unroll
        for (int b = 0; b < 2; ++b)
#pragma unroll
            for (int m = 0; m < 4; ++m)
#pragma unroll
                for (int n = 0; n < 2; ++n) acc[a][b][m][n] = (f32x4){0.f, 0.f, 0.f, 0.f};
    bf16x8 At[4][2], B0[2][2], B1[2][2];
    const char* cA = (const char*)g.A + (size_t)cur.pm * tstep + (size_t)cur.k0 * kstep; const char* cB = (const char*)g.Bt + (size_t)cur.pn * tstep + (size_t)cur.k0 * kstep;
    S.a_ready(cur);
    if constexpr (SP2) {
        PG8_STAGE(PG8_SB(0, 0), cB, voffB); PG8_STAGE(PG8_SB(0, 1), cB + hstep, voffB); PG8_STAGE(PG8_SA(0, 0), cA, voffA); PG8_STAGE(PG8_SA(0, 1), cA + hstep, voffA);
        if (wr == 1) PG8_BAR;
        PG8_WAIT_V(2); PG8_BAR;
        PG8_STAGE(PG8_SB(1, 0), cB + kstep, voffB); PG8_STAGE(PG8_SA(1, 0), cA + kstep, voffA); PG8_STAGE(PG8_SB(1, 1), cB + hstep + kstep, voffB);
        PG8_WAIT_V(6); PG8_BAR;
    } else {
        PG8_STAGE(PG8_SB(0, 0), cB, voffB); PG8_STAGE(PG8_SA(0, 0), cA, voffA); PG8_STAGE(PG8_SB(0, 1), cB + hstep, voffB); PG8_STAGE(PG8_SA(0, 1), cA + hstep, voffA);
        if (wr == 1) PG8_BAR;
        PG8_WAIT_V(4); PG8_BAR;
        PG8_STAGE(PG8_SB(1, 0), cB + kstep, voffB); PG8_STAGE(PG8_SA(1, 0), cA + kstep, voffA); PG8_STAGE(PG8_SB(1, 1), cB + hstep + kstep, voffB);
        PG8_WAIT_V(6); PG8_BAR;
    }
    for (;;) {
        const bool has_next = S.next(ui + 1, nxt);
        const char* nA = has_next ? (const char*)g.A + (size_t)nxt.pm * tstep + (size_t)nxt.k0 * kstep : cA; const char* nB = has_next ? (const char*)g.Bt + (size_t)nxt.pn * tstep + (size_t)nxt.k0 * kstep : cB;
        const int nt = cur.nk;
        for (int t = 0; t < nt; t += 2) {
            const bool last = (t == nt - 2);
            const char* a1 = cA + (size_t)(t + 1) * kstep;
            const char* a2 = last ? nA : cA + (size_t)(t + 2) * kstep; const char* b2 = last ? nB : cB + (size_t)(t + 2) * kstep;
            const char* a3 = a2 + kstep; const char* b3 = b2 + kstep;
            if (last && has_next) S.a_ready(nxt);
            if constexpr (SP2) {
            PG8_LDB(B0, 0, 0); PG8_LDB(B1, 0, 1); PG8_SCHED; PG8_LDA(At, 0, 0); PG8_STAGE(PG8_SA(1, 1), a1 + hstep, voffA);
            PG8_WAIT_V(8); PG8_WAIT_L(0); PG8_BAR; PG8_MMA(0, 0, At, B0); PG8_MMA(0, 1, At, B1); PG8_BAR; PG8_SCHED;
            PG8_LDA(At, 0, 1); PG8_STAGE(PG8_SB(0, 0), b2, voffB); PG8_STAGE(PG8_SB(0, 1), b2 + hstep, voffB); PG8_STAGE(PG8_SA(0, 0), a2, voffA);
            PG8_WAIT_V(8); PG8_WAIT_L(0); PG8_BAR; PG8_MMA(1, 0, At, B0); PG8_MMA(1, 1, At, B1); PG8_BAR; PG8_SCHED;
            PG8_LDB(B0, 1, 0); PG8_LDB(B1, 1, 1); PG8_SCHED; PG8_LDA(At, 1, 0); PG8_STAGE(PG8_SA(0, 1), a2 + hstep, voffA);
            PG8_WAIT_V(8); PG8_WAIT_L(0); PG8_BAR; PG8_MMA(0, 0, At, B0); PG8_MMA(0, 1, At, B1); PG8_BAR; PG8_SCHED;
            PG8_LDA(At, 1, 1); PG8_STAGE(PG8_SB(1, 0), b3, voffB); PG8_STAGE(PG8_SB(1, 1), b3 + hstep, voffB); PG8_STAGE(PG8_SA(1, 0), a3, voffA);
            PG8_WAIT_V(8); PG8_WAIT_L(0); PG8_BAR; PG8_MMA(1, 0, At, B0); PG8_MMA(1, 1, At, B1); PG8_BAR; PG8_SCHED;
            } else {
            PG8_LDB(B0, 0, 0); PG8_SCHED; PG8_LDA(At, 0, 0); PG8_STAGE(PG8_SA(1, 1), a1 + hstep, voffA);
            PG8_WAIT_L(8); PG8_BAR; PG8_WAIT_L(0); PG8_MMA(0, 0, At, B0); PG8_BAR; PG8_SCHED;
            PG8_LDB(B1, 0, 1); PG8_STAGE(PG8_SB(0, 0), b2, voffB);
            PG8_BAR; PG8_WAIT_L(0); PG8_MMA(0, 1, At, B1); PG8_BAR;
            PG8_LDA(At, 0, 1); PG8_STAGE(PG8_SA(0, 0), a2, voffA);
            PG8_BAR; PG8_WAIT_L(0); PG8_MMA(1, 0, At, B0); PG8_BAR; PG8_SCHED;
            PG8_STAGE(PG8_SB(0, 1), b2 + hstep, voffB);
            PG8_WAIT_V(6); PG8_BAR; PG8_MMA(1, 1, At, B1); PG8_BAR;
            PG8_LDB(B0, 1, 0); PG8_SCHED; PG8_LDA(At, 1, 0); PG8_STAGE(PG8_SA(0, 1), a2 + hstep, voffA);
            PG8_WAIT_L(8); PG8_BAR; PG8_WAIT_L(0); PG8_MMA(0, 0, At, B0); PG8_BAR; PG8_SCHED;
            PG8_LDB(B1, 1, 1); PG8_STAGE(PG8_SB(1, 0), b3, voffB);
            PG8_BAR; PG8_WAIT_L(0); PG8_MMA(0, 1, At, B1); PG8_BAR;
            PG8_LDA(At, 1, 1); PG8_STAGE(PG8_SA(1, 0), a3, voffA);
            PG8_BAR; PG8_WAIT_L(0); PG8_MMA(1, 0, At, B0); PG8_BAR; PG8_SCHED;
            PG8_STAGE(PG8_SB(1, 1), b3 + hstep, voffB);
            PG8_WAIT_V(6); PG8_BAR; PG8_MMA(1, 1, At, B1); PG8_BAR;
            }
        }
        if constexpr (ALIGN_EPI) { if (wr == 0) PG8_BAR; }
        if constexpr (!Epi::AFTER_DRAIN) { E(acc, cur, wr, wc, fr, fq); S.done(cur); }
        if (!has_next) break;
#pragma unroll
        for (int a = 0; a < 2; ++a)
#pragma unroll
            for (int b = 0; b < 2; ++b)
#pragma unroll
                for (int m = 0; m < 4; ++m)
#pragma unroll
                    for (int n = 0; n < 2; ++n) acc[a][b][m][n] = (f32x4){0.f, 0.f, 0.f, 0.f};
        cur = nxt; cA = nA; cB = nB; ++ui;
        if constexpr (ALIGN_EPI) { if (wr == 1) PG8_BAR; }
    }
    PG8_WAIT_V(0);
    if constexpr (!ALIGN_EPI) { if (wr == 0) PG8_BAR; }
    PG8_BAR;
    if constexpr (Epi::AFTER_DRAIN) { E.fused(acc, cur, wr, wc, fr, fq, lds, wid, lane); S.done(cur); }
#undef PG8_SA
#undef PG8_SB
#undef PG8_STAGE
#undef PG8_LDA
#undef PG8_LDB
#undef PG8_MMA
#undef PG8_WAIT_V
#undef PG8_WAIT_L
#undef PG8_BAR
#undef PG8_SCHED
}
}

constexpr int NWAVES = 8;
constexpr int D = 1024, FF = 4096, NROW = 20480, NPR = 4096;
constexpr int NPAD = 3840;
constexpr int C_QA = 0, C_KA = 512, C_VA = 1024, C_GA = 1536, C_QB = 2048, C_KB = 2304, C_VB = 2560, C_GB = 3072, C_AL = 3584, C_BE = 3592;
constexpr int NMODV = 5, MODW = 6144;
constexpr float ALPHA_DN = 1.189207115002721f;
constexpr size_t MiB = 1u << 20;
constexpr size_t WS_CTL = 0, CTL_ZERO_BYTES = 1 * MiB;
constexpr size_t CTL_MOD_OFF = 262144;
constexpr int CW_BAR = 4096;
constexpr int CW_RBF = 16384;
constexpr int CW_QRC = 32768;
constexpr int LDS_BYTES = 147456;
constexpr int LDSCTL_OFF = 146432, MISC_OFF = LDSCTL_OFF + 320;
constexpr size_t WS_H = 1 * MiB;
constexpr size_t WS_MIX = WS_H;
constexpr size_t WS_P = 41 * MiB;
constexpr size_t WS_WIN = 191 * MiB;
constexpr size_t WS_RB = 214 * MiB;
constexpr size_t WS_WO = 234 * MiB, WS_W1 = 236 * MiB, WS_W2 = 244 * MiB;
constexpr size_t WS_Y = 41 * MiB, WS_YS0 = 73 * MiB, WS_YS1 = 89 * MiB;
constexpr size_t WS_F = 1 * MiB, WS_FS0 = 201 * MiB, WS_FS1 = 217 * MiB;
constexpr size_t WS_END = 252 * MiB;
constexpr size_t OUT_Y = (size_t)NROW * D, OUT_SD = OUT_Y, OUT_SR = OUT_SD + (size_t)16 * 2 * 4 * 128 * 128;

#define LAS __attribute__((address_space(3)))
typedef unsigned short bf16;
typedef unsigned v4u __attribute__((ext_vector_type(4)));
typedef unsigned v2u __attribute__((ext_vector_type(2)));
typedef float f32x4 __attribute__((ext_vector_type(4)));
#define LDS_WAIT() asm volatile("s_waitcnt lgkmcnt(0)" ::: "memory")
typedef __bf16 hwbf16x2 __attribute__((ext_vector_type(2)));
typedef float f32x2 __attribute__((ext_vector_type(2)));
__device__ __forceinline__ unsigned pk2(float lo, float hi) { const f32x2 f = {lo, hi}; return __builtin_bit_cast(unsigned, __builtin_convertvector(f, hwbf16x2)); }
__device__ __forceinline__ unsigned f2bf(float f) { return (unsigned)__builtin_bit_cast(unsigned short, (__bf16)f); }
__device__ __forceinline__ float bf2f(unsigned short h) { return __builtin_bit_cast(float, (unsigned)h << 16); }
__device__ __forceinline__ float bflo(unsigned w) { return __builtin_bit_cast(float, w << 16); }
__device__ __forceinline__ float bfhi(unsigned w) { return __builtin_bit_cast(float, w & 0xffff0000u); }
__device__ __forceinline__ float wave_sum(float v) {
#pragma unroll
    for (int o = 1; o < 64; o <<= 1) v += __shfl_xor(v, o);
    return v;
}
__device__ __forceinline__ float g16_sum(float v) {
#pragma unroll
    for (int o = 1; o < 16; o <<= 1) v += __shfl_xor(v, o);
    return v;
}
__device__ __forceinline__ float silu_f(float x) { return x / (1.f + __expf(-x)); }

struct Args {
    const float *x_prompt, *x_sample, *c, *state_delta, *state_ret, *c_ctx, *w_mod, *b_mod, *w_in, *conv_w, *a_log, *dt_bias, *norm_a_w, *gn_w, *gn_b, *w_o,
                *ln1_w, *ln1_b, *w_ff1, *b_ff1, *w_ff2, *b_ff2, *ln2_w, *ln2_b;
    float* out; unsigned char* ws; int ph_lo, ph_hi;
};
struct Frame { LAS unsigned char* lds; int tid, lane, wave, gw, NGW; };

__device__ __forceinline__ const float* xrow_ptr(const Args& a, int r) { return r < NPR ? a.x_prompt + (size_t)r * D : a.x_sample + (size_t)(r - NPR) * D; }
__device__ __forceinline__ int vrow_of(int r) { return r < NPR ? 0 : 1 + ((r - NPR) >> 12); }

__device__ __forceinline__ int map_in(int nd) { return nd < 2048 ? nd : (nd < 3584 ? nd + 16 : (nd < 3600 ? nd - 3584 + 2048 : -1)); }
template <bool MAP> __device__ __forceinline__ void transpose_item(const float* W, int K, int N, int nblk, bf16* WT, LAS float* scr, int item, int lane) {
    const int kb = item / nblk, nb = item % nblk, k0 = 64 * kb, n0 = 32 * nb;
    const int nd = n0 + (lane & 31), ns = MAP ? map_in(nd) : nd;
#pragma unroll 8
    for (int i = 0; i < 32; ++i) { const int kk = 2 * i + (lane >> 5); scr[kk * 33 + (lane & 31)] = ns >= 0 ? W[(size_t)(k0 + kk) * N + ns] : 0.f; }
    LDS_WAIT(); asm volatile("" ::: "memory");
    const int c = lane & 7;
#pragma unroll
    for (int j = 0; j < 4; ++j) { const int n = (lane >> 3) + 8 * j; const LAS float* s = scr + (8 * c) * 33 + n;
        v4u o; o.x = pk2(s[0 * 33], s[1 * 33]); o.y = pk2(s[2 * 33], s[3 * 33]); o.z = pk2(s[4 * 33], s[5 * 33]); o.w = pk2(s[6 * 33], s[7 * 33]);
        *(v4u*)(WT + (size_t)(n0 + n) * K + k0 + 8 * c) = o; }
    LDS_WAIT(); asm volatile("" ::: "memory");
}
__device__ __forceinline__ void p0_prologue(const Args& a, Frame& F) {
    LAS float* scr = (LAS float*)(F.lds + F.wave * 16384);
    bf16* Win_t = (bf16*)(a.ws + WS_WIN);
    constexpr int I_IN = (D / 64) * (NPAD / 32);
    constexpr int I_MOD = 24 * 32;
    constexpr int NITEMS = I_MOD + I_IN;
    float* mod = (float*)(a.ws + WS_CTL + CTL_MOD_OFF);
    for (int it = F.gw; it < NITEMS; it += F.NGW) {
        int r = it;
        if (r < I_MOD) {
            const int cg = r % 24, ks = r / 24, e = cg * 256 + F.lane, k0 = ks * 32;
            LDS_WAIT(); asm volatile("" ::: "memory");
            if (F.lane < 32) {
#pragma unroll
                for (int v = 0; v < NMODV; ++v) { const float cv = v == 0 ? a.c_ctx[k0 + F.lane] : a.c[(v - 1) * D + k0 + F.lane]; scr[v * 32 + F.lane] = silu_f(cv); } }
            LDS_WAIT(); asm volatile("" ::: "memory");
            float acc[NMODV][4];
#pragma unroll
            for (int v = 0; v < NMODV; ++v)
#pragma unroll
                for (int i = 0; i < 4; ++i) acc[v][i] = 0.f;
#pragma unroll 8
            for (int dd = 0; dd < 32; ++dd) { const float* wp = a.w_mod + (size_t)(k0 + dd) * MODW + e; const float w0 = wp[0], w1 = wp[64], w2 = wp[128], w3 = wp[192];
#pragma unroll
                for (int v = 0; v < NMODV; ++v) { const float sv = scr[v * 32 + dd]; acc[v][0] += w0 * sv; acc[v][1] += w1 * sv; acc[v][2] += w2 * sv; acc[v][3] += w3 * sv; } }
#pragma unroll
            for (int i = 0; i < 4; ++i) { const float bb = ks == 0 ? a.b_mod[e + 64 * i] : 0.f;
#pragma unroll
                for (int v = 0; v < NMODV; ++v) atomicAdd(mod + v * MODW + e + 64 * i, acc[v][i] + bb); }
            continue; }
        r -= I_MOD;
        transpose_item<true>(a.w_in, D, 3600, NPAD / 32, Win_t, scr, r, F.lane);
    }
}
__device__ __forceinline__ void late_weights(const Args& a, Frame& F) {
    LAS float* scr = (LAS float*)(F.lds + F.wave * 16384);
    bf16* Wo_t = (bf16*)(a.ws + WS_WO); bf16* W1_t = (bf16*)(a.ws + WS_W1); bf16* W2_t = (bf16*)(a.ws + WS_W2);
    constexpr int I_O = (D / 64) * (D / 32), I_1 = (D / 64) * (FF / 32), I_2 = (FF / 64) * (D / 32);
    if (blockIdx.x < 64) return;
    for (int it = F.gw - 64 * NWAVES; it < I_O + I_1 + I_2; it += F.NGW - 64 * NWAVES) {
        int r = it;
        if (r < I_O) { transpose_item<false>(a.w_o, D, D, D / 32, Wo_t, scr, r, F.lane); continue; } r -= I_O;
        if (r < I_1) { transpose_item<false>(a.w_ff1, D, FF, FF / 32, W1_t, scr, r, F.lane); continue; } r -= I_1;
        transpose_item<false>(a.w_ff2, FF, D, D / 32, W2_t, scr, r, F.lane);
    }
}

__device__ __forceinline__ void ln_stats(const f32x4 (&v)[4], float eps, float& mean, float& rstd) {
    float s = 0.f;
#pragma unroll
    for (int j = 0; j < 4; ++j) s += (v[j].x + v[j].y) + (v[j].z + v[j].w);
    mean = wave_sum(s) * (1.f / D); float s2 = 0.f;
#pragma unroll
    for (int j = 0; j < 4; ++j) { const f32x4 d = v[j] - mean; s2 += (d.x * d.x + d.y * d.y) + (d.z * d.z + d.w * d.w); }
    rstd = 1.f / sqrtf(wave_sum(s2) * (1.f / D) + eps);
}
__device__ __forceinline__ void p1_h(const Args& a, Frame& F) {
    const float* mod = (const float*)(a.ws + WS_CTL + CTL_MOD_OFF); bf16* H = (bf16*)(a.ws + WS_H);
    f32x4 nx[4];
    if (F.gw < NROW) { const f32x4* xr = (const f32x4*)xrow_ptr(a, F.gw) + F.lane;
#pragma unroll
        for (int j = 0; j < 4; ++j) nx[j] = xr[64 * j]; }
    for (int r = F.gw; r < NROW; r += F.NGW) {
        const float* mv = mod + (size_t)vrow_of(r) * MODW;
        f32x4 v[4];
#pragma unroll
        for (int j = 0; j < 4; ++j) v[j] = nx[j];
        if (r + F.NGW < NROW) { const f32x4* xr = (const f32x4*)xrow_ptr(a, r + F.NGW) + F.lane;
#pragma unroll
            for (int j = 0; j < 4; ++j) nx[j] = xr[64 * j]; }
        float mean, rstd; ln_stats(v, 1e-6f, mean, rstd);
        unsigned long long* o8 = (unsigned long long*)(H + (size_t)r * D) + F.lane;
#pragma unroll
        for (int j = 0; j < 4; ++j) { const f32x4 sh = *((const f32x4*)mv + F.lane + 64 * j), sc = *((const f32x4*)(mv + 1024) + F.lane + 64 * j);
            const f32x4 h = (v[j] - mean) * rstd * (sc + 1.f) + sh;
            o8[64 * j] = (unsigned long long)pk2(h.x, h.y) | ((unsigned long long)pk2(h.z, h.w) << 32); }
    }
}
#define XB_TMO      128
#define XB_XCNT(j)  (256  + 64 * (j))
#define XB_XSUB(j)  (1280 + 64 * (j))
#define XB_XGEN(j)  (2304 + 64 * (j))
#define XB_TOP      3328
#define XB_TOPGEN   3392
#define XCD_BAR_WORDS 3456
#define XB_SPIN_CAP (1u << 22)

__device__ __forceinline__ unsigned xb_ld(unsigned* p)              { return __hip_atomic_load(p, __ATOMIC_RELAXED, __HIP_MEMORY_SCOPE_AGENT); }
__device__ __forceinline__ unsigned xb_add(unsigned* p, unsigned v) { return __hip_atomic_fetch_add(p, v, __ATOMIC_RELAXED, __HIP_MEMORY_SCOPE_AGENT); }
__device__ __forceinline__ unsigned xb_xcc_id() { return (unsigned)__builtin_amdgcn_s_getreg((3 << 11) | 20) & 0xFu; }
#define XB_SPIN(cond, bar) do { unsigned _sp = 0; while (cond) { __builtin_amdgcn_s_sleep(1); \
    if ((++_sp & 255u) == 0u) { if (xb_ld(&(bar)[XB_TMO])) break; if (_sp > XB_SPIN_CAP) { atomicAdd(&(bar)[XB_TMO], 1u); break; } } } } while (0)

struct XcdBarrier {
    unsigned* bar; unsigned x;
    volatile LAS unsigned* st;
};

__device__ __forceinline__ XcdBarrier xcd_barrier_post(unsigned* bar, volatile LAS unsigned* st) {
    XcdBarrier b; b.bar = bar; b.x = xb_xcc_id(); b.st = st;
    if (threadIdx.x == 0) (void)xb_add(&bar[XB_XCNT(b.x)], 1u);
    return b;
}
__device__ __forceinline__ void xcd_barrier_complete(unsigned* bar, unsigned x, unsigned& nloc, unsigned& nx) {
    const unsigned G = gridDim.x * gridDim.y * gridDim.z;
    unsigned sum, cnt, mine, sp = 0u;
    for (;;) {
        sum = 0u; cnt = 0u; mine = 0u;
#pragma unroll
        for (unsigned j = 0; j < 16; ++j) { const unsigned c = xb_ld(&bar[XB_XCNT(j)]); sum += c; cnt += (c > 0u) ? 1u : 0u; mine = (j == x) ? c : mine; }
        if (sum == G) break;
        __builtin_amdgcn_s_sleep(1);
        if ((++sp & 255u) == 0u) { if (xb_ld(&bar[XB_TMO])) break; if (sp > XB_SPIN_CAP) { atomicAdd(&bar[XB_TMO], 1u); break; } }
    }
    nloc = mine > 0u ? mine : 1u; nx = cnt > 0u ? cnt : 1u;
}

__device__ __forceinline__ void xcd_barrier(const XcdBarrier& b) {
    asm volatile("s_waitcnt vmcnt(0)" ::: "memory");
    __syncthreads();
    if (threadIdx.x == 0) {
        unsigned* bar = b.bar;
        __builtin_amdgcn_s_waitcnt(0);
        unsigned nloc = b.st[0], nx = b.st[1];
        if (nloc == 0u) { xcd_barrier_complete(bar, b.x, nloc, nx); b.st[0] = nloc; b.st[1] = nx; }
        const unsigned old = xb_add(&bar[XB_XSUB(b.x)], 1u);
        const unsigned gen = old / nloc;
        if (old + 1u == (gen + 1u) * nloc) {
            __builtin_amdgcn_fence(__ATOMIC_RELEASE, "agent");
            asm volatile("s_waitcnt vmcnt(0)" ::: "memory");
            const unsigned og = xb_add(&bar[XB_TOP], 1u);
            const unsigned tg = og / nx;
            if (og + 1u == (tg + 1u) * nx) xb_add(&bar[XB_TOPGEN], 1u);
            else XB_SPIN(xb_ld(&bar[XB_TOPGEN]) == tg, bar);
            __builtin_amdgcn_fence(__ATOMIC_ACQUIRE, "agent");
            xb_add(&bar[XB_XGEN(b.x)], 1u);
            asm volatile("s_waitcnt vmcnt(0)" ::: "memory");
        } else {
            XB_SPIN(xb_ld(&bar[XB_XGEN(b.x)]) == gen, bar);
            __builtin_amdgcn_fence(__ATOMIC_ACQUIRE, "agent");
            asm volatile("s_waitcnt vmcnt(0)" ::: "memory");
        }
    }
    __syncthreads();
}
__device__ __forceinline__ void seq_of_row(int r, int& base, int& T, int& t) { if (r < NPR) { base = r & ~255; T = 256; t = r & 255; } else { const int q = r - NPR; base = NPR + (q & ~4095); T = 4096; t = q & 4095; } }
__device__ __forceinline__ void unpack8(const v4u w, float (&f)[8]) { f[0] = bflo(w.x); f[1] = bfhi(w.x); f[2] = bflo(w.y); f[3] = bfhi(w.y); f[4] = bflo(w.z); f[5] = bfhi(w.z); f[6] = bflo(w.w); f[7] = bfhi(w.w); }
__device__ __forceinline__ v4u pack8(const float (&f)[8]) { v4u w; w.x = pk2(f[0], f[1]); w.y = pk2(f[2], f[3]); w.z = pk2(f[4], f[5]); w.w = pk2(f[6], f[7]); return w; }

__device__ __forceinline__ void p5_combine(const Args& a, Frame& F) {
    const bf16* P = (const bf16*)(a.ws + WS_P);
    bf16* MIX = (bf16*)(a.ws + WS_MIX); const int l = F.lane;
    for (int r = F.gw; r < NROW; r += F.NGW) {
        const bf16* rp = P + (size_t)r * NPAD;
        float x0[8], x1[8], gt[8], o[8];
        unpack8(*(const v4u*)(rp + 8 * l), x0); unpack8(*(const v4u*)(rp + 512 + 8 * l), x1); unpack8(*(const v4u*)(rp + C_GA + 8 * l), gt);
        float ss = 0.f;
#pragma unroll
        for (int i = 0; i < 8; ++i) { x0[i] += x1[i]; ss += x0[i] * x0[i]; }
        ss = g16_sum(ss); const float rs = 1.f / sqrtf(ss * (1.f / 128.f) + 1e-6f);
#pragma unroll
        for (int i = 0; i < 8; ++i) o[i] = x0[i] * rs * a.norm_a_w[(8 * l + i) & 127] * silu_f(gt[i]);
        *(v4u*)(MIX + (size_t)r * D + 8 * l) = pack8(o);
        *(v4u*)(MIX + (size_t)r * D + 512 + 8 * l) = *(const v4u*)(rp + 1024 + 8 * l);
    }
}

struct RowY { v2u w[4][4]; };
__device__ __forceinline__ void rowy_load(RowY& y, const bf16* Y, const bf16* S0, const bf16* S1, int r, int lane) {
    if (r < 16384) {
#pragma unroll
        for (int j = 0; j < 4; ++j) { y.w[0][j] = *(const v2u*)(Y + (size_t)r * D + 4 * lane + 256 * j); y.w[1][j] = (v2u){0u, 0u}; y.w[2][j] = (v2u){0u, 0u}; y.w[3][j] = (v2u){0u, 0u}; } }
    else { const size_t o = (size_t)(r - 16384) * D + 4 * lane; const size_t sp = (size_t)4096 * D;
#pragma unroll
        for (int j = 0; j < 4; ++j) { y.w[0][j] = *(const v2u*)(S0 + o + 256 * j); y.w[1][j] = *(const v2u*)(S0 + sp + o + 256 * j); y.w[2][j] = *(const v2u*)(S1 + o + 256 * j); y.w[3][j] = *(const v2u*)(S1 + sp + o + 256 * j); } }
}
__device__ __forceinline__ f32x4 rowy_get(const RowY& y, int j) {
    const v2u a = y.w[0][j], b = y.w[1][j], c = y.w[2][j], d = y.w[3][j];
    return (f32x4){(bflo(a.x) + bflo(b.x)) + (bflo(c.x) + bflo(d.x)), (bfhi(a.x) + bfhi(b.x)) + (bfhi(c.x) + bfhi(d.x)), (bflo(a.y) + bflo(b.y)) + (bflo(c.y) + bflo(d.y)), (bfhi(a.y) + bfhi(b.y)) + (bfhi(c.y) + bfhi(d.y))};
}
__device__ __forceinline__ void p6b_ln1(const Args& a, Frame& F) {
    const float* mod = (const float*)(a.ws + WS_CTL + CTL_MOD_OFF); bf16* H2 = (bf16*)(a.ws + WS_H);
    const bf16* Y = (const bf16*)(a.ws + WS_Y); const bf16* S0 = (const bf16*)(a.ws + WS_YS0); const bf16* S1 = (const bf16*)(a.ws + WS_YS1);
    f32x4 nx[4]; RowY ny;
    if (F.gw < NROW) { const f32x4* xr = (const f32x4*)xrow_ptr(a, F.gw) + F.lane;
#pragma unroll
        for (int j = 0; j < 4; ++j) nx[j] = xr[64 * j];
        rowy_load(ny, Y, S0, S1, F.gw, F.lane); }
    for (int r = F.gw; r < NROW; r += F.NGW) {
        f32x4 v[4]; RowY cy = ny;
#pragma unroll
        for (int j = 0; j < 4; ++j) v[j] = nx[j];
        if (r + F.NGW < NROW) { const f32x4* xr = (const f32x4*)xrow_ptr(a, r + F.NGW) + F.lane;
#pragma unroll
            for (int j = 0; j < 4; ++j) nx[j] = xr[64 * j];
            rowy_load(ny, Y, S0, S1, r + F.NGW, F.lane); }
        f32x4* zr = (f32x4*)(a.out + (size_t)r * D) + F.lane; const float* mv = mod + (size_t)vrow_of(r) * MODW;
#pragma unroll
        for (int j = 0; j < 4; ++j) { const f32x4 g1 = *((const f32x4*)(mv + 2048) + F.lane + 64 * j); v[j] = v[j] * ALPHA_DN + g1 * rowy_get(cy, j); }
        float mean, rstd; ln_stats(v, 1e-6f, mean, rstd);
#pragma unroll
        for (int j = 0; j < 4; ++j) { const f32x4 w = *((const f32x4*)a.ln1_w + F.lane + 64 * j), b = *((const f32x4*)a.ln1_b + F.lane + 64 * j);
            v[j] = (v[j] - mean) * rstd * w + b; zr[64 * j] = v[j]; }
        ln_stats(v, 1e-6f, mean, rstd);
        unsigned long long* o8 = (unsigned long long*)(H2 + (size_t)r * D) + F.lane;
#pragma unroll
        for (int j = 0; j < 4; ++j) { const f32x4 sh = *((const f32x4*)(mv + 3072) + F.lane + 64 * j), sc = *((const f32x4*)(mv + 4096) + F.lane + 64 * j);
            const f32x4 h = (v[j] - mean) * rstd * (sc + 1.f) + sh;
            o8[64 * j] = (unsigned long long)pk2(h.x, h.y) | ((unsigned long long)pk2(h.z, h.w) << 32); }
    }
}
__device__ __forceinline__ void p8b_ln2(const Args& a, Frame& F) {
    const float* mod = (const float*)(a.ws + WS_CTL + CTL_MOD_OFF);
    const bf16* Y = (const bf16*)(a.ws + WS_F); const bf16* S0 = (const bf16*)(a.ws + WS_FS0); const bf16* S1 = (const bf16*)(a.ws + WS_FS1);
    f32x4 nx[4]; RowY ny;
    if (F.gw < NROW) { const f32x4* xr = (const f32x4*)(a.out + (size_t)F.gw * D) + F.lane;
#pragma unroll
        for (int j = 0; j < 4; ++j) nx[j] = xr[64 * j];
        rowy_load(ny, Y, S0, S1, F.gw, F.lane); }
    for (int r = F.gw; r < NROW; r += F.NGW) {
        f32x4 v[4]; RowY cy = ny;
#pragma unroll
        for (int j = 0; j < 4; ++j) v[j] = nx[j];
        if (r + F.NGW < NROW) { const f32x4* xr = (const f32x4*)(a.out + (size_t)(r + F.NGW) * D) + F.lane;
#pragma unroll
            for (int j = 0; j < 4; ++j) nx[j] = xr[64 * j];
            rowy_load(ny, Y, S0, S1, r + F.NGW, F.lane); }
        f32x4* zr = (f32x4*)(a.out + (size_t)r * D) + F.lane; const float* mv = mod + (size_t)vrow_of(r) * MODW;
#pragma unroll
        for (int j = 0; j < 4; ++j) { const f32x4 g2 = *((const f32x4*)(mv + 5120) + F.lane + 64 * j), bb = *((const f32x4*)a.b_ff2 + F.lane + 64 * j);
            v[j] = v[j] * ALPHA_DN + g2 * (rowy_get(cy, j) + bb); }
        float mean, rstd; ln_stats(v, 1e-6f, mean, rstd);
#pragma unroll
        for (int j = 0; j < 4; ++j) { const f32x4 w = *((const f32x4*)a.ln2_w + F.lane + 64 * j), b = *((const f32x4*)a.ln2_b + F.lane + 64 * j);
            zr[64 * j] = (v[j] - mean) * rstd * w + b; }
    }
}
constexpr int RL_Q = 0, RL_K = 18432, RL_VT = 36864, RL_KTF = 71680, RL_KTB = 89088;
constexpr int RQP = 72, RVP = 136;
typedef short bf16x8 __attribute__((ext_vector_type(8)));
typedef short s16x4 __attribute__((ext_vector_type(4)));
#define MFMA16(a, b, c) __builtin_amdgcn_mfma_f32_16x16x32_bf16((a), (b), (c), 0, 0, 0)
constexpr size_t WS_SP = WS_RB;

__device__ __forceinline__ void ret_item(int it, int& base, int& n, int& h, bool& smp) {
    if (it < 512) { smp = true; h = it & 3; n = (it >> 2) & 31; base = NPR + (it >> 7) * 4096; }
    else { const int q = it - 512; smp = false; h = q & 3; n = (q >> 2) & 1; base = (q >> 3) * 256; }
}
__device__ __forceinline__ float lg2gamma(int hg) { return log2f(1.f - exp2f(-5.f - (float)hg)); }

template <bool NEED_QK, bool NEED_KT>
__device__ __forceinline__ void ret_stage(const Args& a, Frame& F, int base, int n, int h, bool smp) {
    const bf16* P = (const bf16*)(a.ws + WS_P);
    LAS bf16* Lq = (LAS bf16*)(F.lds + RL_Q); LAS bf16* Lk = (LAS bf16*)(F.lds + RL_K); LAS bf16* Lvt = (LAS bf16*)(F.lds + RL_VT);
    LAS bf16* Lkf = (LAS bf16*)(F.lds + RL_KTF); LAS bf16* Lkb = (LAS bf16*)(F.lds + RL_KTB);
    const int t = F.tid, row = t >> 2, pc = t & 3, tpos = 128 * n + row;
    const bf16* rp = P + (size_t)(base + tpos) * NPAD;
    { const int j0 = pc * 8;
      float q1[8], q2[8], k1[8], k2[8];
      if (NEED_QK) { unpack8(*(const v4u*)(rp + C_QB + 64 * h + j0), q1); unpack8(*(const v4u*)(rp + C_QB + 64 * h + 32 + j0), q2); }
      unpack8(*(const v4u*)(rp + C_KB + 64 * h + j0), k1); unpack8(*(const v4u*)(rp + C_KB + 64 * h + 32 + j0), k2);
      if (smp) { const float pos = (pc < 2) ? (float)(tpos >> 6) : (float)(tpos & 63);
#pragma unroll
          for (int i = 0; i < 8; ++i) { const int f = (j0 + i) & 15; const float ang = pos * exp2f(-(float)f * 0.83048202372184059f); float sn, cs; __sincosf(ang, &sn, &cs);
              if (NEED_QK) { const float x1 = q1[i], x2 = q2[i]; q1[i] = x1 * cs - x2 * sn; q2[i] = x1 * sn + x2 * cs; }
              const float y1 = k1[i], y2 = k2[i]; k1[i] = y1 * cs - y2 * sn; k2[i] = y1 * sn + y2 * cs; } }
      if (NEED_QK) {
#pragma unroll
          for (int i = 0; i < 8; ++i) { q1[i] *= 0.125f; q2[i] *= 0.125f; }
          *(LAS v4u*)(Lq + row * RQP + j0) = pack8(q1); *(LAS v4u*)(Lq + row * RQP + 32 + j0) = pack8(q2);
          *(LAS v4u*)(Lk + row * RQP + j0) = pack8(k1); *(LAS v4u*)(Lk + row * RQP + 32 + j0) = pack8(k2); }
      if (NEED_KT) { const float zf = exp2f((float)(127 - row) * lg2gamma(h)), zb = exp2f((float)row * lg2gamma(3 - h));
#pragma unroll
          for (int i = 0; i < 8; ++i) { Lkf[(j0 + i) * RVP + row] = (bf16)f2bf(k1[i] * zf); Lkf[(32 + j0 + i) * RVP + row] = (bf16)f2bf(k2[i] * zf);
              Lkb[(j0 + i) * RVP + row] = (bf16)f2bf(k1[i] * zb); Lkb[(32 + j0 + i) * RVP + row] = (bf16)f2bf(k2[i] * zb); } } }
    { const int e0 = pc * 32;
#pragma unroll
      for (int q4 = 0; q4 < 4; ++q4) { const v4u w = *(const v4u*)(rp + C_VB + 128 * h + e0 + 8 * q4); const unsigned ww[4] = {w.x, w.y, w.z, w.w};
#pragma unroll
          for (int i = 0; i < 4; ++i) { Lvt[(e0 + 8 * q4 + 2 * i) * RVP + row] = (bf16)(ww[i] & 0xffffu); Lvt[(e0 + 8 * q4 + 2 * i + 1) * RVP + row] = (bf16)(ww[i] >> 16); } } }
}

__device__ __forceinline__ void ret_ra(const Args& a, Frame& F) {
    bf16* DS = (bf16*)(a.ws + WS_SP);
    const int l = F.lane, g = l >> 4, c = l & 15, w = F.wave;
    for (int it = blockIdx.x; it < 640; it += gridDim.x) {
        int base, n, h; bool smp; ret_item(it, base, n, h, smp);
        __syncthreads();
        ret_stage<false, true>(a, F, base, n, h, smp);
        __syncthreads();
        const LAS bf16* Lvt = (const LAS bf16*)(F.lds + RL_VT); const LAS bf16* Lkf = (const LAS bf16*)(F.lds + RL_KTF); const LAS bf16* Lkb = (const LAS bf16*)(F.lds + RL_KTB);
        f32x4 acc[2][4];
#pragma unroll
        for (int d = 0; d < 2; ++d)
#pragma unroll
            for (int nd = 0; nd < 4; ++nd) acc[d][nd] = (f32x4){0.f, 0.f, 0.f, 0.f};
#pragma unroll
        for (int s = 0; s < 4; ++s) { const bf16x8 av = *(const LAS bf16x8*)(Lvt + (16 * w + c) * RVP + 32 * s + 8 * g);
#pragma unroll
            for (int nd = 0; nd < 4; ++nd) { const bf16x8 bf_ = *(const LAS bf16x8*)(Lkf + (16 * nd + c) * RVP + 32 * s + 8 * g), bb_ = *(const LAS bf16x8*)(Lkb + (16 * nd + c) * RVP + 32 * s + 8 * g);
                acc[0][nd] = MFMA16(av, bf_, acc[0][nd]); acc[1][nd] = MFMA16(av, bb_, acc[1][nd]); } }
#pragma unroll
        for (int d = 0; d < 2; ++d) { bf16* o = DS + ((size_t)it * 2 + d) * 8192;
#pragma unroll
            for (int nd = 0; nd < 4; ++nd)
#pragma unroll
                for (int r = 0; r < 4; ++r) o[(16 * w + 4 * g + r) * 64 + 16 * nd + c] = (bf16)f2bf(acc[d][nd][r]); }
    }
}

__device__ __forceinline__ void ret_rb(const Args& a, Frame& F) {
    bf16* SP = (bf16*)(a.ws + WS_SP); unsigned* ctl = (unsigned*)(a.ws + WS_CTL);
    for (int cid = (int)gridDim.x - 1 - (int)blockIdx.x; cid < 160; cid += gridDim.x) {
        const bool smp = cid < 32; const int q = smp ? cid : cid - 32;
        const int dir = q & 1, h = (q >> 1) & 3, sq = q >> 3, N = smp ? 32 : 2;
        const float gch = exp2f(128.f * lg2gamma(dir ? 3 - h : h));
        const int idx = F.tid * 16, e = idx >> 6, d0 = idx & 63;
        float S[16];
        if (smp) { const float* S0 = a.state_ret + ((size_t)(sq * 2 + dir) * 4 + h) * 8192;
#pragma unroll
            for (int i = 0; i < 16; ++i) S[i] = S0[(size_t)(d0 + i) * 128 + e]; }
        else {
#pragma unroll
            for (int i = 0; i < 16; ++i) S[i] = 0.f; }
        for (int s0 = 0; s0 < N; s0 += 8) {
            v4u dv[8][2];
#pragma unroll
            for (int i = 0; i < 8; ++i) if (s0 + i < N) { const int n = dir ? N - 1 - (s0 + i) : s0 + i; const int it = smp ? (sq * 32 + n) * 4 + h : 512 + (sq * 2 + n) * 4 + h;
                const bf16* sp = SP + ((size_t)it * 2 + dir) * 8192 + idx; dv[i][0] = *(const v4u*)sp; dv[i][1] = *(const v4u*)(sp + 8); }
#pragma unroll
            for (int i = 0; i < 8; ++i) if (s0 + i < N) { const int n = dir ? N - 1 - (s0 + i) : s0 + i; const int it = smp ? (sq * 32 + n) * 4 + h : 512 + (sq * 2 + n) * 4 + h;
                bf16* sp = SP + ((size_t)it * 2 + dir) * 8192 + idx;
                v4u o0, o1; o0.x = pk2(S[0], S[1]); o0.y = pk2(S[2], S[3]); o0.z = pk2(S[4], S[5]); o0.w = pk2(S[6], S[7]);
                o1.x = pk2(S[8], S[9]); o1.y = pk2(S[10], S[11]); o1.z = pk2(S[12], S[13]); o1.w = pk2(S[14], S[15]);
                *(v4u*)sp = o0; *(v4u*)(sp + 8) = o1;
                float t8[8]; unpack8(dv[i][0], t8);
#pragma unroll
                for (int k = 0; k < 8; ++k) S[k] = gch * S[k] + t8[k];
                unpack8(dv[i][1], t8);
#pragma unroll
                for (int k = 0; k < 8; ++k) S[8 + k] = gch * S[8 + k] + t8[k]; } }
        if (!smp) { float* So = a.out + OUT_SR + ((size_t)(sq * 2 + dir) * 4 + h) * 8192;
#pragma unroll
            for (int i = 0; i < 16; ++i) So[(size_t)(d0 + i) * 128 + e] = S[i]; }
        asm volatile("s_waitcnt vmcnt(0)" ::: "memory");
        __syncthreads();
        if (F.tid == 0) { __builtin_amdgcn_fence(__ATOMIC_RELEASE, "agent"); asm volatile("s_waitcnt vmcnt(0)" ::: "memory");
            __hip_atomic_store(ctl + CW_RBF + 64 * cid, 1u, __ATOMIC_RELAXED, __HIP_MEMORY_SCOPE_AGENT); }
    }
}

__device__ __forceinline__ void ret_rc(const Args& a, Frame& F) {
    bf16* P = (bf16*)(a.ws + WS_P); const bf16* SP = (const bf16*)(a.ws + WS_SP); unsigned* ctl = (unsigned*)(a.ws + WS_CTL);
    volatile LAS unsigned* MISC = (volatile LAS unsigned*)(F.lds + MISC_OFF);
    const int l = F.lane, g = l >> 4, c = l & 15, w = F.wave;
    for (;;) {
        __syncthreads();
        if (F.tid == 0) MISC[16] = __hip_atomic_fetch_add(ctl + CW_QRC, 1u, __ATOMIC_RELAXED, __HIP_MEMORY_SCOPE_AGENT);
        __syncthreads();
        const int qi = (int)MISC[16]; if (qi >= 640) break;
        const int it = qi < 128 ? 512 + qi : qi - 128;
        int base, n, h; bool smp; ret_item(it, base, n, h, smp);
        if (F.tid == 0) { const int sqx = smp ? (it >> 7) : ((it - 512) >> 3); const int c0 = (smp ? 0 : 32) + (sqx * 4 + h) * 2;
            unsigned sp_ = 0;
            while (__hip_atomic_load(ctl + CW_RBF + 64 * c0, __ATOMIC_RELAXED, __HIP_MEMORY_SCOPE_AGENT) == 0u || __hip_atomic_load(ctl + CW_RBF + 64 * (c0 + 1), __ATOMIC_RELAXED, __HIP_MEMORY_SCOPE_AGENT) == 0u) {
                __builtin_amdgcn_s_sleep(4); if (++sp_ > (1u << 22)) break; }
            __builtin_amdgcn_fence(__ATOMIC_ACQUIRE, "agent"); asm volatile("s_waitcnt vmcnt(0)" ::: "memory"); }
        __syncthreads();
        ret_stage<true, false>(a, F, base, n, h, smp);
        __syncthreads();
        const LAS bf16* Lq = (const LAS bf16*)(F.lds + RL_Q); const LAS bf16* Lk = (const LAS bf16*)(F.lds + RL_K); const LAS bf16* Lvt = (const LAS bf16*)(F.lds + RL_VT);
        const float lgf = lg2gamma(h), lgb = lg2gamma(3 - h);
        const int il = 16 * w + c;
        bf16x8 bq[2];
#pragma unroll
        for (int s = 0; s < 2; ++s) bq[s] = *(const LAS bf16x8*)(Lq + il * RQP + 32 * s + 8 * g);
        bf16x8 pb[4];
#pragma unroll
        for (int s = 0; s < 4; ++s) { f32x4 st2[2];
#pragma unroll
            for (int hh = 0; hh < 2; ++hh) { const int mt = 2 * s + hh; f32x4 acc = (f32x4){0.f, 0.f, 0.f, 0.f};
#pragma unroll
                for (int s2 = 0; s2 < 2; ++s2) { const bf16x8 ak = *(const LAS bf16x8*)(Lk + (16 * mt + c) * RQP + 32 * s2 + 8 * g); acc = MFMA16(ak, bq[s2], acc); }
#pragma unroll
                for (int r = 0; r < 4; ++r) { const int j = 16 * mt + 4 * g + r; const float dm = j < il ? exp2f((float)(il - j) * lgf) : (j > il ? exp2f((float)(j - il) * lgb) : 2.f); acc[r] *= dm; }
                st2[hh] = acc; }
            v4u pw; pw.x = pk2(st2[0][0], st2[0][1]); pw.y = pk2(st2[0][2], st2[0][3]); pw.z = pk2(st2[1][0], st2[1][1]); pw.w = pk2(st2[1][2], st2[1][3]);
            pb[s] = __builtin_bit_cast(bf16x8, pw); }
        const bf16* spf = SP + ((size_t)it * 2 + 0) * 8192; const bf16* spb = SP + ((size_t)it * 2 + 1) * 8192;
        const float xf = exp2f((float)(il + 1) * lgf), xb = exp2f((float)(128 - il) * lgb);
        f32x4 O[8]; float sm = 0.f;
#pragma unroll
        for (int me = 0; me < 8; ++me) { f32x4 cf = (f32x4){0.f, 0.f, 0.f, 0.f}, cb = cf;
#pragma unroll
            for (int s2 = 0; s2 < 2; ++s2) { const bf16x8 af = *(const bf16x8*)(spf + (16 * me + c) * 64 + 32 * s2 + 8 * g), ab = *(const bf16x8*)(spb + (16 * me + c) * 64 + 32 * s2 + 8 * g);
                cf = MFMA16(af, bq[s2], cf); cb = MFMA16(ab, bq[s2], cb); }
            f32x4 acc = cf * xf + cb * xb;
#pragma unroll
            for (int s = 0; s < 4; ++s) { const s16x4 lo = *(const LAS s16x4*)(Lvt + (16 * me + c) * RVP + 32 * s + 4 * g), hi = *(const LAS s16x4*)(Lvt + (16 * me + c) * RVP + 32 * s + 16 + 4 * g);
                const bf16x8 av = __builtin_shufflevector(lo, hi, 0, 1, 2, 3, 4, 5, 6, 7); acc = MFMA16(av, pb[s], acc); }
            O[me] = acc; sm += (acc[0] + acc[1]) + (acc[2] + acc[3]); }
        sm += __shfl_xor(sm, 16); sm += __shfl_xor(sm, 32);
        const float mean = sm * (1.f / 128.f); float sv = 0.f;
#pragma unroll
        for (int me = 0; me < 8; ++me) { O[me] = O[me] - mean; sv += (O[me][0] * O[me][0] + O[me][1] * O[me][1]) + (O[me][2] * O[me][2] + O[me][3] * O[me][3]); }
        sv += __shfl_xor(sv, 16); sv += __shfl_xor(sv, 32);
        const float rstd = 1.f / sqrtf(sv * (1.f / 128.f) + 1e-5f);
        const size_t grow = (size_t)(base + 128 * n + il);
#pragma unroll
        for (int me = 0; me < 8; ++me) { const int e = 16 * me + 4 * g;
            const v2u gw2 = *(const v2u*)(P + grow * NPAD + C_GB + 128 * h + e); const float gt[4] = {bflo(gw2.x), bfhi(gw2.x), bflo(gw2.y), bfhi(gw2.y)};
            const f32x4 wv = *(const f32x4*)(a.gn_w + 128 * h + e), bv = *(const f32x4*)(a.gn_b + 128 * h + e);
            float y[4];
#pragma unroll
            for (int r = 0; r < 4; ++r) y[r] = (O[me][r] * rstd * wv[r] + bv[r]) * silu_f(gt[r]);
            v2u ow; ow.x = pk2(y[0], y[1]); ow.y = pk2(y[2], y[3]); *(v2u*)(P + grow * NPAD + 1024 + 128 * h + e) = ow; }
    }
}
constexpr size_t WS_QK = WS_H;
constexpr size_t OUT_WF = 0, OUT_UF = 40 * MiB;
constexpr size_t WS_QKF = 191 * MiB;
constexpr size_t WS_SM = 211 * MiB;
constexpr int DL_Q = 0, DL_K = 17408, DL_KT = 34816, DL_VT = 53248, DL_M0 = 71680, DL_M1 = 90112, DL_SM = 108544;
constexpr int DQP = 136, DTP = 72, DMP = 72;

__device__ __forceinline__ void delta_item(int ci, int& base, int& T, int& n, int& h) {
    if (ci < 1024) { h = ci & 3; n = (ci >> 2) & 63; base = NPR + (ci >> 8) * 4096; T = 4096; }
    else { const int q = ci - 1024; h = q & 3; n = (q >> 2) & 3; base = (q >> 4) * 256; T = 256; }
}
__device__ __forceinline__ bf16x8 pack_tiles(const f32x4& t0, const f32x4& t1) {
    v4u pw; pw.x = pk2(t0[0], t0[1]); pw.y = pk2(t0[2], t0[3]); pw.z = pk2(t1[0], t1[1]); pw.w = pk2(t1[2], t1[3]); return __builtin_bit_cast(bf16x8, pw);
}
constexpr int TLP = 68;
template <bool FLIP> __device__ __forceinline__ f32x4 ld_m4(const LAS float* M, int i, int j0) {
    if (!FLIP) return *(const LAS f32x4*)(M + i * DMP + j0);
    const f32x4 t = *(const LAS f32x4*)(M + (63 - i) * DMP + 60 - j0); return (f32x4){t.w, t.z, t.y, t.x};
}
template <bool FLIP>
__device__ __forceinline__ void tri_inv(LAS float* M, LAS float* Tl, float sw, float su, int lane) {
    const int g = lane >> 4, c = lane & 15;
#pragma unroll 8
    for (int i = 0; i < 64; ++i) Tl[i * TLP + lane] = 0.f;
    { float Dr[16];
#pragma unroll
      for (int i = 0; i < 16; ++i) { float a0 = (c == i) ? 1.f : 0.f, a1 = 0.f;
#pragma unroll
          for (int x = 0; x < 4; ++x) if (4 * x < i) { const f32x4 m4 = ld_m4<FLIP>(M, 16 * g + i, 16 * g + 4 * x);
              a0 -= m4.x * Dr[4 * x]; if (4 * x + 1 < i) a1 -= m4.y * Dr[4 * x + 1]; if (4 * x + 2 < i) a0 -= m4.z * Dr[4 * x + 2]; if (4 * x + 3 < i) a1 -= m4.w * Dr[4 * x + 3]; }
          Dr[i] = a0 + a1; }
#pragma unroll
      for (int i = 0; i < 16; ++i) Tl[(16 * g + i) * TLP + 16 * g + c] = Dr[i]; }
#pragma unroll
    for (int bc = 0; bc < 3; ++bc)
#pragma unroll
        for (int b = bc + 1; b < 4; ++b) {
            f32x4 y = (f32x4){0.f, 0.f, 0.f, 0.f};
#pragma unroll
            for (int k = bc; k < b; ++k) { const f32x4 av = ld_m4<FLIP>(M, 16 * b + c, 16 * k + 4 * g);
                const LAS float* tp = Tl + (16 * k + 4 * g) * TLP + 16 * bc + c;
                const float b0 = tp[0], b1 = tp[TLP], b2 = tp[2 * TLP], b3 = tp[3 * TLP];
                y = __builtin_amdgcn_mfma_f32_16x16x4f32(av.x, b0, y, 0, 0, 0); y = __builtin_amdgcn_mfma_f32_16x16x4f32(av.y, b1, y, 0, 0, 0);
                y = __builtin_amdgcn_mfma_f32_16x16x4f32(av.z, b2, y, 0, 0, 0); y = __builtin_amdgcn_mfma_f32_16x16x4f32(av.w, b3, y, 0, 0, 0); }
            const f32x4 dv = *(const LAS f32x4*)(Tl + (16 * b + c) * TLP + 16 * b + 4 * g);
            f32x4 z = (f32x4){0.f, 0.f, 0.f, 0.f};
            z = __builtin_amdgcn_mfma_f32_16x16x4f32(dv.x, y[0], z, 0, 0, 0); z = __builtin_amdgcn_mfma_f32_16x16x4f32(dv.y, y[1], z, 0, 0, 0);
            z = __builtin_amdgcn_mfma_f32_16x16x4f32(dv.z, y[2], z, 0, 0, 0); z = __builtin_amdgcn_mfma_f32_16x16x4f32(dv.w, y[3], z, 0, 0, 0);
            LAS float* op = Tl + (16 * b + 4 * g) * TLP + 16 * bc + c;
            op[0] = -z[0]; op[TLP] = -z[1]; op[2 * TLP] = -z[2]; op[3 * TLP] = -z[3];
        }
    LDS_WAIT(); asm volatile("" ::: "memory");
    LAS bf16* Tw = (LAS bf16*)M; LAS bf16* Tu = Tw + 64 * DTP;
    const int cp = FLIP ? 63 - lane : lane;
#pragma unroll 8
    for (int ip = 0; ip < 64; ++ip) { const int cr = FLIP ? 63 - ip : ip; const float t = Tl[ip * TLP + lane]; Tw[cr * DTP + cp] = (bf16)f2bf(t * sw); Tu[cr * DTP + cp] = (bf16)f2bf(t * su); }
}

__device__ __forceinline__ void delta_prep(const Args& a, Frame& F) {
    const bf16* P = (const bf16*)(a.ws + WS_P);
    LAS bf16* Lq = (LAS bf16*)(F.lds + DL_Q); LAS bf16* Lk = (LAS bf16*)(F.lds + DL_K); LAS bf16* LkT = (LAS bf16*)(F.lds + DL_KT); LAS bf16* LvT = (LAS bf16*)(F.lds + DL_VT);
    LAS float* LM0 = (LAS float*)(F.lds + DL_M0); LAS float* LM1 = (LAS float*)(F.lds + DL_M1);
    LAS float* Lg = (LAS float*)(F.lds + DL_SM); LAS float* Lbeta = Lg + 128; LAS float* Lgc = Lg + 256; LAS float* Lbe = Lg + 384;
    const int l0 = F.lane, w = F.wave;
    for (int ci = blockIdx.x; ci < 1280; ci += gridDim.x) {
        int l = l0; asm volatile("" : "+v"(l));
        const int g = l >> 4, c = l & 15;
        int base, T, n, h; delta_item(ci, base, T, n, h);
        __syncthreads();
        { const int s = g, col = 512 * s + 128 * h + 8 * c; const bool act = l < 48;
          v4u xp[12];
#pragma unroll
          for (int rr = 0; rr < 12; ++rr) { const int tt = 64 * n + 8 * w - 2 + rr;
              xp[rr] = (act && tt >= 0 && tt < T) ? *(const v4u*)(P + (size_t)(base + tt) * NPAD + col) : (v4u){0u, 0u, 0u, 0u}; }
          float cw[5][8];
#pragma unroll
          for (int kk = 0; kk < 5; ++kk) { const f32x4 w0 = act ? *(const f32x4*)(a.conv_w + kk * 1536 + col) : (f32x4){0.f, 0.f, 0.f, 0.f}, w1 = act ? *(const f32x4*)(a.conv_w + kk * 1536 + col + 4) : (f32x4){0.f, 0.f, 0.f, 0.f};
              cw[kk][0] = w0.x; cw[kk][1] = w0.y; cw[kk][2] = w0.z; cw[kk][3] = w0.w; cw[kk][4] = w1.x; cw[kk][5] = w1.y; cw[kk][6] = w1.z; cw[kk][7] = w1.w; }
          unsigned ot[8][4];
#pragma unroll
          for (int rr = 0; rr < 8; ++rr) {
              float acc[8];
#pragma unroll
              for (int i = 0; i < 8; ++i) acc[i] = 0.f;
#pragma unroll
              for (int kk = 0; kk < 5; ++kk) { float xv[8]; unpack8(xp[rr + kk], xv);
#pragma unroll
                  for (int i = 0; i < 8; ++i) acc[i] += xv[i] * cw[kk][i]; }
              float ss = 0.f;
#pragma unroll
              for (int i = 0; i < 8; ++i) { acc[i] = silu_f(acc[i]); ss += acc[i] * acc[i]; }
              ss = g16_sum(ss);
              const float sc = s == 2 ? 1.f : (1.f / sqrtf(ss + 1e-6f)) * (s == 0 ? 0.08838834764831845f : 1.f);
#pragma unroll
              for (int p = 0; p < 4; ++p) ot[rr][p] = pk2(acc[2 * p] * sc, acc[2 * p + 1] * sc); }
          if (s < 2) { LAS bf16* dst = s == 0 ? Lq : Lk;
#pragma unroll
              for (int rr = 0; rr < 8; ++rr) *(LAS v4u*)(dst + (8 * w + rr) * DQP + 8 * c) = (v4u){ot[rr][0], ot[rr][1], ot[rr][2], ot[rr][3]}; }
          if (s == 1 || s == 2) { LAS bf16* dst = s == 1 ? LkT : LvT;
#pragma unroll
              for (int p = 0; p < 4; ++p) { v4u lo, hi;
                  lo.x = (ot[0][p] & 0xffffu) | (ot[1][p] << 16); lo.y = (ot[2][p] & 0xffffu) | (ot[3][p] << 16); lo.z = (ot[4][p] & 0xffffu) | (ot[5][p] << 16); lo.w = (ot[6][p] & 0xffffu) | (ot[7][p] << 16);
                  hi.x = (ot[0][p] >> 16) | (ot[1][p] & 0xffff0000u); hi.y = (ot[2][p] >> 16) | (ot[3][p] & 0xffff0000u); hi.z = (ot[4][p] >> 16) | (ot[5][p] & 0xffff0000u); hi.w = (ot[6][p] >> 16) | (ot[7][p] & 0xffff0000u);
                  *(LAS v4u*)(dst + (8 * c + 2 * p) * DTP + 8 * w) = lo; *(LAS v4u*)(dst + (8 * c + 2 * p + 1) * DTP + 8 * w) = hi; } } }
        if (F.tid < 128) { const int dir = F.tid >> 6, row = F.tid & 63, ix = dir * 4 + h; const bf16* rp = P + (size_t)(base + 64 * n + row) * NPAD;
            const float z = bf2f(rp[C_AL + ix]) + a.dt_bias[ix]; const float sp = z > 20.f ? z : log1pf(expf(z));
            Lg[dir * 64 + row] = -expf(a.a_log[ix]) * sp; Lbeta[dir * 64 + row] = 1.f / (1.f + expf(-bf2f(rp[C_BE + ix]))); }
        __syncthreads();
        if (w < 2) { const int dir = w; float v = Lg[dir * 64 + l];
#pragma unroll
            for (int off = 1; off < 64; off <<= 1) { const float t2 = dir ? __shfl_down(v, off) : __shfl_up(v, off); if (dir ? (l + off < 64) : (l >= off)) v += t2; }
            const float gl = __shfl(v, dir ? 0 : 63); const float eg = __expf(v), ekd = __expf(gl - v);
            Lgc[dir * 64 + l] = v; Lbe[dir * 64 + l] = Lbeta[dir * 64 + l] * eg;
            float* sm = (float*)(a.ws + WS_SM) + ((size_t)ci * 2 + dir) * 256; sm[l] = eg; sm[64 + l] = ekd; if (l == 0) sm[128] = __expf(gl); }
        __syncthreads();
        { const int it = w >> 1;
#pragma unroll
          for (int jj2 = 0; jj2 < 2; ++jj2) { const int jt = 2 * (w & 1) + jj2; f32x4 acc = (f32x4){0.f, 0.f, 0.f, 0.f};
#pragma unroll
              for (int s = 0; s < 4; ++s) { const bf16x8 av = *(const LAS bf16x8*)(Lk + (16 * it + c) * DQP + 32 * s + 8 * g), bv = *(const LAS bf16x8*)(Lk + (16 * jt + c) * DQP + 32 * s + 8 * g); acc = MFMA16(av, bv, acc); }
              const int j = 16 * jt + c; const float gfj = Lgc[j], gbj = Lgc[64 + j];
#pragma unroll
              for (int r = 0; r < 4; ++r) { const int i = 16 * it + 4 * g + r;
                  LM0[i * DMP + j] = i > j ? Lbeta[i] * acc[r] * __expf(Lgc[i] - gfj) : 0.f;
                  LM1[i * DMP + j] = i < j ? Lbeta[64 + i] * acc[r] * __expf(Lgc[64 + i] - gbj) : 0.f; } }
          const int m = w & 3, sp2 = w >> 2; f32x4 tf[2], tb[2];
#pragma unroll
          for (int hh = 0; hh < 2; ++hh) { const int mt = 2 * sp2 + hh; f32x4 acc = (f32x4){0.f, 0.f, 0.f, 0.f};
#pragma unroll
              for (int s = 0; s < 4; ++s) { const bf16x8 av = *(const LAS bf16x8*)(Lk + (16 * mt + c) * DQP + 32 * s + 8 * g), bv = *(const LAS bf16x8*)(Lq + (16 * m + c) * DQP + 32 * s + 8 * g); acc = MFMA16(av, bv, acc); }
              const int cq = 16 * m + c; const float gfq = Lgc[cq], gbq = Lgc[64 + cq];
#pragma unroll
              for (int r = 0; r < 4; ++r) { const int cp = 16 * mt + 4 * g + r;
                  tf[hh][r] = cq >= cp ? acc[r] * __expf(gfq - Lgc[cp]) : 0.f; tb[hh][r] = cq <= cp ? acc[r] * __expf(gbq - Lgc[64 + cp]) : 0.f; } }
          bf16x8* qkf = (bf16x8*)(a.ws + WS_QKF) + ((size_t)ci * 2) * 512;
          qkf[(m * 2 + sp2) * 64 + l] = pack_tiles(tf[0], tf[1]); qkf[512 + (m * 2 + sp2) * 64 + l] = pack_tiles(tb[0], tb[1]);
          bf16x8* qf = (bf16x8*)(a.ws + WS_QK) + (size_t)ci * 2048; bf16x8* ktf = qf + 1024;
#pragma unroll
          for (int f2 = 0; f2 < 2; ++f2) { const int f = 2 * w + f2;
              { const int mq = f >> 2, s = f & 3; const s16x4 lo = *(const LAS s16x4*)(Lq + (16 * mq + c) * DQP + 32 * s + 4 * g), hi = *(const LAS s16x4*)(Lq + (16 * mq + c) * DQP + 32 * s + 16 + 4 * g);
                qf[f * 64 + l] = __builtin_shufflevector(lo, hi, 0, 1, 2, 3, 4, 5, 6, 7); }
              { const int mt = f >> 1, s = f & 1; const s16x4 lo = *(const LAS s16x4*)(LkT + (16 * mt + c) * DTP + 32 * s + 4 * g), hi = *(const LAS s16x4*)(LkT + (16 * mt + c) * DTP + 32 * s + 16 + 4 * g);
                ktf[f * 64 + l] = __builtin_shufflevector(lo, hi, 0, 1, 2, 3, 4, 5, 6, 7); } } }
        __syncthreads();
        if (w == 0) tri_inv<false>(LM0, (LAS float*)(F.lds + DL_Q), Lbe[l], Lbeta[l], l);
        else if (w == 1) tri_inv<true>(LM1, (LAS float*)(F.lds + DL_K), Lbe[64 + 63 - l], Lbeta[64 + 63 - l], l);
        __syncthreads();
        { const int dir = w >> 2, wq = w & 3; const LAS bf16* Tw = (const LAS bf16*)(dir ? LM1 : LM0); const LAS bf16* Tu = Tw + 64 * DTP;
          bf16x8* wf = (bf16x8*)((unsigned char*)a.out + OUT_WF) + ((size_t)ci * 2 + dir) * 1024;
          bf16x8 bt[2];
#pragma unroll
          for (int sp = 0; sp < 2; ++sp) bt[sp] = *(const LAS bf16x8*)(Tw + (16 * wq + c) * DTP + 32 * sp + 8 * g);
#pragma unroll
          for (int s = 0; s < 4; ++s) { f32x4 t2[2];
#pragma unroll
              for (int hh = 0; hh < 2; ++hh) { const int mt = 2 * s + hh; f32x4 acc = (f32x4){0.f, 0.f, 0.f, 0.f};
#pragma unroll
                  for (int sp = 0; sp < 2; ++sp) { const bf16x8 av = *(const LAS bf16x8*)(LkT + (16 * mt + c) * DTP + 32 * sp + 8 * g); acc = MFMA16(av, bt[sp], acc); }
                  t2[hh] = acc; }
              wf[(wq * 4 + s) * 64 + l] = pack_tiles(t2[0], t2[1]); }
          v4u* uf = (v4u*)((unsigned char*)a.out + OUT_UF) + ((size_t)ci * 2 + dir) * 1024;
#pragma unroll
          for (int n2 = 0; n2 < 2; ++n2) { const int ne = 2 * wq + n2; bf16x8 bv[2]; f32x4 ut[4];
#pragma unroll
              for (int sp = 0; sp < 2; ++sp) bv[sp] = *(const LAS bf16x8*)(LvT + (16 * ne + c) * DTP + 32 * sp + 8 * g);
#pragma unroll
              for (int m = 0; m < 4; ++m) { f32x4 acc = (f32x4){0.f, 0.f, 0.f, 0.f};
#pragma unroll
                  for (int sp = 0; sp < 2; ++sp) { const bf16x8 av = *(const LAS bf16x8*)(Tu + (16 * m + c) * DTP + 32 * sp + 8 * g); acc = MFMA16(av, bv[sp], acc); }
                  ut[m] = acc; }
              v4u o0, o1; o0.x = pk2(ut[0][0], ut[0][1]); o0.y = pk2(ut[0][2], ut[0][3]); o0.z = pk2(ut[1][0], ut[1][1]); o0.w = pk2(ut[1][2], ut[1][3]);
              o1.x = pk2(ut[2][0], ut[2][1]); o1.y = pk2(ut[2][2], ut[2][3]); o1.z = pk2(ut[3][0], ut[3][1]); o1.w = pk2(ut[3][2], ut[3][3]);
              uf[(ne * 64 + l) * 2] = o0; uf[(ne * 64 + l) * 2 + 1] = o1; } }
    }
}

constexpr int DS_SLOT = 69632;
__device__ __forceinline__ void ds_compute(Frame& F, int l, bf16* P, v4u (&RS)[17], int st, int base, int dir, int h, int j, int N) {
    const int g = l >> 4, c = l & 15, w = F.wave & 3;
    f32x4 S[8];
#pragma unroll
    for (int mt = 0; mt < 8; ++mt) S[mt] = __builtin_bit_cast(f32x4, RS[mt]);
    const int n = dir ? N - 1 - st : st;
    const LAS unsigned char* slot = F.lds + (st & 1) * DS_SLOT;
    const LAS bf16x8* QF = (const LAS bf16x8*)slot; const LAS bf16x8* KTF = QF + 1024; const LAS bf16x8* WF = QF + 2048; const LAS bf16x8* QKF = QF + 3072;
    const LAS v4u* up = (const LAS v4u*)(slot + 57344) + (w * 64 + l) * 2; const LAS float* sm = (const LAS float*)(slot + 65536);
    const v4u u0 = up[0], u1 = up[1];
    const unsigned uw[8] = {u0.x, u0.y, u0.z, u0.w, u1.x, u1.y, u1.z, u1.w};
    bf16x8 Sb[4];
#pragma unroll
    for (int s = 0; s < 4; ++s) Sb[s] = pack_tiles(S[2 * s], S[2 * s + 1]);
    f32x4 vn[4];
#pragma unroll
    for (int m = 0; m < 4; ++m) { f32x4 acc = (f32x4){0.f, 0.f, 0.f, 0.f};
#pragma unroll
        for (int s = 0; s < 4; ++s) acc = MFMA16(WF[(m * 4 + s) * 64 + l], Sb[s], acc);
        vn[m][0] = bflo(uw[2 * m]) - acc[0]; vn[m][1] = bfhi(uw[2 * m]) - acc[1]; vn[m][2] = bflo(uw[2 * m + 1]) - acc[2]; vn[m][3] = bfhi(uw[2 * m + 1]) - acc[3]; }
    __builtin_amdgcn_sched_barrier(0);
    bf16x8 vb[2], vk[2];
#pragma unroll
    for (int s = 0; s < 2; ++s) { vb[s] = pack_tiles(vn[2 * s], vn[2 * s + 1]);
        const f32x4 e0 = *(const LAS f32x4*)(sm + 64 + 32 * s + 4 * g), e1 = *(const LAS f32x4*)(sm + 64 + 32 * s + 16 + 4 * g);
        vk[s] = pack_tiles(vn[2 * s] * e0, vn[2 * s + 1] * e1); }
    const float gl = sm[128];
#pragma unroll
    for (int m = 0; m < 4; ++m) { f32x4 acc = (f32x4){0.f, 0.f, 0.f, 0.f};
#pragma unroll
        for (int s = 0; s < 4; ++s) acc = MFMA16(QF[(m * 4 + s) * 64 + l], Sb[s], acc);
        acc = acc * *(const LAS f32x4*)(sm + 16 * m + 4 * g);
#pragma unroll
        for (int s = 0; s < 2; ++s) acc = MFMA16(QKF[(m * 2 + s) * 64 + l], vb[s], acc);
        bf16* op = P + (size_t)(base + 64 * n + 16 * m + 4 * g) * NPAD + dir * 512 + h * 128 + 16 * j + c;
#pragma unroll
        for (int r = 0; r < 4; ++r) op[(size_t)r * NPAD] = (bf16)f2bf(acc[r]); }
    __builtin_amdgcn_sched_barrier(0);
#pragma unroll
    for (int mt = 0; mt < 8; ++mt) { f32x4 acc = S[mt] * gl;
#pragma unroll
        for (int s = 0; s < 2; ++s) acc = MFMA16(KTF[(mt * 2 + s) * 64 + l], vk[s], acc);
        S[mt] = acc; }
#pragma unroll
    for (int mt = 0; mt < 8; ++mt) RS[mt] = __builtin_bit_cast(v4u, S[mt]);
}
__device__ __forceinline__ void delta_scan_sample(const Args& a, Frame& F) {
    const int b = blockIdx.x, half = (b >> 3) & 1, q = (b >> 4) * 8 + (b & 7);
    const int dir = q & 1, h = (q >> 1) & 3, sq = q >> 3, N = 64, base = NPR + sq * 4096;
    const int l = F.lane, g = l >> 4, c = l & 15, w = F.wave, j = 4 * half + (w & 3);
    const bool loader = w >= 4; const int lw = w & 3;
    bf16* P = (bf16*)(a.ws + WS_P);
    const unsigned char* gQK = a.ws + WS_QK; const unsigned char* gWF = (const unsigned char*)a.out + OUT_WF; const unsigned char* gQKF = a.ws + WS_QKF;
    const unsigned char* gUF = (const unsigned char*)a.out + OUT_UF; const unsigned char* gSM = a.ws + WS_SM;
#define DS_CI(st) (((sq * 64 + (dir ? N - 1 - (st) : (st))) * 4 + h))
#define DS_SRC(ci_, p) ((p) < 32 ? gQK + (size_t)(ci_) * 32768 + (p) * 1024 : (p) < 48 ? gWF + ((size_t)(ci_) * 2 + dir) * 16384 + ((p) - 32) * 1024 : \
        (p) < 56 ? gQKF + ((size_t)(ci_) * 2 + dir) * 8192 + ((p) - 48) * 1024 : (p) < 64 ? gUF + ((size_t)(ci_) * 2 + dir) * 16384 + half * 8192 + ((p) - 56) * 1024 : gSM + ((size_t)(ci_) * 2 + dir) * 1024 + ((p) - 64) * 1024)
#define DS_LOAD(SET, st) do { const int ci_ = DS_CI(st); _Pragma("unroll") for (int i_ = 0; i_ < 17; ++i_) { const int p_ = lw + 4 * i_; SET[i_] = *(const v4u*)(DS_SRC(ci_, p_) + l * 16); } } while (0)
#define DS_WRITE(SET, slot) do { _Pragma("unroll") for (int i_ = 0; i_ < 17; ++i_) { const int p_ = lw + 4 * i_; *(LAS v4u*)(F.lds + (slot) * DS_SLOT + p_ * 1024 + l * 16) = SET[i_]; } } while (0)
    __syncthreads();
    if (loader) {
        v4u r0[17], r1[17], r2[17];
        DS_LOAD(r0, 0); DS_LOAD(r1, 1); DS_LOAD(r2, 2); DS_WRITE(r0, 0); DS_LOAD(r0, 3);
#define DS_LSTEP(st, SET) do { __syncthreads(); DS_WRITE(SET, ((st) + 1) & 1); DS_LOAD(SET, ((st) + 4 < N ? (st) + 4 : N - 1)); } while (0)
        for (int st0 = 0; st0 < N + 2; st0 += 3) { DS_LSTEP(st0, r1); DS_LSTEP(st0 + 1, r2); DS_LSTEP(st0 + 2, r0); }
#undef DS_LSTEP
    } else {
        v4u rs[17];
        const float* S0 = a.state_delta + ((size_t)(sq * 2 + dir) * 4 + h) * 16384;
#pragma unroll
        for (int mt = 0; mt < 8; ++mt) { f32x4 t;
#pragma unroll
            for (int r = 0; r < 4; ++r) t[r] = S0[(size_t)(16 * mt + 4 * g + r) * 128 + 16 * j + c];
            rs[mt] = __builtin_bit_cast(v4u, t); }
        for (int st = 0; st < N + 2; ++st) { __syncthreads(); if (st >= N) continue; int lx = l; asm volatile("" : "+v"(lx));
            ds_compute(F, lx, P, rs, st, base, dir, h, j, N); }
    }
#undef DS_CI
#undef DS_SRC
#undef DS_LOAD
#undef DS_WRITE
#undef DS_STEP
}

constexpr int DB_BUF = 57344;
__device__ __forceinline__ void delta_scan(const Args& a, Frame& F) {
    const int b = blockIdx.x; if (b >= 192) return;
    if (b < 64) { delta_scan_sample(a, F); return; }
    const bool smp = b < 64; const int q = smp ? (b >> 1) : b - 64, half = b & 1;
    const int dir = q & 1, h = (q >> 1) & 3, sq = q >> 3, N = smp ? 64 : 4, base = smp ? NPR + sq * 4096 : sq * 256;
    const int l = F.lane, g = l >> 4, c = l & 15, j = smp ? 4 * half + (F.wave & 3) : F.wave, dj = F.wave;
    const bool act = smp ? F.wave < 4 : true;
    bf16* P = (bf16*)(a.ws + WS_P);
    const unsigned char* gQK = a.ws + WS_QK; const unsigned char* gWF = (const unsigned char*)a.out + OUT_WF; const unsigned char* gQKF = a.ws + WS_QKF;
    const unsigned char* gUF = (const unsigned char*)a.out + OUT_UF; const float* gSM = (const float*)(a.ws + WS_SM);
    f32x4 S[8];
    if (smp) { const float* S0 = a.state_delta + ((size_t)(sq * 2 + dir) * 4 + h) * 16384;
#pragma unroll
        for (int mt = 0; mt < 8; ++mt)
#pragma unroll
            for (int r = 0; r < 4; ++r) S[mt][r] = S0[(size_t)(16 * mt + 4 * g + r) * 128 + 16 * j + c]; }
    else {
#pragma unroll
        for (int mt = 0; mt < 8; ++mt) S[mt] = (f32x4){0.f, 0.f, 0.f, 0.f}; }
#define DB_CI(st) ({ const int n_ = dir ? N - 1 - (st) : (st); smp ? (sq * 64 + n_) * 4 + h : 1024 + (sq * 4 + n_) * 4 + h; })
#define DB_DMA(st, buf) do { const int ci_ = DB_CI(st); _Pragma("unroll") for (int i_ = 0; i_ < 7; ++i_) { const int qd = 7 * dj + i_; \
        const unsigned char* src = qd < 32 ? gQK + (size_t)ci_ * 32768 + qd * 1024 : (qd < 48 ? gWF + ((size_t)ci_ * 2 + dir) * 16384 + (qd - 32) * 1024 : gQKF + ((size_t)ci_ * 2 + dir) * 8192 + (qd - 48) * 1024); \
        __builtin_amdgcn_global_load_lds((const unsigned*)(src + l * 16), (LAS unsigned*)(F.lds + (buf) * DB_BUF + qd * 1024), 16, 0, 0); } } while (0)
    __syncthreads();
    DB_DMA(0, 0);
    v4u nu0, nu1; f32x4 neg[4], nek[4]; float ngl;
    { const int ci0 = DB_CI(0); const v4u* up = (const v4u*)(gUF + ((size_t)ci0 * 2 + dir) * 16384) + (j * 64 + l) * 2; nu0 = up[0]; nu1 = up[1];
      const float* sm = gSM + ((size_t)ci0 * 2 + dir) * 256;
#pragma unroll
      for (int m = 0; m < 4; ++m) { neg[m] = *(const f32x4*)(sm + 16 * m + 4 * g); nek[m] = *(const f32x4*)(sm + 64 + 16 * m + 4 * g); }
      ngl = sm[128]; }
    unsigned po[8] = {0u, 0u, 0u, 0u, 0u, 0u, 0u, 0u}; int pn_ = 0;
    for (int st = 0; st < N; ++st) {
        asm volatile("s_waitcnt vmcnt(0)" ::: "memory");
        __syncthreads();
        if (act && st > 0) {
#pragma unroll
            for (int m = 0; m < 4; ++m) { bf16* op = P + (size_t)(base + 64 * pn_ + 16 * m + 4 * g) * NPAD + dir * 512 + h * 128 + 16 * j + c;
                op[0] = (bf16)(po[2 * m] & 0xffffu); op[(size_t)NPAD] = (bf16)(po[2 * m] >> 16); op[(size_t)2 * NPAD] = (bf16)(po[2 * m + 1] & 0xffffu); op[(size_t)3 * NPAD] = (bf16)(po[2 * m + 1] >> 16); } }
        const v4u u0 = nu0, u1 = nu1; f32x4 eg[4], ek[4];
#pragma unroll
        for (int m = 0; m < 4; ++m) { eg[m] = neg[m]; ek[m] = nek[m]; }
        const float gl = ngl;
        const int n = dir ? N - 1 - st : st;
        if (st + 1 < N) { DB_DMA(st + 1, (st + 1) & 1);
            const int ci1 = DB_CI(st + 1); const v4u* up = (const v4u*)(gUF + ((size_t)ci1 * 2 + dir) * 16384) + (j * 64 + l) * 2; nu0 = up[0]; nu1 = up[1];
            const float* sm = gSM + ((size_t)ci1 * 2 + dir) * 256;
#pragma unroll
            for (int m = 0; m < 4; ++m) { neg[m] = *(const f32x4*)(sm + 16 * m + 4 * g); nek[m] = *(const f32x4*)(sm + 64 + 16 * m + 4 * g); }
            ngl = sm[128]; }
        if (act) {
        const LAS bf16x8* bufp = (const LAS bf16x8*)(F.lds + (st & 1) * DB_BUF);
        const LAS bf16x8* QF = bufp; const LAS bf16x8* KTF = bufp + 1024; const LAS bf16x8* WF = bufp + 2048; const LAS bf16x8* QKF = bufp + 3072;
        bf16x8 Sb[4];
#pragma unroll
        for (int s = 0; s < 4; ++s) Sb[s] = pack_tiles(S[2 * s], S[2 * s + 1]);
        const float uu[16] = {bflo(u0.x), bfhi(u0.x), bflo(u0.y), bfhi(u0.y), bflo(u0.z), bfhi(u0.z), bflo(u0.w), bfhi(u0.w), bflo(u1.x), bfhi(u1.x), bflo(u1.y), bfhi(u1.y), bflo(u1.z), bfhi(u1.z), bflo(u1.w), bfhi(u1.w)};
        f32x4 vn[4];
#pragma unroll
        for (int m = 0; m < 4; ++m) { f32x4 acc = (f32x4){0.f, 0.f, 0.f, 0.f};
#pragma unroll
            for (int s = 0; s < 4; ++s) acc = MFMA16(WF[(m * 4 + s) * 64 + l], Sb[s], acc);
#pragma unroll
            for (int r = 0; r < 4; ++r) vn[m][r] = uu[4 * m + r] - acc[r]; }
        bf16x8 vb[2], vk[2];
#pragma unroll
        for (int s = 0; s < 2; ++s) { vb[s] = pack_tiles(vn[2 * s], vn[2 * s + 1]); vk[s] = pack_tiles(vn[2 * s] * ek[2 * s], vn[2 * s + 1] * ek[2 * s + 1]); }
#pragma unroll
        for (int m = 0; m < 4; ++m) { f32x4 acc = (f32x4){0.f, 0.f, 0.f, 0.f};
#pragma unroll
            for (int s = 0; s < 4; ++s) acc = MFMA16(QF[(m * 4 + s) * 64 + l], Sb[s], acc);
            acc = acc * eg[m];
#pragma unroll
            for (int s = 0; s < 2; ++s) acc = MFMA16(QKF[(m * 2 + s) * 64 + l], vb[s], acc);
            po[2 * m] = pk2(acc[0], acc[1]); po[2 * m + 1] = pk2(acc[2], acc[3]); }
        pn_ = n;
#pragma unroll
        for (int mt = 0; mt < 8; ++mt) { f32x4 acc = S[mt] * gl;
#pragma unroll
            for (int s = 0; s < 2; ++s) acc = MFMA16(KTF[(mt * 2 + s) * 64 + l], vk[s], acc);
            S[mt] = acc; }
        }
    }
    if (act) {
#pragma unroll
        for (int m = 0; m < 4; ++m) { bf16* op = P + (size_t)(base + 64 * pn_ + 16 * m + 4 * g) * NPAD + dir * 512 + h * 128 + 16 * j + c;
            op[0] = (bf16)(po[2 * m] & 0xffffu); op[(size_t)NPAD] = (bf16)(po[2 * m] >> 16); op[(size_t)2 * NPAD] = (bf16)(po[2 * m + 1] & 0xffffu); op[(size_t)3 * NPAD] = (bf16)(po[2 * m + 1] >> 16); } }
    if (!smp) { float* So = a.out + OUT_SD + ((size_t)(sq * 2 + dir) * 4 + h) * 16384;
#pragma unroll
        for (int mt = 0; mt < 8; ++mt)
#pragma unroll
            for (int r = 0; r < 4; ++r) So[(size_t)(16 * mt + 4 * g + r) * 128 + 16 * j + c] = S[mt][r]; }
#undef DB_CI
#undef DB_DMA
}

constexpr int N_PHASES = 11;
#ifndef PROBE_PHASE
#define PROBE_PHASE (-1)
#endif
#define PROBE_MULT 4
#ifndef N_LAUNCHES
#define N_LAUNCHES 1
#endif
__global__ void __launch_bounds__(NWAVES * 64, 2) fwd(Args a) {
    extern __shared__ __attribute__((aligned(16))) unsigned char lds[];
    Frame F; F.lds = (LAS unsigned char*)lds; F.tid = threadIdx.x; F.lane = F.tid & 63; F.wave = __builtin_amdgcn_readfirstlane(F.tid >> 6);
    F.gw = blockIdx.x * NWAVES + F.wave; F.NGW = gridDim.x * NWAVES;
    const int lo = a.ph_lo, hi = a.ph_hi;
    const float* mod = (const float*)(a.ws + WS_CTL + CTL_MOD_OFF);
    volatile LAS unsigned* MISC = (volatile LAS unsigned*)(F.lds + MISC_OFF);
    for (int u = F.tid; u < (LDS_BYTES - LDSCTL_OFF) / 4; u += NWAVES * 64) ((LAS unsigned*)(F.lds + LDSCTL_OFF))[u] = 0u;
    __syncthreads();
    XcdBarrier bar; bar.bar = (unsigned*)(a.ws + WS_CTL) + CW_BAR; bar.x = 0; bar.st = nullptr;
    if (hi - lo > 1) bar = xcd_barrier_post((unsigned*)(a.ws + WS_CTL) + CW_BAR, MISC + 8);
#define IN(k) (lo <= (k) && (k) < hi)
    unsigned long long pt0_ = 0, pt1_ = 0;
#define SEAM(k) do { if (PROBE_PHASE == (k)) pt1_ = 0; if (IN(k) && IN((k) + 1)) xcd_barrier(bar); if (PROBE_PHASE == (k)) pt1_ = __builtin_amdgcn_s_memrealtime(); if (PROBE_PHASE == (k) + 1) pt0_ = __builtin_amdgcn_s_memrealtime(); } while (0)
    if (PROBE_PHASE == 0) pt0_ = __builtin_amdgcn_s_memrealtime();
    if (IN(0)) p0_prologue(a, F);
    SEAM(0);
    if (IN(1)) p1_h(a, F);
    SEAM(1);
    if (IN(2)) { pg8::Gemm g{(const pg8::bf16_t*)(a.ws + WS_H), (const pg8::bf16_t*)(a.ws + WS_WIN), NROW, NPAD, D}; pg8::StaticOrder S; S.init(NROW, NPAD, D, gridDim.x, (int)blockIdx.x);
        pg8::EpiBf16<0> E{(pg8::bf16_t*)(a.ws + WS_P), NPAD, nullptr};
        pg8::gemm_phase<pg8::EpiBf16<0>, pg8::StaticOrder, true, true>(F.lds, g, S, E); }
    SEAM(2);
    if (IN(3)) { delta_prep(a, F); ret_ra(a, F); }
    SEAM(3);
    if (IN(4)) { delta_scan(a, F); ret_rb(a, F); __syncthreads(); late_weights(a, F); ret_rc(a, F); }
    SEAM(4);
    if (IN(5)) p5_combine(a, F);
    SEAM(5);
    if (IN(6)) { pg8::Gemm g{(const pg8::bf16_t*)(a.ws + WS_MIX), (const pg8::bf16_t*)(a.ws + WS_WO), NROW, D, D}; pg8::SplitTail S; S.init(D, gridDim.x, (int)blockIdx.x);
        pg8::EpiSplit E{(pg8::bf16_t*)(a.ws + WS_Y), (pg8::bf16_t*)(a.ws + WS_YS0), (pg8::bf16_t*)(a.ws + WS_YS1), D};
        pg8::gemm_phase<pg8::EpiSplit, pg8::SplitTail, true, true>(F.lds, g, S, E); }
    SEAM(6);
    if (IN(7)) p6b_ln1(a, F);
    SEAM(7);
    if (IN(8)) { pg8::Gemm g{(const pg8::bf16_t*)(a.ws + WS_H), (const pg8::bf16_t*)(a.ws + WS_W1), NROW, FF, D}; pg8::StaticOrder S; S.init(NROW, FF, D, gridDim.x, (int)blockIdx.x);
        pg8::EpiBf16<2> E{(pg8::bf16_t*)(a.ws + WS_P), FF, a.b_ff1};
        pg8::gemm_phase<pg8::EpiBf16<2>, pg8::StaticOrder, true, true>(F.lds, g, S, E); }
    SEAM(8);
    if (IN(9)) { pg8::Gemm g{(const pg8::bf16_t*)(a.ws + WS_P), (const pg8::bf16_t*)(a.ws + WS_W2), NROW, D, FF}; pg8::SplitTail S; S.init(FF, gridDim.x, (int)blockIdx.x);
        pg8::EpiSplit E{(pg8::bf16_t*)(a.ws + WS_F), (pg8::bf16_t*)(a.ws + WS_FS0), (pg8::bf16_t*)(a.ws + WS_FS1), D};
        pg8::gemm_phase<pg8::EpiSplit, pg8::SplitTail, true, true>(F.lds, g, S, E); }
    SEAM(9);
    if (IN(10)) p8b_ln2(a, F);
    if (PROBE_PHASE == 10) pt1_ = __builtin_amdgcn_s_memrealtime();
    if (PROBE_PHASE >= 0 && blockIdx.x == 0) { const unsigned long long want = (pt1_ - pt0_) * PROBE_MULT, s0_ = __builtin_amdgcn_s_memrealtime(); while (__builtin_amdgcn_s_memrealtime() - s0_ < want) __builtin_amdgcn_s_sleep(8); }
#undef IN
#undef SEAM
}

extern "C" void kernel_launch(void* const* d_in, const int* in_sizes, int n_in, void* d_out, int out_size, void* d_ws, size_t ws_size, hipStream_t stream) {
    static int grid = 0;
    if (grid == 0) {
        if (n_in != 24 || ws_size < WS_END || (size_t)out_size != OUT_SR + (size_t)16 * 2 * 4 * 64 * 128) { fprintf(stderr, "kernel_launch: unexpected problem: n_in %d out %d ws %zu\n", n_in, out_size, ws_size); grid = -1; return; }
        int dev = 0, cus = 0, per_cu = 0;
        if (hipGetDevice(&dev) != hipSuccess || hipDeviceGetAttribute(&cus, hipDeviceAttributeMultiprocessorCount, dev) != hipSuccess) { grid = -1; return; }
        if (hipFuncSetAttribute((const void*)fwd, hipFuncAttributeMaxDynamicSharedMemorySize, LDS_BYTES) != hipSuccess) { fprintf(stderr, "kernel_launch: hipFuncSetAttribute failed\n"); grid = -1; return; }
        if (hipOccupancyMaxActiveBlocksPerMultiprocessor(&per_cu, (const void*)fwd, NWAVES * 64, LDS_BYTES) != hipSuccess || per_cu < 1) { fprintf(stderr, "kernel_launch: occupancy query says %d workgroups per CU\n", per_cu); (void)hipGetLastError(); grid = -1; return; }
        grid = cus;
    }
    if (grid < 0) return;
    (void)hipMemsetAsync((char*)d_ws + WS_CTL, 0, CTL_ZERO_BYTES, stream);
    Args a{};
    const float** ap = (const float**)&a;
    for (int i = 0; i < 24; ++i) ap[i] = (const float*)d_in[i];
    a.out = (float*)d_out; a.ws = (unsigned char*)d_ws;
    if (N_LAUNCHES == 1) { a.ph_lo = 0; a.ph_hi = N_PHASES; hipLaunchKernelGGL(fwd, dim3(grid), dim3(NWAVES * 64), LDS_BYTES, stream, a); }
    else for (int p = 0; p < N_PHASES; ++p) { a.ph_lo = p; a.ph_hi = p + 1; hipLaunchKernelGGL(fwd, dim3(grid), dim3(NWAVES * 64), LDS_BYTES, stream, a); }
}
```
